# Optimizing an MI355X kernel written in HIP

```python
import jax, jax.numpy as jnp
from jax import lax
import numpy as np

D_MODEL = 1024
BATCH = 8
SEQ = 8192
DEPTH = 1

GRID_W = 64
CTX_LEN = 256
D_MIX = D_MODEL
NA_HEADS = 8
NA_HEAD_DIM = 64
NA_WIDTH = NA_HEADS * NA_HEAD_DIM
NA_WIN_ROWS = 8
NA_WIN_COLS = 16
ML_HEADS = 4
ML_HEAD_DIM = 128
ML_WIDTH = ML_HEADS * ML_HEAD_DIM
ML_CHUNK = 128
CONV_K = 5
N_GROUPS = 8
EXPERTS_PER_GROUP = 8
N_EXPERTS = N_GROUPS * EXPERTS_PER_GROUP
TOP_K_IN_GROUP = 2
EXPERT_HIDDEN = 512
MOE_BLOCK = 128
ROPE_BASE = 10000.0
LN_EPS = 1e-5
DEEPNORM_ALPHA = (2.0 * DEPTH) ** 0.25
DEEPNORM_BETA = (8.0 * DEPTH) ** -0.25

COL_NA_Q = 0
COL_NA_K = COL_NA_Q + NA_WIDTH
COL_NA_V = COL_NA_K + NA_WIDTH
COL_ML_Q = COL_NA_V + NA_WIDTH
COL_ML_K = COL_ML_Q + ML_WIDTH
COL_ML_V = COL_ML_K + ML_WIDTH
COL_ML_O = COL_ML_V + ML_WIDTH
COL_GATES = COL_ML_O + ML_WIDTH
IN_COLS = COL_GATES + 4 * ML_HEADS

kernel_name = 'hybrid_na_mlstm_hmoe_layer'


def _layer_norm(x, gain=None, bias=None):
    x32 = x.astype(jnp.float32)
    mu = jnp.mean(x32, axis=-1, keepdims=True)
    var = jnp.mean(jnp.square(x32 - mu), axis=-1, keepdims=True)
    y = (x32 - mu) * lax.rsqrt(var + LN_EPS)
    if gain is not None:
        y = y * gain.astype(jnp.float32) + bias.astype(jnp.float32)
    return y.astype(x.dtype)


def _modulate(xn, shift, scale):
    return xn * (1.0 + scale) + shift


def _heads(z, col, n_heads, head_dim):
    B, T, _ = z.shape
    return z[..., col:col + n_heads * head_dim].reshape(B, T, n_heads, head_dim)


def _centred_depthwise_conv(u, w, b):
    pad = CONV_K // 2
    out = lax.conv_general_dilated(u, w[:, None, :].astype(u.dtype), window_strides=(1,),
                                   padding=[(pad, pad)], dimension_numbers=('NWC', 'WIO', 'NWC'),
                                   feature_group_count=u.shape[-1])
    return out + b


def _rope_axis(x, pos):
    half = x.shape[-1] // 2
    inv = ROPE_BASE ** (-jnp.arange(half, dtype=jnp.float32) / half)
    ang = pos.astype(jnp.float32)[:, None] * inv[None, :]
    cos = jnp.cos(ang)[None, :, None, :]
    sin = jnp.sin(ang)[None, :, None, :]
    x32 = x.astype(jnp.float32)
    x1, x2 = x32[..., :half], x32[..., half:]
    return jnp.concatenate([x1 * cos - x2 * sin, x1 * sin + x2 * cos], axis=-1).astype(x.dtype)


def _rope_2d(x, row_pos, col_pos):
    d2 = x.shape[-1] // 2
    return jnp.concatenate([_rope_axis(x[..., :d2], row_pos), _rope_axis(x[..., d2:], col_pos)], axis=-1)


def _neighbourhood_attention(q, k, v, k_ctx, v_ctx, rpb):
    B, N, H, d = q.shape
    rows = N // GRID_W
    kr = min(NA_WIN_ROWS, rows)
    n_win = kr * NA_WIN_COLS
    qg = (q * d ** -0.5).reshape(B, rows, GRID_W, H, d)
    kg = k.reshape(B, rows, GRID_W, H, d)
    vg = v.reshape(B, rows, GRID_W, H, d)
    cols = jnp.arange(GRID_W)
    col_start = jnp.clip(cols - NA_WIN_COLS // 2, 0, GRID_W - NA_WIN_COLS)
    col_idx = col_start[:, None] + jnp.arange(NA_WIN_COLS)[None, :]
    col_off = col_idx - cols[:, None] + (NA_WIN_COLS - 1)

    def row_block(r):
        r0 = jnp.clip(r - kr // 2, 0, rows - kr)
        q_r = lax.dynamic_index_in_dim(qg, r, axis=1, keepdims=False)
        k_band = lax.dynamic_slice_in_dim(kg, r0, kr, axis=1)
        v_band = lax.dynamic_slice_in_dim(vg, r0, kr, axis=1)
        k_win = k_band[:, :, col_idx]
        v_win = v_band[:, :, col_idx]
        row_off = r0 + jnp.arange(kr) - r + (NA_WIN_ROWS - 1)
        bias = rpb[:, row_off[:, None, None], col_off[None, :, :]]
        bias = bias.transpose(0, 2, 1, 3).reshape(H, GRID_W, n_win)
        s_win = jnp.einsum('bqhd,brqjhd->bhqrj', q_r, k_win).reshape(B, H, GRID_W, n_win)
        s_ctx = jnp.einsum('bqhd,bchd->bhqc', q_r, k_ctx)
        s = jnp.concatenate([s_win.astype(jnp.float32) + bias.astype(jnp.float32),
                             s_ctx.astype(jnp.float32)], axis=-1)
        p = jax.nn.softmax(s, axis=-1).astype(v.dtype)
        p_win = p[..., :n_win].reshape(B, H, GRID_W, kr, NA_WIN_COLS)
        p_ctx = p[..., n_win:]
        return (jnp.einsum('bhqrj,brqjhd->bqhd', p_win, v_win)
                + jnp.einsum('bhqc,bchd->bqhd', p_ctx, v_ctx))

    out = lax.map(row_block, jnp.arange(rows))
    return out.transpose(1, 0, 2, 3, 4).reshape(B, N, H * d)


def _context_attention(q, k, v):
    B, T, H, d = q.shape
    s = jnp.einsum('bqhd,bkhd->bhqk', q * d ** -0.5, k).astype(jnp.float32)
    p = jax.nn.softmax(s, axis=-1).astype(v.dtype)
    return jnp.einsum('bhqk,bkhd->bqhd', p, v).reshape(B, T, H * d)


def _mlstm_streams(z, conv_w, conv_b, gate_b, row_pos, col_pos):
    B, T, _ = z.shape
    qk = jax.nn.silu(_centred_depthwise_conv(z[..., COL_ML_Q:COL_ML_V], conv_w, conv_b))
    q = qk[..., :ML_WIDTH].reshape(B, T, ML_HEADS, ML_HEAD_DIM)
    k = qk[..., ML_WIDTH:].reshape(B, T, ML_HEADS, ML_HEAD_DIM)
    if row_pos is not None:
        q = _rope_2d(q, row_pos, col_pos)
        k = _rope_2d(k, row_pos, col_pos)
    v = _heads(z, COL_ML_V, ML_HEADS, ML_HEAD_DIM)
    gates = (z[..., COL_GATES:IN_COLS] + gate_b).astype(jnp.float32)
    gates = gates.reshape(B, T, 4, ML_HEADS).transpose(2, 0, 3, 1)
    to_bhtd = lambda a: a.transpose(0, 2, 1, 3)
    return to_bhtd(q), to_bhtd(k) * ML_HEAD_DIM ** -0.5, to_bhtd(v), gates


def _mlstm_chunkwise(q, k, v, i_pre, f_pre, state):
    B, H, T, dk = q.shape
    dv = v.shape[-1]
    L = ML_CHUNK
    nc = T // L

    def to_chunks(a):
        a = a.astype(jnp.float32)
        return jnp.moveaxis(a.reshape((B, H, nc, L) + a.shape[3:]), 2, 0)

    causal = jnp.tril(jnp.ones((L, L), dtype=bool))

    def step(carry, inp):
        C, n, m = carry
        q_c, k_c, v_c, i_c, lf_c = inp
        b = jnp.cumsum(lf_c, axis=-1)
        dlog = jnp.where(causal, b[..., :, None] - b[..., None, :] + i_c[..., None, :], -jnp.inf)
        m_t = jnp.maximum(b + m[..., None], jnp.max(dlog, axis=-1))
        dw = jnp.exp(dlog - m_t[..., None])
        inter = jnp.exp(b + m[..., None] - m_t)
        s = jnp.einsum('bhtd,bhsd->bhts', q_c, k_c) * dw
        num = jnp.einsum('bhts,bhsv->bhtv', s, v_c) + inter[..., None] * jnp.einsum('bhtd,bhdv->bhtv', q_c, C)
        den = jnp.sum(s, axis=-1) + inter * jnp.einsum('bhtd,bhd->bht', q_c, n)
        h = num / jnp.maximum(jnp.abs(den), jnp.exp(-m_t))[..., None]
        b_end = b[..., -1]
        g = b_end[..., None] - b + i_c
        m_new = jnp.maximum(b_end + m, jnp.max(g, axis=-1))
        decay = jnp.exp(b_end + m - m_new)
        wgt = jnp.exp(g - m_new[..., None])
        C_new = decay[..., None, None] * C + jnp.einsum('bhs,bhsd,bhsv->bhdv', wgt, k_c, v_c)
        n_new = decay[..., None] * n + jnp.einsum('bhs,bhsd->bhd', wgt, k_c)
        return (C_new, n_new, m_new), h

    xs = (to_chunks(q), to_chunks(k), to_chunks(v), to_chunks(i_pre), to_chunks(jax.nn.log_sigmoid(f_pre)))
    state, hs = lax.scan(step, state, xs)
    h = jnp.moveaxis(hs, 0, 2).reshape(B, H, T, dv)
    return h, state


def _mlstm_bidirectional(q, k, v, gates, state_fwd, state_bwd):
    i_f, f_f, i_b, f_b = gates
    h_f, st_f = _mlstm_chunkwise(q, k, v, i_f, f_f, state_fwd)
    rev = lambda a: jnp.flip(a, axis=2)
    h_b, st_b = _mlstm_chunkwise(rev(q), rev(k), rev(v), rev(i_b), rev(f_b), state_bwd)
    return h_f + rev(h_b), st_f, st_b


def _mlstm_readout(h, o_pre, gain):
    B, H, T, dv = h.shape
    hn = h * lax.rsqrt(jnp.mean(jnp.square(h), axis=-1, keepdims=True) + LN_EPS)
    hn = hn.transpose(0, 2, 1, 3).reshape(B, T, H * dv)
    return (hn * gain.astype(jnp.float32) * jax.nn.sigmoid(o_pre.astype(jnp.float32))).astype(o_pre.dtype)


def _zero_mlstm_state(B):
    return (jnp.zeros((B, ML_HEADS, ML_HEAD_DIM, ML_HEAD_DIM), jnp.float32),
            jnp.zeros((B, ML_HEADS, ML_HEAD_DIM), jnp.float32),
            jnp.zeros((B, ML_HEADS), jnp.float32))


def _hier_moe(h, w_rg, b_rg, w_re, b_re, w1, w3, w2):
    B, T, D = h.shape
    n_tok = B * T
    xt = h.reshape(n_tok, D)
    group_logits = (xt @ w_rg + b_rg).astype(jnp.float32)
    group_prob = jax.nn.softmax(group_logits, axis=-1)
    grp = jnp.argmax(group_logits, axis=-1)
    grp_w = jnp.take_along_axis(group_prob, grp[:, None], axis=1)
    exp_logits = (xt @ w_re + b_re).astype(jnp.float32).reshape(n_tok, N_GROUPS, EXPERTS_PER_GROUP)
    exp_logits = jnp.take_along_axis(exp_logits, grp[:, None, None], axis=1)[:, 0]
    top_val, top_idx = lax.top_k(exp_logits, TOP_K_IN_GROUP)
    weights = grp_w * jax.nn.softmax(top_val, axis=-1)
    expert = grp[:, None] * EXPERTS_PER_GROUP + top_idx

    n_assign = n_tok * TOP_K_IN_GROUP
    flat_e = expert.reshape(-1).astype(jnp.int32)
    flat_tok = jnp.repeat(jnp.arange(n_tok, dtype=jnp.int32), TOP_K_IN_GROUP)
    flat_w = weights.reshape(-1)
    order = jnp.argsort(flat_e)
    e_sorted, tok_sorted, w_sorted = flat_e[order], flat_tok[order], flat_w[order]
    sizes = jnp.bincount(flat_e, length=N_EXPERTS)
    padded = (sizes + MOE_BLOCK - 1) // MOE_BLOCK * MOE_BLOCK
    start = jnp.cumsum(sizes) - sizes
    pstart = jnp.cumsum(padded) - padded
    dest = pstart[e_sorted] + jnp.arange(n_assign, dtype=jnp.int32) - start[e_sorted]
    cap = -(-n_assign // MOE_BLOCK) * MOE_BLOCK + N_EXPERTS * MOE_BLOCK
    n_blocks = cap // MOE_BLOCK
    buf_tok = jnp.full((cap,), n_tok, jnp.int32).at[dest].set(tok_sorted)
    buf_w = jnp.zeros((cap,), jnp.float32).at[dest].set(w_sorted)
    block_e = jnp.minimum(jnp.searchsorted(jnp.cumsum(padded), jnp.arange(n_blocks) * MOE_BLOCK, side='right'),
                          N_EXPERTS - 1)

    def expert_block(args):
        tok, e = args
        xb = xt[jnp.minimum(tok, n_tok - 1)]
        return (jax.nn.silu(xb @ w1[e]) * (xb @ w3[e])) @ w2[e]

    ys = lax.map(expert_block, (buf_tok.reshape(n_blocks, MOE_BLOCK), block_e)).reshape(cap, D)
    out = jax.ops.segment_sum(ys * buf_w[:, None].astype(ys.dtype), buf_tok, num_segments=n_tok + 1)[:n_tok]
    return out.reshape(B, T, D)


def setup_inputs(seed: int = 0) -> dict:
    key = jax.random.key(seed)
    ks = jax.random.split(key, 25)
    f32 = jnp.float32
    nrm = lambda k, shape, s: jax.random.normal(k, shape, f32) * s
    x = nrm(ks[0], (BATCH, SEQ, D_MODEL), 1.0)
    c = nrm(ks[1], (BATCH, D_MODEL), 1.0)
    ctx = nrm(ks[2], (BATCH, CTX_LEN, D_MODEL), 1.0)
    c_ctx = nrm(ks[3], (D_MODEL,), 1.0)
    w_ada = nrm(ks[4], (DEPTH, D_MODEL, 6 * D_MODEL), D_MODEL ** -0.5)
    b_ada = nrm(ks[5], (DEPTH, 6 * D_MODEL), 0.02)
    w_in = nrm(ks[6], (DEPTH, D_MODEL, IN_COLS), D_MODEL ** -0.5)
    conv_w = nrm(ks[7], (DEPTH, CONV_K, 2 * ML_WIDTH), CONV_K ** -0.5)
    conv_b = nrm(ks[8], (DEPTH, 2 * ML_WIDTH), 0.02)
    i_bias = nrm(ks[9], (DEPTH, 2, ML_HEADS), 0.1)
    f_bias = jnp.linspace(3.0, 6.0, ML_HEADS, dtype=f32) + nrm(ks[10], (DEPTH, 2, ML_HEADS), 0.1)
    gate_b = jnp.stack([i_bias[:, 0], f_bias[:, 0], i_bias[:, 1], f_bias[:, 1]], axis=1).reshape(DEPTH, 4 * ML_HEADS)
    rpb = nrm(ks[11], (DEPTH, NA_HEADS, 2 * NA_WIN_ROWS - 1, 2 * NA_WIN_COLS - 1), 0.1)
    ml_norm_g = 1.0 + nrm(ks[12], (DEPTH, ML_WIDTH), 0.02)
    w_out = nrm(ks[13], (DEPTH, D_MIX, D_MODEL), D_MIX ** -0.5 * DEEPNORM_BETA)
    ln1_g = 1.0 + nrm(ks[14], (DEPTH, D_MODEL), 0.02)
    ln1_b = nrm(ks[15], (DEPTH, D_MODEL), 0.02)
    w_router_g = nrm(ks[16], (DEPTH, D_MODEL, N_GROUPS), D_MODEL ** -0.5)
    b_router_g = nrm(ks[17], (DEPTH, N_GROUPS), 0.01)
    w_router_e = nrm(ks[18], (DEPTH, D_MODEL, N_EXPERTS), D_MODEL ** -0.5)
    b_router_e = nrm(ks[19], (DEPTH, N_EXPERTS), 0.01)
    w1 = nrm(ks[20], (DEPTH, N_EXPERTS, D_MODEL, EXPERT_HIDDEN), D_MODEL ** -0.5)
    w3 = nrm(ks[21], (DEPTH, N_EXPERTS, D_MODEL, EXPERT_HIDDEN), D_MODEL ** -0.5)
    w2 = nrm(ks[22], (DEPTH, N_EXPERTS, EXPERT_HIDDEN, D_MODEL), EXPERT_HIDDEN ** -0.5 * DEEPNORM_BETA)
    ln2_g = 1.0 + nrm(ks[23], (DEPTH, D_MODEL), 0.02)
    ln2_b = nrm(ks[24], (DEPTH, D_MODEL), 0.02)
    return {'x': x, 'c': c, 'ctx': ctx, 'c_ctx': c_ctx, 'w_ada': w_ada, 'b_ada': b_ada, 'w_in': w_in,
            'conv_w': conv_w, 'conv_b': conv_b, 'gate_b': gate_b, 'rpb': rpb, 'ml_norm_g': ml_norm_g,
            'w_out': w_out, 'ln1_g': ln1_g, 'ln1_b': ln1_b, 'w_router_g': w_router_g, 'b_router_g': b_router_g,
            'w_router_e': w_router_e, 'b_router_e': b_router_e, 'w1': w1, 'w3': w3, 'w2': w2,
            'ln2_g': ln2_g, 'ln2_b': ln2_b}


def reference(x, c, ctx, c_ctx, w_ada, b_ada, w_in, conv_w, conv_b, gate_b, rpb, ml_norm_g, w_out,
              ln1_g, ln1_b, w_router_g, b_router_g, w_router_e, b_router_e, w1, w3, w2, ln2_g, ln2_b):
    B, N, _ = x.shape
    pos = jnp.arange(N)
    row_pos = pos // GRID_W
    col_pos = pos % GRID_W
    for l in range(DEPTH):
        last = l == DEPTH - 1
        ada = (jax.nn.silu(c) @ w_ada[l] + b_ada[l])[:, None, :]
        ada_c = jax.nn.silu(c_ctx) @ w_ada[l] + b_ada[l]
        sh1, sc1, g1, sh2, sc2, g2 = jnp.split(ada, 6, axis=-1)
        csh1, csc1, cg1, csh2, csc2, cg2 = jnp.split(ada_c, 6, axis=-1)

        z = _modulate(_layer_norm(x), sh1, sc1) @ w_in[l]
        zc = _modulate(_layer_norm(ctx), csh1, csc1) @ w_in[l]

        k_na_c = _heads(zc, COL_NA_K, NA_HEADS, NA_HEAD_DIM)
        v_na_c = _heads(zc, COL_NA_V, NA_HEADS, NA_HEAD_DIM)
        na = _neighbourhood_attention(_heads(z, COL_NA_Q, NA_HEADS, NA_HEAD_DIM),
                                      _heads(z, COL_NA_K, NA_HEADS, NA_HEAD_DIM),
                                      _heads(z, COL_NA_V, NA_HEADS, NA_HEAD_DIM),
                                      k_na_c, v_na_c, rpb[l])

        zero = _zero_mlstm_state(B)
        q_c, k_c, v_c, gates_c = _mlstm_streams(zc, conv_w[l], conv_b[l], gate_b[l], None, None)
        h_ml_c, st_f, st_b = _mlstm_bidirectional(q_c, k_c, v_c, gates_c, zero, zero)
        q_l, k_l, v_l, gates_l = _mlstm_streams(z, conv_w[l], conv_b[l], gate_b[l], row_pos, col_pos)
        h_ml, _, _ = _mlstm_bidirectional(q_l, k_l, v_l, gates_l, st_f, st_b)
        ml = _mlstm_readout(h_ml, z[..., COL_ML_O:COL_GATES], ml_norm_g[l])

        mix = jnp.concatenate([na, ml], axis=-1) @ w_out[l]
        x_mid = _layer_norm(DEEPNORM_ALPHA * x + g1 * mix, ln1_g[l], ln1_b[l])

        moe = _hier_moe(_modulate(_layer_norm(x_mid), sh2, sc2), w_router_g[l], b_router_g[l],
                        w_router_e[l], b_router_e[l], w1[l], w3[l], w2[l])
        x_next = _layer_norm(DEEPNORM_ALPHA * x_mid + g2 * moe, ln2_g[l], ln2_b[l])

        if not last:
            na_c = _context_attention(_heads(zc, COL_NA_Q, NA_HEADS, NA_HEAD_DIM), k_na_c, v_na_c)
            ml_cout = _mlstm_readout(h_ml_c, zc[..., COL_ML_O:COL_GATES], ml_norm_g[l])
            mix_c = jnp.concatenate([na_c, ml_cout], axis=-1) @ w_out[l]
            ctx_mid = _layer_norm(DEEPNORM_ALPHA * ctx + cg1 * mix_c, ln1_g[l], ln1_b[l])
            moe_c = _hier_moe(_modulate(_layer_norm(ctx_mid), csh2, csc2), w_router_g[l], b_router_g[l],
                              w_router_e[l], b_router_e[l], w1[l], w3[l], w2[l])
            ctx = _layer_norm(DEEPNORM_ALPHA * ctx_mid + cg2 * moe_c, ln2_g[l], ln2_b[l])
        x = x_next
    return x
```

```cpp
#include <hip/hip_runtime.h>
#include <cstdio>
#include <cstdint>

#ifndef MK_N_LAUNCHES
#define MK_N_LAUNCHES 1
#endif

#define GAS __attribute__((address_space(1)))
#define LAS __attribute__((address_space(3)))
typedef unsigned short bf16;
typedef short bf16x8 __attribute__((ext_vector_type(8)));
typedef short bf16x4 __attribute__((ext_vector_type(4)));
typedef float f32x4 __attribute__((ext_vector_type(4)));
typedef float f32x2 __attribute__((ext_vector_type(2)));
typedef unsigned u32x4 __attribute__((ext_vector_type(4)));
typedef unsigned u32x2 __attribute__((ext_vector_type(2)));

constexpr int NB = 8, SEQ = 8192, DM = 1024, CTXL = 256;
constexpr int ML_ROWS = NB * SEQ, MC_ROWS = NB * CTXL, MT = ML_ROWS + MC_ROWS;
constexpr int IN_COLS = 3600, NZ = 3840;
constexpr int NEXP = 64, EH = 512;
constexpr float LN_EPS = 1e-5f;
constexpr float DN_ALPHA = 1.189207115002721f;
constexpr int NPHASE = 12;

constexpr size_t MiB = 1u << 20;
constexpr size_t WS_CTL = 0, CTL_ZERO_BYTES = 1 * MiB;
constexpr size_t WS_WIN = 1 * MiB;
constexpr size_t WS_WOUT = 9 * MiB;
constexpr size_t WS_W13 = 11 * MiB;
constexpr size_t WS_W2 = 139 * MiB;
constexpr size_t WS_ADA = 203 * MiB;
constexpr size_t WS_ROPE = 204 * MiB;
constexpr size_t WS_WR = 204 * MiB + 512 * 1024;
constexpr size_t WS_GATES = 205 * MiB;
constexpr size_t WS_TOKL = 210 * MiB;
constexpr size_t WS_ROUTE = 226 * MiB;
constexpr size_t WS_MLST = 227 * MiB;
constexpr int REC_FLOATS = 18688;
constexpr size_t WS_ZA = 270 * MiB;
constexpr size_t WS_ZQK = 468 * MiB;
constexpr size_t WS_ZV = 600 * MiB;
constexpr size_t WS_ZO = 666 * MiB;
constexpr size_t WS_XM = 732 * MiB;
constexpr size_t WS_MIX = 864 * MiB;
constexpr size_t WS_HB = 270 * MiB;
constexpr size_t WS_Y1 = 270 * MiB;
constexpr size_t WS_HMOE = 526 * MiB;
constexpr size_t WS_XM2 = 655 * MiB;
constexpr size_t WS_YMOE = 655 * MiB;
constexpr size_t WS_END = 992 * MiB;
static_assert(WS_MLST + (size_t)64 * 9 * REC_FLOATS * 4 <= WS_ZA, "ws map");
static_assert(WS_YMOE + (size_t)(131072 + 256) * 1024 * 2 <= WS_END, "ws map");
constexpr int CW_TMO = 0;
constexpr int CW_BAR = 4096;
constexpr int CW_CNT = 16384;

constexpr int PH_BYTES = 155648;
constexpr int MISC_OFF = PH_BYTES;
constexpr int LDS_BYTES = PH_BYTES + 4096;
constexpr int MS_TSTART = 64;
constexpr int MS_CNT = 384;
constexpr int MS_START = 704;
constexpr int MS_HIST = 1024;
constexpr int MS_BASE = 1280;

#define LDS_WAIT() asm volatile("s_waitcnt lgkmcnt(0)" ::: "memory")
#define VM_WAIT() asm volatile("s_waitcnt vmcnt(0)" ::: "memory")
#define RLX_AGENT __ATOMIC_RELAXED, __HIP_MEMORY_SCOPE_AGENT

__device__ __forceinline__ unsigned cvt_pk_bf16(float lo, float hi) { unsigned r; asm volatile("v_cvt_pk_bf16_f32 %0, %1, %2" : "=v"(r) : "v"(lo), "v"(hi)); return r; }
__device__ __forceinline__ float bf_lo(unsigned u) { return __builtin_bit_cast(float, u << 16); }
__device__ __forceinline__ float bf_hi(unsigned u) { return __builtin_bit_cast(float, u & 0xffff0000u); }
__device__ __forceinline__ float wave_sum(float v) {
#pragma unroll
    for (int o = 1; o < 64; o <<= 1) v += __shfl_xor(v, o);
    return v;
}
__device__ __forceinline__ bf16x4 tr_read(const LAS unsigned char* p) { return __builtin_amdgcn_ds_read_tr16_b64_v4i16((LAS bf16x4*)p); }
__device__ __forceinline__ bf16x8 cat4(bf16x4 a, bf16x4 b) { return (bf16x8){a[0], a[1], a[2], a[3], b[0], b[1], b[2], b[3]}; }
__device__ __forceinline__ bf16x8 as_bf16x8(u32x4 v) { return __builtin_bit_cast(bf16x8, v); }

#define XB_TMO      128
#define XB_XCNT(j)  (256  + 64 * (j))
#define XB_XSUB(j)  (1280 + 64 * (j))
#define XB_XGEN(j)  (2304 + 64 * (j))
#define XB_TOP      3328
#define XB_TOPGEN   3392
#define XCD_BAR_WORDS 3456
#define XB_SPIN_CAP (1u << 18)
__device__ __forceinline__ unsigned xb_ld(unsigned* p)              { return __hip_atomic_load(p, __ATOMIC_RELAXED, __HIP_MEMORY_SCOPE_AGENT); }
__device__ __forceinline__ unsigned xb_add(unsigned* p, unsigned v) { return __hip_atomic_fetch_add(p, v, __ATOMIC_RELAXED, __HIP_MEMORY_SCOPE_AGENT); }
__device__ __forceinline__ unsigned xb_xcc_id() { return (unsigned)__builtin_amdgcn_s_getreg((3 << 11) | 20) & 0xFu; }
#define XB_SPIN(cond, bar) do { unsigned _sp = 0; while (cond) { __builtin_amdgcn_s_sleep(1); \
    if ((++_sp & 255u) == 0u) { if (xb_ld(&(bar)[XB_TMO])) break; if (_sp > XB_SPIN_CAP) { atomicAdd(&(bar)[XB_TMO], 1u); break; } } } } while (0)
struct XcdBarrier { unsigned* bar; unsigned x; volatile LAS unsigned* st; };
__device__ __forceinline__ XcdBarrier xcd_barrier_post(unsigned* bar, volatile LAS unsigned* st) {
    XcdBarrier b; b.bar = bar; b.x = xb_xcc_id(); b.st = st;
    if (threadIdx.x == 0) (void)xb_add(&bar[XB_XCNT(b.x)], 1u);
    return b;
}
__device__ __forceinline__ void xcd_barrier_complete(unsigned* bar, unsigned x, unsigned& nloc, unsigned& nx) {
    const unsigned G = gridDim.x * gridDim.y * gridDim.z;
    unsigned sum, cnt, mine, sp = 0u;
    for (;;) {
        sum = 0u; cnt = 0u; mine = 0u;
#pragma unroll
        for (unsigned j = 0; j < 16; ++j) { const unsigned c = xb_ld(&bar[XB_XCNT(j)]); sum += c; cnt += (c > 0u) ? 1u : 0u; mine = (j == x) ? c : mine; }
        if (sum == G) break;
        __builtin_amdgcn_s_sleep(1);
        if ((++sp & 255u) == 0u) { if (xb_ld(&bar[XB_TMO])) break; if (sp > XB_SPIN_CAP) { atomicAdd(&bar[XB_TMO], 1u); break; } }
    }
    nloc = mine > 0u ? mine : 1u; nx = cnt > 0u ? cnt : 1u;
}
__device__ __forceinline__ void xcd_barrier(const XcdBarrier& b) {
    asm volatile("s_waitcnt vmcnt(0)" ::: "memory");
    __syncthreads();
    if (threadIdx.x == 0) {
        unsigned* bar = b.bar;
        __builtin_amdgcn_s_waitcnt(0);
        unsigned nloc = b.st[0], nx = b.st[1];
        if (nloc == 0u) { xcd_barrier_complete(bar, b.x, nloc, nx); b.st[0] = nloc; b.st[1] = nx; }
        const unsigned old = xb_add(&bar[XB_XSUB(b.x)], 1u);
        const unsigned gen = old / nloc;
        if (old + 1u == (gen + 1u) * nloc) {
            __builtin_amdgcn_fence(__ATOMIC_RELEASE, "agent");
            asm volatile("s_waitcnt vmcnt(0)" ::: "memory");
            const unsigned og = xb_add(&bar[XB_TOP], 1u);
            const unsigned tg = og / nx;
            if (og + 1u == (tg + 1u) * nx) xb_add(&bar[XB_TOPGEN], 1u);
            else XB_SPIN(xb_ld(&bar[XB_TOPGEN]) == tg, bar);
            __builtin_amdgcn_fence(__ATOMIC_ACQUIRE, "agent");
            xb_add(&bar[XB_XGEN(b.x)], 1u);
            asm volatile("s_waitcnt vmcnt(0)" ::: "memory");
        } else {
            XB_SPIN(xb_ld(&bar[XB_XGEN(b.x)]) == gen, bar);
            __builtin_amdgcn_fence(__ATOMIC_ACQUIRE, "agent");
            asm volatile("s_waitcnt vmcnt(0)" ::: "memory");
        }
    }
    __syncthreads();
}

namespace pg8 {
constexpr int BM = 256, BK = 64, HALF = 128, HTB = HALF * BK * 2, STAGE_BYTES = 8 * HTB, NXCD = 8, WGM = 8;
__host__ __device__ __forceinline__ int lds_byte(int r, int c) { const int st = (r >> 4) * 2 + (c >> 5), rr = r & 15, cc = c & 31, ob = rr * 64 + cc * 2; return st * 1024 + (ob ^ (((ob >> 9) & 1) << 5)); }
__host__ __device__ __forceinline__ void stage_rc(int b, int& R, int& C) { const int st = b / 1024, sb = b % 1024, swz = sb ^ (((sb >> 9) & 1) << 5); R = (st >> 1) * 16 + swz / 64; C = (st & 1) * 32 + (swz % 64) / 2; }
__host__ __device__ __forceinline__ int perm32(int rho) { const int n = rho >> 4, i = rho & 15; return 8 * (i >> 2) + 4 * n + (i & 3); }

struct Unit { int pm, pn, e, cnt; };

struct StaticOrder {
    int nM, nN, nwg, G, c;
    __device__ void init(int M, int N, int G_, int c_) { nM = M / BM; nN = N / BM; nwg = nM * nN; G = G_; c = c_; }
    __device__ bool next(int i, Unit& u) const {
        const long L = (long)i * G + c; if (L >= nwg) return false;
        int wgid = (int)L; { const int q = nwg / NXCD, r = nwg % NXCD, xcd = wgid % NXCD, off = wgid / NXCD; wgid = (xcd < r ? xcd * (q + 1) : r * (q + 1) + (xcd - r) * q) + off; }
        const int nig = WGM * nN, gid = wgid / nig, fm = gid * WGM, gsz = (nM - fm) < WGM ? (nM - fm) : WGM;
        u.pm = fm + ((wgid % nig) % gsz); u.pn = (wgid % nig) / gsz; u.e = 0; u.cnt = 256; return true;
    }
};
struct DenseSched {
    static constexpr bool GATHER = false;
    const char* A; const char* Bt; int K; StaticOrder ord;
    __device__ __forceinline__ bool next(int i, Unit& u) const { return ord.next(i, u); }
    __device__ __forceinline__ const char* a_ptr(const Unit& u) const { return A + (size_t)u.pm * BM * K * 2; }
    __device__ __forceinline__ const char* b_ptr(const Unit& u) const { return Bt + (size_t)u.pn * BM * K * 2; }
    __device__ __forceinline__ void a_voff(const Unit&, unsigned (&)[2][2], int, int, int, int) const {}
};

template <class Epi, class Sched, bool ALIGN_EPI = true>
__device__ __forceinline__ void gemm_phase(LAS unsigned char* lds, const int K, const Sched& S, const Epi& E) {
    const int tid = threadIdx.x, wid = __builtin_amdgcn_readfirstlane(tid >> 6), lane = tid & 63, wr = wid >> 2, wc = wid & 3, fr = lane & 15, fq = lane >> 4;
    const int nt = K / BK;
    unsigned voffA[2], voffB[2]; int RA[2], CA[2];
#pragma unroll
    for (int i = 0; i < 2; ++i) { int R, C; stage_rc(tid * 16 + i * 8192, R, C); const int Rb = Epi::PERM ? ((R & ~31) + perm32(R & 31)) : R;
        RA[i] = R; CA[i] = C; voffA[i] = (unsigned)(R * K + C) * 2u; voffB[i] = (unsigned)(Rb * K + C) * 2u; }
    const size_t kstep = (size_t)(BK * 2);
    const size_t hstep = (size_t)HALF * K * 2;
    const unsigned ldsw = (unsigned)wid * 1024u;
    const int aoff = lds_byte(wr * 64 + fr, fq * 8), boff = lds_byte(wc * 32 + fr, fq * 8);
#define PG8_SA(b, h) (((b) * 2 + (h)) * HTB)
#define PG8_SB(b, h) ((4 + (b) * 2 + (h)) * HTB)
#define PG8_STAGE(bufoff, gbase, voff) do { _Pragma("unroll") for (int _i = 0; _i < 2; ++_i) \
        __builtin_amdgcn_global_load_lds((const unsigned*)((const char*)(gbase) + (voff)[_i]), (LAS unsigned*)(lds + (bufoff) + ldsw + _i * 8192), 16, 0, 0); } while (0)
#define PG8_STAGE_A(b, h, ptr, gv) do { if constexpr (Sched::GATHER) { PG8_STAGE(PG8_SA(b, h), ptr, gv[h]); } else { PG8_STAGE(PG8_SA(b, h), (ptr) + ((h) ? hstep : 0), voffA); } } while (0)
#define PG8_LDA(dst, b, h) do { _Pragma("unroll") for (int m = 0; m < 4; ++m) _Pragma("unroll") for (int k = 0; k < 2; ++k) dst[m][k] = *(const LAS bf16x8*)(lds + PG8_SA(b, h) + aoff + m * 2048 + k * 1024); } while (0)
#define PG8_LDB(dst, b, h) do { _Pragma("unroll") for (int n = 0; n < 2; ++n) _Pragma("unroll") for (int k = 0; k < 2; ++k) dst[n][k] = *(const LAS bf16x8*)(lds + PG8_SB(b, h) + boff + n * 2048 + k * 1024); } while (0)
#define PG8_MMA(ai, bj, At, Bt) do { __builtin_amdgcn_s_setprio(1); _Pragma("unroll") for (int m = 0; m < 4; ++m) _Pragma("unroll") for (int n = 0; n < 2; ++n) _Pragma("unroll") for (int k = 0; k < 2; ++k) \
        acc[ai][bj][m][n] = __builtin_amdgcn_mfma_f32_16x16x32_bf16(Bt[n][k], At[m][k], acc[ai][bj][m][n], 0, 0, 0); __builtin_amdgcn_s_setprio(0); } while (0)
#define PG8_WAIT_V(n) asm volatile("s_waitcnt vmcnt(" #n ")" ::: "memory")
#define PG8_WAIT_L(n) asm volatile("s_waitcnt lgkmcnt(" #n ")" ::: "memory")
#define PG8_BAR __builtin_amdgcn_s_barrier()
#define PG8_SCHED __builtin_amdgcn_sched_barrier(0)
    Unit cur, nxt; int ui = 0;
    if (!S.next(0, cur)) return;
    f32x4 acc[2][2][4][2];
#pragma unroll
    for (int a = 0; a < 2; ++a)
#pragma unroll
        for (int b = 0; b < 2; ++b)
#pragma unroll
            for (int m = 0; m < 4; ++m)
#pragma unroll
                for (int n = 0; n < 2; ++n) acc[a][b][m][n] = (f32x4){0.f, 0.f, 0.f, 0.f};
    bf16x8 At[4][2], B0[2][2], B1[2][2];
    unsigned cv[2][2], nv[2][2];
    const char* cA = S.a_ptr(cur); const char* cB = S.b_ptr(cur);
    if constexpr (Sched::GATHER) { S.a_voff(cur, cv, RA[0], RA[1], CA[0], CA[1]);
#pragma unroll
        for (int h = 0; h < 2; ++h)
#pragma unroll
            for (int i = 0; i < 2; ++i) nv[h][i] = cv[h][i]; }
    PG8_STAGE(PG8_SB(0, 0), cB, voffB); PG8_STAGE(PG8_SB(0, 1), cB + hstep, voffB); PG8_STAGE_A(0, 0, cA, cv); PG8_STAGE_A(0, 1, cA, cv);
    if (wr == 1) PG8_BAR;
    PG8_WAIT_V(2); PG8_BAR;
    PG8_STAGE(PG8_SB(1, 0), cB + kstep, voffB); PG8_STAGE_A(1, 0, cA + kstep, cv); PG8_STAGE(PG8_SB(1, 1), cB + hstep + kstep, voffB);
    PG8_WAIT_V(6); PG8_BAR;
    for (;;) {
        const bool has_next = S.next(ui + 1, nxt);
        const char* nA = has_next ? S.a_ptr(nxt) : cA; const char* nB = has_next ? S.b_ptr(nxt) : cB;
        if constexpr (Sched::GATHER) { if (has_next) S.a_voff(nxt, nv, RA[0], RA[1], CA[0], CA[1]); }
        for (int t = 0; t < nt; t += 2) {
            const bool last = (t == nt - 2);
            const char* a1 = cA + (size_t)(t + 1) * kstep;
            const char* a2 = last ? nA : cA + (size_t)(t + 2) * kstep; const char* b2 = last ? nB : cB + (size_t)(t + 2) * kstep;
            const char* a3 = a2 + kstep; const char* b3 = b2 + kstep;
            unsigned v2[2][2];
            if constexpr (Sched::GATHER) {
#pragma unroll
                for (int h = 0; h < 2; ++h)
#pragma unroll
                    for (int i = 0; i < 2; ++i) v2[h][i] = last ? nv[h][i] : cv[h][i]; }
            PG8_LDB(B0, 0, 0); PG8_LDB(B1, 0, 1); PG8_SCHED; PG8_LDA(At, 0, 0); PG8_STAGE_A(1, 1, a1, cv);
            PG8_WAIT_V(8); PG8_WAIT_L(0); PG8_BAR; PG8_MMA(0, 0, At, B0); PG8_MMA(0, 1, At, B1); PG8_BAR; PG8_SCHED;
            PG8_LDA(At, 0, 1); PG8_STAGE(PG8_SB(0, 0), b2, voffB); PG8_STAGE(PG8_SB(0, 1), b2 + hstep, voffB); PG8_STAGE_A(0, 0, a2, v2);
            PG8_WAIT_V(8); PG8_WAIT_L(0); PG8_BAR; PG8_MMA(1, 0, At, B0); PG8_MMA(1, 1, At, B1); PG8_BAR; PG8_SCHED;
            PG8_LDB(B0, 1, 0); PG8_LDB(B1, 1, 1); PG8_SCHED; PG8_LDA(At, 1, 0); PG8_STAGE_A(0, 1, a2, v2);
            PG8_WAIT_V(8); PG8_WAIT_L(0); PG8_BAR; PG8_MMA(0, 0, At, B0); PG8_MMA(0, 1, At, B1); PG8_BAR; PG8_SCHED;
            PG8_LDA(At, 1, 1); PG8_STAGE(PG8_SB(1, 0), b3, voffB); PG8_STAGE(PG8_SB(1, 1), b3 + hstep, voffB); PG8_STAGE_A(1, 0, a3, v2);
            PG8_WAIT_V(8); PG8_WAIT_L(0); PG8_BAR; PG8_MMA(1, 0, At, B0); PG8_MMA(1, 1, At, B1); PG8_BAR; PG8_SCHED;
        }
        if constexpr (ALIGN_EPI) { if (wr == 0) PG8_BAR; }
        E(acc, cur, wr, wc, fr, fq);
        if (!has_next) break;
#pragma unroll
        for (int a = 0; a < 2; ++a)
#pragma unroll
            for (int b = 0; b < 2; ++b)
#pragma unroll
                for (int m = 0; m < 4; ++m)
#pragma unroll
                    for (int n = 0; n < 2; ++n) acc[a][b][m][n] = (f32x4){0.f, 0.f, 0.f, 0.f};
        cur = nxt; cA = nA; cB = nB; ++ui;
        if constexpr (Sched::GATHER) {
#pragma unroll
            for (int h = 0; h < 2; ++h)
#pragma unroll
                for (int i = 0; i < 2; ++i) cv[h][i] = nv[h][i]; }
        if constexpr (ALIGN_EPI) { if (wr == 1) PG8_BAR; }
    }
    PG8_WAIT_V(0);
    if constexpr (!ALIGN_EPI) { if (wr == 0) PG8_BAR; }
    PG8_BAR;
#undef PG8_SA
#undef PG8_SB
#undef PG8_STAGE
#undef PG8_STAGE_A
#undef PG8_LDA
#undef PG8_LDB
#undef PG8_MMA
#undef PG8_WAIT_V
#undef PG8_WAIT_L
#undef PG8_BAR
#undef PG8_SCHED
}
}

struct Args { const float* in[24]; float* out; unsigned char* ws; int ph_lo, ph_hi, li, pad; };
struct Frame {
    LAS unsigned char* lds;
    unsigned* ctl;
    int tid, lane, wave, vcu, G;
    unsigned char* ws;
};

__device__ __forceinline__ int rowmap(int mode, int n) { return mode == 0 ? n : ((n >> 7) * 256 + (n & 127) + (mode == 2 ? 128 : 0)); }
__device__ __forceinline__ void p0_transpose_item(const float* W, int K, int N, bf16* WT, int mode, LAS float* scr, int item, int lane) {
    const int nblk = (N + 31) / 32, kb = item / nblk, nb = item % nblk, k0 = 64 * kb, n0 = 32 * nb;
    const int nn = n0 + (lane & 31); const bool ok = nn < N;
#pragma unroll 8
    for (int i = 0; i < 32; ++i) { const int kk = 2 * i + (lane >> 5); scr[kk * 33 + (lane & 31)] = ok ? W[(size_t)(k0 + kk) * N + nn] : 0.f; }
    LDS_WAIT(); asm volatile("" ::: "memory");
    const int c = lane & 7;
#pragma unroll
    for (int j = 0; j < 4; ++j) { const int n = (lane >> 3) + 8 * j; const LAS float* s = scr + (8 * c) * 33 + n;
        u32x4 o; o.x = cvt_pk_bf16(s[0 * 33], s[1 * 33]); o.y = cvt_pk_bf16(s[2 * 33], s[3 * 33]); o.z = cvt_pk_bf16(s[4 * 33], s[5 * 33]); o.w = cvt_pk_bf16(s[6 * 33], s[7 * 33]);
        if (n0 + n < N) *(u32x4*)(WT + (size_t)rowmap(mode, n0 + n) * K + k0 + 8 * c) = o; }
    LDS_WAIT(); asm volatile("" ::: "memory");
}
__device__ __forceinline__ void p0_prologue(Frame& F, const Args& a) {
    const int gw = F.vcu * 8 + F.wave, NGW = F.G * 8, lane = F.lane, tid = F.tid;
    float* ada = (float*)(F.ws + WS_ADA);
    {
        LAS float* sS = (LAS float*)F.lds;
        LAS float* sP = (LAS float*)(F.lds + 36864);
        bool staged = false;
        for (int it = blockIdx.x; it < 192; it += F.G) {
            if (!staged) {
                for (int i = tid; i < 9 * 1024; i += 512) { const int r = i >> 10, k = i & 1023; const float v = r < 8 ? a.in[1][r * 1024 + k] : a.in[3][k]; sS[i] = v / (1.f + __expf(-v)); }
                staged = true;
            }
            __syncthreads();
            const int n = it * 32 + (lane & 31), kh = lane >> 5, kb = F.wave * 128;
            float acc[9];
#pragma unroll
            for (int r = 0; r < 9; ++r) acc[r] = 0.f;
            const float* W = a.in[4];
#pragma unroll 4
            for (int j = 0; j < 64; ++j) { const int k = kb + 2 * j + kh; const float w = W[(size_t)k * 6144 + n];
#pragma unroll
                for (int r = 0; r < 9; ++r) acc[r] += sS[r * 1024 + k] * w; }
#pragma unroll
            for (int r = 0; r < 9; ++r) { acc[r] += __shfl_xor(acc[r], 32); if (lane < 32) sP[(F.wave * 9 + r) * 32 + lane] = acc[r]; }
            __syncthreads();
            if (tid < 288) { const int r = tid >> 5, c = tid & 31; float s = a.in[5][it * 32 + c];
#pragma unroll
                for (int w = 0; w < 8; ++w) s += sP[(w * 9 + r) * 32 + c];
                ada[r * 6144 + it * 32 + c] = s; }
        }
        __syncthreads();
    }
    { float* rope = (float*)(F.ws + WS_ROPE);
      for (int i = blockIdx.x * 512 + tid; i < 128 * 32; i += F.G * 512) { const int pos = i >> 5, j = i & 31; const double ang = (double)pos * pow(10000.0, -(double)j / 32.0);
          rope[2 * i] = (float)cos(ang); rope[2 * i + 1] = (float)sin(ang); } }
    { bf16* wr = (bf16*)(F.ws + WS_WR);
      for (int i = blockIdx.x * 512 + tid; i < 80 * 1024; i += F.G * 512) { const int r = i >> 10, k = i & 1023; float v = 0.f;
          if (r < 8) v = a.in[15][k * 8 + r]; else if (r >= 16) v = a.in[17][k * 64 + (r - 16)];
          wr[i] = (bf16)(cvt_pk_bf16(v, 0.f) & 0xffffu); } }
    { u32x4* z = (u32x4*)((bf16*)(F.ws + WS_WIN) + (size_t)IN_COLS * 1024);
      for (int i = blockIdx.x * 512 + tid; i < (NZ - IN_COLS) * 1024 / 8; i += F.G * 512) z[i] = (u32x4){0u, 0u, 0u, 0u}; }
    LAS float* scr = (LAS float*)(F.lds + 49152 + F.wave * 8448);
    constexpr int I_IN = 16 * 113, I_OUT = 16 * 32, I_E = 256;
    constexpr int NITEMS = I_IN + I_OUT + 3 * NEXP * I_E;
    for (int it = gw; it < NITEMS; it += NGW) {
        int r = it;
        if (r < I_IN) { p0_transpose_item(a.in[6], 1024, IN_COLS, (bf16*)(F.ws + WS_WIN), 0, scr, r, lane); continue; } r -= I_IN;
        if (r < I_OUT) { p0_transpose_item(a.in[12], 1024, 1024, (bf16*)(F.ws + WS_WOUT), 0, scr, r, lane); continue; } r -= I_OUT;
        if (r < NEXP * I_E) { const int e = r >> 8; p0_transpose_item(a.in[19] + (size_t)e * 1024 * 512, 1024, 512, (bf16*)(F.ws + WS_W13) + (size_t)e * 1024 * 1024, 1, scr, r & 255, lane); continue; } r -= NEXP * I_E;
        if (r < NEXP * I_E) { const int e = r >> 8; p0_transpose_item(a.in[20] + (size_t)e * 1024 * 512, 1024, 512, (bf16*)(F.ws + WS_W13) + (size_t)e * 1024 * 1024, 2, scr, r & 255, lane); continue; } r -= NEXP * I_E;
        { const int e = r >> 8; p0_transpose_item(a.in[21] + (size_t)e * 512 * 1024, 512, 1024, (bf16*)(F.ws + WS_W2) + (size_t)e * 1024 * 512, 0, scr, r & 255, lane); }
    }
}

__device__ __forceinline__ void p1_ln_mod(Frame& F, const Args& a) {
    const int gw = F.vcu * 8 + F.wave, NGW = F.G * 8, lane = F.lane;
    const float* ada = (const float*)(F.ws + WS_ADA);
    bf16* XM = (bf16*)(F.ws + WS_XM);
    for (int m = gw; m < MT; m += NGW) {
        const float* xrow = m < ML_ROWS ? a.in[0] + (size_t)m * DM : a.in[2] + (size_t)(m - ML_ROWS) * DM;
        const int ab = m < ML_ROWS ? (m >> 13) : 8;
        const f32x4* xr = (const f32x4*)xrow + lane;
        const f32x4* sh = (const f32x4*)(ada + ab * 6144) + lane; const f32x4* sc = sh + 256;
        f32x4 v[4]; float s = 0.f;
#pragma unroll
        for (int j = 0; j < 4; ++j) { v[j] = xr[64 * j]; s += (v[j].x + v[j].y) + (v[j].z + v[j].w); }
        const float mean = wave_sum(s) * (1.f / DM); float s2 = 0.f;
#pragma unroll
        for (int j = 0; j < 4; ++j) { v[j] = v[j] - mean; s2 += (v[j].x * v[j].x + v[j].y * v[j].y) + (v[j].z * v[j].z + v[j].w * v[j].w); }
        const float rstd = 1.f / sqrtf(wave_sum(s2) * (1.f / DM) + LN_EPS);
        u32x2* o8 = (u32x2*)(XM + (size_t)m * DM) + lane;
#pragma unroll
        for (int j = 0; j < 4; ++j) { const f32x4 h = sh[64 * j], c = sc[64 * j]; const f32x4 y = (v[j] * rstd) * (c + 1.f) + h;
            o8[64 * j] = (u32x2){cvt_pk_bf16(y.x, y.y), cvt_pk_bf16(y.z, y.w)}; }
    }
}

struct EpiZ {
    static constexpr bool PERM = true;
    unsigned char* ws; const float* gate_b;
    __device__ __forceinline__ void operator()(const f32x4 (&acc)[2][2][4][2], const pg8::Unit& u, int wr, int wc, int fr, int fq) const {
        const int row0 = u.pm * 256 + wr * 64 + fr;
        if (u.pn < 14) {
            bf16* base; int ldc, colt;
            if (u.pn < 6) { base = (bf16*)(ws + WS_ZA); ldc = 1536; colt = u.pn * 256; }
            else if (u.pn < 10) { base = (bf16*)(ws + WS_ZQK); ldc = 1024; colt = (u.pn - 6) * 256; }
            else if (u.pn < 12) { base = (bf16*)(ws + WS_ZV); ldc = 512; colt = (u.pn - 10) * 256; }
            else { base = (bf16*)(ws + WS_ZO); ldc = 512; colt = (u.pn - 12) * 256; }
            const int col0 = colt + wc * 32 + 8 * fq;
#pragma unroll
            for (int ai = 0; ai < 2; ++ai)
#pragma unroll
                for (int m = 0; m < 4; ++m) { bf16* rowp = base + (size_t)(row0 + ai * 128 + m * 16) * ldc + col0;
#pragma unroll
                    for (int bj = 0; bj < 2; ++bj) { const f32x4 v0 = acc[ai][bj][m][0], v1 = acc[ai][bj][m][1];
                        u32x4 w; w.x = cvt_pk_bf16(v0[0], v0[1]); w.y = cvt_pk_bf16(v0[2], v0[3]); w.z = cvt_pk_bf16(v1[0], v1[1]); w.w = cvt_pk_bf16(v1[2], v1[3]);
                        *(u32x4*)(rowp + bj * 128) = w; } }
        } else if (wc == 0 && fq < 2) {
            float* G = (float*)(ws + WS_GATES);
            const f32x4 b0 = *(const f32x4*)(gate_b + 8 * fq), b1 = *(const f32x4*)(gate_b + 8 * fq + 4);
#pragma unroll
            for (int ai = 0; ai < 2; ++ai)
#pragma unroll
                for (int m = 0; m < 4; ++m) { float* rowp = G + (size_t)(row0 + ai * 128 + m * 16) * 16 + 8 * fq;
                    *(f32x4*)rowp = acc[ai][0][m][0] + b0; *(f32x4*)(rowp + 4) = acc[ai][0][m][1] + b1; }
        }
    }
};

__device__ __forceinline__ void p3_qkprep(Frame& F, const Args& a) {
    const int gw = F.vcu * 8 + F.wave, NGW = F.G * 8, lane = F.lane;
    const bf16* ZQK = (const bf16*)(F.ws + WS_ZQK); bf16* QKP = (bf16*)(F.ws + WS_XM);
    const float* rope = (const float*)(F.ws + WS_ROPE);
    const int blk = lane >> 2, i0 = (lane & 3) * 8, cA = blk * 64 + i0, cB = cA + 32;
    const bool is_k = blk >= 8, col_rot = (blk & 1) != 0;
    float wA[5][8], wB[5][8], bA[8], bB[8];
#pragma unroll
    for (int j = 0; j < 5; ++j)
#pragma unroll
        for (int e = 0; e < 8; ++e) { wA[j][e] = a.in[7][j * 1024 + cA + e]; wB[j][e] = a.in[7][j * 1024 + cB + e]; }
#pragma unroll
    for (int e = 0; e < 8; ++e) { bA[e] = a.in[8][cA + e]; bB[e] = a.in[8][cB + e]; }
    constexpr int RUN = 16, NITEM = MT / RUN;
    for (int it = gw; it < NITEM; it += NGW) {
        const int row0 = it * RUN;
        const bool lat = row0 < ML_ROWS;
        const int T = lat ? SEQ : CTXL, s0 = lat ? (row0 & (SEQ - 1)) : ((row0 - ML_ROWS) & (CTXL - 1));
        u32x4 winA[5], winB[5];
#pragma unroll
        for (int j = 0; j < 4; ++j) { const int s = s0 + j - 2; const bool ok = s >= 0 && s < T; const bf16* p = ZQK + (size_t)(row0 + j - 2) * 1024;
            winA[j + 1] = ok ? *(const u32x4*)(p + cA) : (u32x4){0u, 0u, 0u, 0u}; winB[j + 1] = ok ? *(const u32x4*)(p + cB) : (u32x4){0u, 0u, 0u, 0u}; }
#pragma unroll
        for (int r = 0; r < RUN; ++r) {
#pragma unroll
            for (int j = 0; j < 4; ++j) { winA[j] = winA[j + 1]; winB[j] = winB[j + 1]; }
            { const int s = s0 + r + 2; const bool ok = s < T; const bf16* p = ZQK + (size_t)(row0 + r + 2) * 1024;
              winA[4] = ok ? *(const u32x4*)(p + cA) : (u32x4){0u, 0u, 0u, 0u}; winB[4] = ok ? *(const u32x4*)(p + cB) : (u32x4){0u, 0u, 0u, 0u}; }
            float uA[8], uB[8];
#pragma unroll
            for (int e = 0; e < 8; ++e) { uA[e] = bA[e]; uB[e] = bB[e]; }
#pragma unroll
            for (int j = 0; j < 5; ++j)
#pragma unroll
                for (int q = 0; q < 4; ++q) { const unsigned xa = winA[j][q], xb = winB[j][q];
                    uA[2 * q] += wA[j][2 * q] * bf_lo(xa); uA[2 * q + 1] += wA[j][2 * q + 1] * bf_hi(xa);
                    uB[2 * q] += wB[j][2 * q] * bf_lo(xb); uB[2 * q + 1] += wB[j][2 * q + 1] * bf_hi(xb); }
#pragma unroll
            for (int e = 0; e < 8; ++e) { uA[e] = uA[e] / (1.f + __expf(-uA[e])); uB[e] = uB[e] / (1.f + __expf(-uB[e])); }
            if (lat) {
                const int s = s0 + r, pos = col_rot ? (s & 63) : (s >> 6);
                const f32x4* rp = (const f32x4*)(rope + (size_t)(pos * 32 + i0) * 2);
#pragma unroll
                for (int q = 0; q < 4; ++q) { const f32x4 cs = rp[q];
                    const float x1 = uA[2 * q], x2 = uB[2 * q], y1 = uA[2 * q + 1], y2 = uB[2 * q + 1];
                    uA[2 * q] = x1 * cs.x - x2 * cs.y; uB[2 * q] = x1 * cs.y + x2 * cs.x;
                    uA[2 * q + 1] = y1 * cs.z - y2 * cs.w; uB[2 * q + 1] = y1 * cs.w + y2 * cs.z; }
            }
            const float ksc = is_k ? 0.08838834764831845f : 1.f;
            u32x4 oA, oB;
#pragma unroll
            for (int q = 0; q < 4; ++q) { oA[q] = cvt_pk_bf16(uA[2 * q] * ksc, uA[2 * q + 1] * ksc); oB[q] = cvt_pk_bf16(uB[2 * q] * ksc, uB[2 * q + 1] * ksc); }
            bf16* o = QKP + (size_t)(row0 + r) * 1024;
            *(u32x4*)(o + cA) = oA; *(u32x4*)(o + cB) = oB;
        }
    }
}

constexpr int NA_RS = 160;
constexpr int NA_VB = 0, NA_VC = 512 * NA_RS, NA_MRG = NA_VC + 256 * NA_RS, NA_RPB = NA_MRG + 4 * 4224;
static_assert(NA_RPB + 2048 <= PH_BYTES, "NA LDS");
__device__ __forceinline__ void p3_na(Frame& F, const Args& a) {
    const int w = F.wave, lane = F.lane, tid = F.tid, cg = w & 3, half = w >> 2, g = lane >> 4, lq = lane & 15, qp = lq >> 2, pp = lane & 3;
    const bf16* ZA = (const bf16*)(F.ws + WS_ZA); bf16* MIX = (bf16*)(F.ws + WS_MIX);
    LAS unsigned char* VB = F.lds + NA_VB; LAS unsigned char* VC = F.lds + NA_VC; LAS float* RPB = (LAS float*)(F.lds + NA_RPB);
    LAS float* mb = (LAS float*)(F.lds + NA_MRG + cg * 4224);
    constexpr int NUNIT = NB * 8 * 128;
    const int per = (NUNIT + F.G - 1) / F.G, u0 = blockIdx.x * per, u1 = (u0 + per < NUNIT) ? u0 + per : NUNIT;
    const int cs = cg == 0 ? 0 : (cg == 1 ? 8 : (cg == 2 ? 24 : 32));
    const int qc = 16 * cg + lq, c0q = qc - 8 < 0 ? 0 : (qc - 8 > 48 ? 48 : qc - 8);
    int cur_bh = -1;
    for (int u = u0; u < u1; ++u) {
        const int r = u & 127, bh = u >> 7, head = bh & 7, b = bh >> 3;
        const int r0 = r - 4 < 0 ? 0 : (r - 4 > 120 ? 120 : r - 4);
        { const bf16* src = ZA + ((size_t)(b * SEQ + r0 * 64)) * 1536 + 1024 + head * 64;
#pragma unroll
          for (int i = 0; i < 8; ++i) { const int idx = tid + 512 * i, tok = idx >> 3, ch = idx & 7; *(LAS u32x4*)(VB + tok * NA_RS + ch * 16) = *(const u32x4*)(src + (size_t)tok * 1536 + ch * 8); } }
        if (bh != cur_bh) {
            const bf16* src = ZA + ((size_t)(ML_ROWS + b * CTXL)) * 1536 + 1024 + head * 64;
#pragma unroll
            for (int i = 0; i < 4; ++i) { const int idx = tid + 512 * i, tok = idx >> 3, ch = idx & 7; *(LAS u32x4*)(VC + tok * NA_RS + ch * 16) = *(const u32x4*)(src + (size_t)tok * 1536 + ch * 8); }
            if (tid < 465) RPB[tid] = a.in[10][head * 465 + tid];
            cur_bh = bh;
        }
        __syncthreads();
        const size_t qtok = (size_t)b * SEQ + r * 64 + qc;
        bf16x8 qf[2];
#pragma unroll
        for (int kk = 0; kk < 2; ++kk) qf[kk] = *(const bf16x8*)(ZA + qtok * 1536 + head * 64 + 32 * kk + 8 * g);
        f32x4 s[16];
        if (half == 0) {
#pragma unroll
            for (int rr = 0; rr < 8; ++rr)
#pragma unroll
                for (int tt = 0; tt < 2; ++tt) {
                    const size_t ktok = (size_t)b * SEQ + (r0 + rr) * 64 + cs + 16 * tt + lq;
                    const bf16* kp = ZA + ktok * 1536 + 512 + head * 64 + 8 * g;
                    const bf16x8 k0 = *(const bf16x8*)kp, k1 = *(const bf16x8*)(kp + 32);
                    f32x4 acc = (f32x4){0.f, 0.f, 0.f, 0.f};
                    acc = __builtin_amdgcn_mfma_f32_16x16x32_bf16(k0, qf[0], acc, 0, 0, 0);
                    acc = __builtin_amdgcn_mfma_f32_16x16x32_bf16(k1, qf[1], acc, 0, 0, 0);
                    const int rowoff = r0 + rr - r + 7;
#pragma unroll
                    for (int j = 0; j < 4; ++j) { const int kc = cs + 16 * tt + 4 * g + j; const bool valid = kc >= c0q && kc < c0q + 16;
                        int co = kc - qc + 15; co = co < 0 ? 0 : (co > 30 ? 30 : co);
                        const float bias = RPB[rowoff * 31 + co];
                        s[rr * 2 + tt][j] = valid ? acc[j] * 0.125f + bias : -1e30f; }
                }
        } else {
#pragma unroll
            for (int t = 0; t < 16; ++t) {
                const size_t ktok = (size_t)ML_ROWS + b * CTXL + 16 * t + lq;
                const bf16* kp = ZA + ktok * 1536 + 512 + head * 64 + 8 * g;
                const bf16x8 k0 = *(const bf16x8*)kp, k1 = *(const bf16x8*)(kp + 32);
                f32x4 acc = (f32x4){0.f, 0.f, 0.f, 0.f};
                acc = __builtin_amdgcn_mfma_f32_16x16x32_bf16(k0, qf[0], acc, 0, 0, 0);
                acc = __builtin_amdgcn_mfma_f32_16x16x32_bf16(k1, qf[1], acc, 0, 0, 0);
                s[t] = acc * 0.125f;
            }
        }
        float mx = -1e30f;
#pragma unroll
        for (int t = 0; t < 16; ++t) mx = fmaxf(mx, fmaxf(fmaxf(s[t][0], s[t][1]), fmaxf(s[t][2], s[t][3])));
        mx = fmaxf(mx, __shfl_xor(mx, 16)); mx = fmaxf(mx, __shfl_xor(mx, 32));
        float sum = 0.f;
#pragma unroll
        for (int t = 0; t < 16; ++t)
#pragma unroll
            for (int j = 0; j < 4; ++j) { const float p = __expf(s[t][j] - mx); s[t][j] = p; sum += p; }
        sum += __shfl_xor(sum, 16); sum += __shfl_xor(sum, 32);
        f32x4 o[4];
#pragma unroll
        for (int dt = 0; dt < 4; ++dt) o[dt] = (f32x4){0.f, 0.f, 0.f, 0.f};
        const LAS unsigned char* vb = half == 0 ? VB + cs * NA_RS : VC;
        const int kstride = half == 0 ? 64 : 32;
#pragma unroll
        for (int kp = 0; kp < 8; ++kp) {
            u32x4 pw; pw.x = cvt_pk_bf16(s[2 * kp][0], s[2 * kp][1]); pw.y = cvt_pk_bf16(s[2 * kp][2], s[2 * kp][3]); pw.z = cvt_pk_bf16(s[2 * kp + 1][0], s[2 * kp + 1][1]); pw.w = cvt_pk_bf16(s[2 * kp + 1][2], s[2 * kp + 1][3]);
            const bf16x8 pf = as_bf16x8(pw);
            const LAS unsigned char* vr = vb + (kp * kstride + 4 * g + qp) * NA_RS + 8 * pp;
#pragma unroll
            for (int dt = 0; dt < 4; ++dt) {
                const bf16x8 vf = cat4(tr_read(vr + 32 * dt), tr_read(vr + 16 * NA_RS + 32 * dt));
                o[dt] = __builtin_amdgcn_mfma_f32_16x16x32_bf16(vf, pf, o[dt], 0, 0, 0);
            }
        }
        if (half == 1) {
#pragma unroll
            for (int dt = 0; dt < 4; ++dt)
#pragma unroll
                for (int j = 0; j < 4; ++j) mb[(16 * dt + 4 * g + j) * 16 + lq] = o[dt][j];
            if (g == 0) { mb[1024 + lq] = mx; mb[1040 + lq] = sum; }
        }
        __syncthreads();
        if (half == 0) {
            const float m1 = mb[1024 + lq], l1 = mb[1040 + lq], M = fmaxf(mx, m1), f0 = __expf(mx - M), f1 = __expf(m1 - M), inv = 1.f / (f0 * sum + f1 * l1);
            bf16* op = MIX + qtok * 1024 + head * 64 + 4 * g;
#pragma unroll
            for (int dt = 0; dt < 4; ++dt) { float v[4];
#pragma unroll
                for (int j = 0; j < 4; ++j) v[j] = (f0 * o[dt][j] + f1 * mb[(16 * dt + 4 * g + j) * 16 + lq]) * inv;
                *(u32x2*)(op + 16 * dt) = (u32x2){cvt_pk_bf16(v[0], v[1]), cvt_pk_bf16(v[2], v[3])}; }
        }
    }
    __syncthreads();
}

constexpr int ML_QS = 0, ML_KS = 34816, ML_VS = 69632, ML_CS = 108544, ML_VEC = 147456;
constexpr int ML_QR = 272, ML_VR = 304;
static_assert(ML_VEC + 5 * 512 + 64 <= PH_BYTES, "mLSTM LDS");
template <bool OUT>
__device__ __forceinline__ void mlstm_unit(Frame& F, const int sc, const int grp  ) {
    const int w = F.wave, lane = F.lane, tid = F.tid, g = lane >> 4, lq = lane & 15, qp = lq >> 2, pp = lane & 3;
    const int dir = sc & 1, head = (sc >> 1) & 3, b = sc >> 3;
    const bf16* QKP = (const bf16*)(F.ws + WS_XM); const bf16* ZV = (const bf16*)(F.ws + WS_ZV); const float* GT = (const float*)(F.ws + WS_GATES);
    bf16* HB = (bf16*)(F.ws + WS_HB) + (size_t)dir * ML_ROWS * 512;
    float* REC = (float*)(F.ws + WS_MLST) + (size_t)sc * 9 * REC_FLOATS;
    LAS unsigned char* QS = F.lds + ML_QS; LAS unsigned char* KS = F.lds + ML_KS; LAS unsigned char* VS = F.lds + ML_VS; LAS unsigned char* CS = F.lds + ML_CS;
    LAS float* Va = (LAS float*)(F.lds + ML_VEC); LAS float* VA = Va + 128; LAS float* Vem = Va + 256; LAS float* Vin = Va + 384; LAS float* Vw = Va + 512; LAS float* Vs = Va + 640;
    const int nch = grp < 0 ? 2 : 8;
    const int T = grp < 0 ? CTXL : SEQ;
    const size_t rowbase = grp < 0 ? (size_t)ML_ROWS + b * CTXL : (size_t)b * SEQ;
    const int sig0 = grp < 0 ? 0 : grp * 1024;
    const int tt = w < 4 ? w : 11 - w;
    f32x4 Cacc[9];
#pragma unroll
    for (int vt = 0; vt < 9; ++vt) Cacc[vt] = (f32x4){0.f, 0.f, 0.f, 0.f};
    float m_prev = (grp < 0) ? 0.f : -1e30f, bsum = 0.f;
    if constexpr (OUT) {
        const float* R0 = REC;
        m_prev = R0[18432];
#pragma unroll
        for (int vt = 0; vt < 9; ++vt) Cacc[vt] = *(const f32x4*)(R0 + (16 * w + lq) * 144 + 16 * vt + 4 * g);
        for (int j = 0; j < grp; ++j) { const float* R = REC + (size_t)(1 + j) * REC_FLOATS; const float mj = R[18432], Bj = R[18433];
            const float mn = fmaxf(Bj + m_prev, mj), f = __expf(Bj + m_prev - mn), gc = __expf(mj - mn);
#pragma unroll
            for (int vt = 0; vt < 9; ++vt) Cacc[vt] = Cacc[vt] * f + *(const f32x4*)(R + (16 * w + lq) * 144 + 16 * vt + 4 * g) * gc;
            m_prev = mn; }
    }
    __syncthreads();
    if (tid < 384) { const int row = tid / 3, pc = tid % 3; u32x4 v = (u32x4){0u, 0u, 0u, 0u}; if (pc == 0) v.x = 0x3F80u; *(LAS u32x4*)(VS + row * ML_VR + 256 + pc * 16) = v; }
    if constexpr (OUT) {
#pragma unroll
        for (int vt = 0; vt < 9; ++vt) *(LAS u32x2*)(CS + (16 * w + lq) * ML_VR + (16 * vt + 4 * g) * 2) = (u32x2){cvt_pk_bf16(Cacc[vt][0], Cacc[vt][1]), cvt_pk_bf16(Cacc[vt][2], Cacc[vt][3])};
    }
    u32x4 pq[4], pk[4], pv[4]; float gi0 = 0.f, gi1 = 0.f, gf0 = 0.f, gf1 = 0.f;
    const int gcol_i = (2 * dir) * 4 + head, gcol_f = (2 * dir + 1) * 4 + head;
#define ML_TOK(sig) (dir ? (T - 1 - (sig)) : (sig))
#define ML_LOAD(k) do { _Pragma("unroll") for (int j = 0; j < 4; ++j) { const int id = tid + 512 * j, row = id >> 4, ch = id & 15; const size_t gr = rowbase + ML_TOK(sig0 + (k) * 128 + row); \
            if (OUT) pq[j] = *(const u32x4*)(QKP + gr * 1024 + head * 128 + ch * 8); \
            pk[j] = *(const u32x4*)(QKP + gr * 1024 + 512 + head * 128 + ch * 8); pv[j] = *(const u32x4*)(ZV + gr * 512 + head * 128 + ch * 8); } \
        if (w == 0) { const size_t g0 = rowbase + ML_TOK(sig0 + (k) * 128 + 2 * lane), g1 = rowbase + ML_TOK(sig0 + (k) * 128 + 2 * lane + 1); \
            gi0 = GT[g0 * 16 + gcol_i]; gf0 = GT[g0 * 16 + gcol_f]; gi1 = GT[g1 * 16 + gcol_i]; gf1 = GT[g1 * 16 + gcol_f]; } } while (0)
    ML_LOAD(0);
    for (int k = 0; k < nch; ++k) {
#pragma unroll
        for (int j = 0; j < 4; ++j) { const int id = tid + 512 * j, row = id >> 4, ch = id & 15;
            if (OUT) *(LAS u32x4*)(QS + row * ML_QR + ch * 16) = pq[j];
            *(LAS u32x4*)(KS + row * ML_QR + ch * 16) = pk[j]; *(LAS u32x4*)(VS + row * ML_VR + ch * 16) = pv[j]; }
        if (w == 0) {
            const float lf0 = fminf(gf0, 0.f) - log1pf(__expf(-fabsf(gf0))), lf1 = fminf(gf1, 0.f) - log1pf(__expf(-fabsf(gf1)));
            float P = lf0 + lf1;
#pragma unroll
            for (int o = 1; o < 64; o <<= 1) { const float t = __shfl_up(P, o); if (lane >= o) P += t; }
            const float b1 = P, b0 = P - lf1, a0 = gi0 - b0, a1 = gi1 - b1;
            float M = fmaxf(a0, a1);
#pragma unroll
            for (int o = 1; o < 64; o <<= 1) { const float t = __shfl_up(M, o); if (lane >= o) M = fmaxf(M, t); }
            float Mex = __shfl_up(M, 1); if (lane == 0) Mex = -1e30f;
            const float A0 = fmaxf(m_prev, fmaxf(Mex, a0)), A1 = fmaxf(m_prev, M);
            const float Aend = __shfl(A1, 63), bend = __shfl(b1, 63);
            *(LAS f32x2*)(Va + 2 * lane) = (f32x2){a0, a1}; *(LAS f32x2*)(VA + 2 * lane) = (f32x2){A0, A1};
            *(LAS f32x2*)(Vem + 2 * lane) = (f32x2){__expf(-(b0 + A0)), __expf(-(b1 + A1))};
            *(LAS f32x2*)(Vin + 2 * lane) = (f32x2){__expf(m_prev - A0), __expf(m_prev - A1)};
            *(LAS f32x2*)(Vw + 2 * lane) = (f32x2){__expf(a0 - Aend), __expf(a1 - Aend)};
            if (lane == 0) { Vs[0] = __expf(m_prev - Aend); Vs[1] = bend + Aend; Vs[2] = bend; }
        }
        if (k + 1 < nch) ML_LOAD(k + 1);
        __syncthreads();
        const float decay = Vs[0], m_new = Vs[1]; bsum += Vs[2];
        if constexpr (OUT) {
            const int t = 16 * tt + lq;
            bf16x8 qf[4];
#pragma unroll
            for (int kk = 0; kk < 4; ++kk) qf[kk] = *(const LAS bf16x8*)(QS + t * ML_QR + (32 * kk + 8 * g) * 2);
            f32x4 acc[9];
#pragma unroll
            for (int vt = 0; vt < 9; ++vt) acc[vt] = (f32x4){0.f, 0.f, 0.f, 0.f};
#pragma unroll
            for (int kk = 0; kk < 4; ++kk) { const LAS unsigned char* cr = CS + (32 * kk + 8 * g + qp) * ML_VR + 8 * pp;
#pragma unroll
                for (int vt = 0; vt < 9; ++vt) { const bf16x8 cf = cat4(tr_read(cr + 32 * vt), tr_read(cr + 4 * ML_VR + 32 * vt));
                    acc[vt] = __builtin_amdgcn_mfma_f32_16x16x32_bf16(cf, qf[kk], acc[vt], 0, 0, 0); } }
            { const float it = Vin[t];
#pragma unroll
              for (int vt = 0; vt < 9; ++vt) acc[vt] = acc[vt] * it; }
            const float At = VA[t];
            u32x2 pw[8];
#pragma unroll
            for (int st = 0; st < 8; ++st) {
                pw[st] = (u32x2){0u, 0u};
                if (st <= tt) {
                    f32x4 sa = (f32x4){0.f, 0.f, 0.f, 0.f};
#pragma unroll
                    for (int kk = 0; kk < 4; ++kk) { const bf16x8 kf = *(const LAS bf16x8*)(KS + (16 * st + lq) * ML_QR + (32 * kk + 8 * g) * 2);
                        sa = __builtin_amdgcn_mfma_f32_16x16x32_bf16(kf, qf[kk], sa, 0, 0, 0); }
                    const f32x4 av = *(const LAS f32x4*)(Va + 16 * st + 4 * g);
                    float p[4];
#pragma unroll
                    for (int j = 0; j < 4; ++j) { const int s = 16 * st + 4 * g + j; p[j] = (s <= t) ? sa[j] * __expf(av[j] - At) : 0.f; }
                    pw[st] = (u32x2){cvt_pk_bf16(p[0], p[1]), cvt_pk_bf16(p[2], p[3])};
                }
            }
#pragma unroll
            for (int kp = 0; kp < 4; ++kp) {
                if (2 * kp <= tt) {
                    const bf16x8 pf = as_bf16x8((u32x4){pw[2 * kp].x, pw[2 * kp].y, pw[2 * kp + 1].x, pw[2 * kp + 1].y});
                    const LAS unsigned char* vr = VS + (32 * kp + 4 * g + qp) * ML_VR + 8 * pp;
#pragma unroll
                    for (int vt = 0; vt < 9; ++vt) { const bf16x8 vf = cat4(tr_read(vr + 32 * vt), tr_read(vr + 16 * ML_VR + 32 * vt));
                        acc[vt] = __builtin_amdgcn_mfma_f32_16x16x32_bf16(vf, pf, acc[vt], 0, 0, 0); }
                }
            }
            const float den = __shfl(acc[8][0], lq);
            const float rd = 1.f / fmaxf(fabsf(den), Vem[t]);
            bf16* hp = HB + (rowbase + ML_TOK(sig0 + k * 128 + t)) * 512 + head * 128 + 4 * g;
#pragma unroll
            for (int vt = 0; vt < 8; ++vt) *(u32x2*)(hp + 16 * vt) = (u32x2){cvt_pk_bf16(acc[vt][0] * rd, acc[vt][1] * rd), cvt_pk_bf16(acc[vt][2] * rd, acc[vt][3] * rd)};
        }
#pragma unroll
        for (int vt = 0; vt < 9; ++vt) Cacc[vt] = Cacc[vt] * decay;
#pragma unroll
        for (int ks = 0; ks < 4; ++ks) {
            const LAS unsigned char* kr = KS + (32 * ks + 8 * g + qp) * ML_QR + (16 * w) * 2 + 8 * pp;
            const bf16x4 k0 = tr_read(kr), k1 = tr_read(kr + 4 * ML_QR);
            const f32x4 w0 = *(const LAS f32x4*)(Vw + 32 * ks + 8 * g), w1 = *(const LAS f32x4*)(Vw + 32 * ks + 8 * g + 4);
            const u32x2 ku0 = __builtin_bit_cast(u32x2, k0), ku1 = __builtin_bit_cast(u32x2, k1);
            const bf16x8 kf = as_bf16x8((u32x4){cvt_pk_bf16(bf_lo(ku0.x) * w0[0], bf_hi(ku0.x) * w0[1]), cvt_pk_bf16(bf_lo(ku0.y) * w0[2], bf_hi(ku0.y) * w0[3]),
                                                cvt_pk_bf16(bf_lo(ku1.x) * w1[0], bf_hi(ku1.x) * w1[1]), cvt_pk_bf16(bf_lo(ku1.y) * w1[2], bf_hi(ku1.y) * w1[3])});
            const LAS unsigned char* vr = VS + (32 * ks + 8 * g + qp) * ML_VR + 8 * pp;
#pragma unroll
            for (int vt = 0; vt < 9; ++vt) { const bf16x8 vf = cat4(tr_read(vr + 32 * vt), tr_read(vr + 4 * ML_VR + 32 * vt));
                Cacc[vt] = __builtin_amdgcn_mfma_f32_16x16x32_bf16(vf, kf, Cacc[vt], 0, 0, 0); }
        }
        m_prev = m_new;
        __syncthreads();
        if constexpr (OUT) {
#pragma unroll
            for (int vt = 0; vt < 9; ++vt) *(LAS u32x2*)(CS + (16 * w + lq) * ML_VR + (16 * vt + 4 * g) * 2) = (u32x2){cvt_pk_bf16(Cacc[vt][0], Cacc[vt][1]), cvt_pk_bf16(Cacc[vt][2], Cacc[vt][3])};
        }
    }
#undef ML_LOAD
#undef ML_TOK
    if constexpr (!OUT) {
        float* R = REC + (size_t)(grp < 0 ? 0 : 1 + grp) * REC_FLOATS;
#pragma unroll
        for (int vt = 0; vt < 9; ++vt) *(f32x4*)(R + (16 * w + lq) * 144 + 16 * vt + 4 * g) = Cacc[vt];
        if (tid == 0) { R[18432] = m_prev; R[18433] = bsum; }
    }
}

__device__ __forceinline__ void p6_readout(Frame& F, const Args& a) {
    const int gw = F.vcu * 8 + F.wave, NGW = F.G * 8, lane = F.lane;
    const bf16* HB0 = (const bf16*)(F.ws + WS_HB); const bf16* HB1 = HB0 + (size_t)ML_ROWS * 512; const bf16* ZO = (const bf16*)(F.ws + WS_ZO);
    bf16* MIX = (bf16*)(F.ws + WS_MIX);
    const f32x4 g0 = *(const f32x4*)(a.in[11] + 8 * lane), g1 = *(const f32x4*)(a.in[11] + 8 * lane + 4);
    for (int m = gw; m < ML_ROWS; m += NGW) {
        const u32x4 hf = *(const u32x4*)(HB0 + (size_t)m * 512 + 8 * lane), hb = *(const u32x4*)(HB1 + (size_t)m * 512 + 8 * lane), zo = *(const u32x4*)(ZO + (size_t)m * 512 + 8 * lane);
        float h[8]; float ss = 0.f;
#pragma unroll
        for (int q = 0; q < 4; ++q) { h[2 * q] = bf_lo(hf[q]) + bf_lo(hb[q]); h[2 * q + 1] = bf_hi(hf[q]) + bf_hi(hb[q]); ss += h[2 * q] * h[2 * q] + h[2 * q + 1] * h[2 * q + 1]; }
        ss += __shfl_xor(ss, 1); ss += __shfl_xor(ss, 2); ss += __shfl_xor(ss, 4); ss += __shfl_xor(ss, 8);
        const float rs = 1.f / sqrtf(ss * (1.f / 128.f) + LN_EPS);
        float o[8];
#pragma unroll
        for (int q = 0; q < 4; ++q) { const float z0 = bf_lo(zo[q]), z1 = bf_hi(zo[q]);
            o[2 * q] = h[2 * q] * rs * (q < 2 ? g0[2 * q] : g1[2 * q - 4]) / (1.f + __expf(-z0));
            o[2 * q + 1] = h[2 * q + 1] * rs * (q < 2 ? g0[2 * q + 1] : g1[2 * q - 3]) / (1.f + __expf(-z1)); }
        *(u32x4*)(MIX + (size_t)m * 1024 + 512 + 8 * lane) = (u32x4){cvt_pk_bf16(o[0], o[1]), cvt_pk_bf16(o[2], o[3]), cvt_pk_bf16(o[4], o[5]), cvt_pk_bf16(o[6], o[7])};
    }
}

struct EpiY1 {
    static constexpr bool PERM = false;
    const float* x; const float* ada; float* y1;
    __device__ __forceinline__ void operator()(const f32x4 (&acc)[2][2][4][2], const pg8::Unit& u, int wr, int wc, int fr, int fq) const {
        const int row0 = u.pm * 256 + wr * 64 + fr, col0 = u.pn * 256 + wc * 32 + 4 * fq;
        const float* g1 = ada + (size_t)(u.pm >> 5) * 6144 + 2048;
        f32x4 gv[2][2];
#pragma unroll
        for (int bj = 0; bj < 2; ++bj)
#pragma unroll
            for (int n = 0; n < 2; ++n) gv[bj][n] = *(const f32x4*)(g1 + col0 + bj * 128 + n * 16);
#pragma unroll
        for (int ai = 0; ai < 2; ++ai)
#pragma unroll
            for (int m = 0; m < 4; ++m) { const size_t off = (size_t)(row0 + ai * 128 + m * 16) * 1024 + col0;
#pragma unroll
                for (int bj = 0; bj < 2; ++bj)
#pragma unroll
                    for (int n = 0; n < 2; ++n) { const f32x4 xv = *(const f32x4*)(x + off + bj * 128 + n * 16);
                        *(f32x4*)(y1 + off + bj * 128 + n * 16) = xv * DN_ALPHA + gv[bj][n] * acc[ai][bj][m][n]; } }
    }
};

constexpr int P8_LG = 0;
constexpr int P8_REC = 40960;
__device__ __forceinline__ void p8_mid(Frame& F, const Args& a) {
    const int gw = F.vcu * 8 + F.wave, NGW = F.G * 8, lane = F.lane, tid = F.tid, g = lane >> 4, lq = lane & 15;
    float* Y1 = (float*)(F.ws + WS_Y1); bf16* XM2 = (bf16*)(F.ws + WS_XM2);
    const float* ada = (const float*)(F.ws + WS_ADA); const bf16* WR = (const bf16*)(F.ws + WS_WR);
    LAS float* lg = (LAS float*)(F.lds + P8_LG) + F.wave * 1280;
    LAS unsigned* rec = (LAS unsigned*)(F.lds + P8_REC);
    LAS int* hist = (LAS int*)(F.lds + MISC_OFF + MS_HIST); LAS int* base = (LAS int*)(F.lds + MISC_OFF + MS_BASE);
    if (tid < 64) hist[tid] = 0;
    __syncthreads();
    int nloc = 0;
    for (int wt = gw; wt < ML_ROWS / 16; wt += NGW, ++nloc) {
        const int row0 = wt * 16;
        const float* sh2 = ada + (size_t)(row0 >> 13) * 6144 + 3072; const float* sc2 = sh2 + 1024;
        for (int r = 0; r < 16; ++r) {
            const size_t m = (size_t)row0 + r;
            f32x4* yr = (f32x4*)(Y1 + m * 1024) + lane;
            f32x4 v[4]; float s = 0.f;
#pragma unroll
            for (int j = 0; j < 4; ++j) { v[j] = yr[64 * j]; s += (v[j].x + v[j].y) + (v[j].z + v[j].w); }
            float mean = wave_sum(s) * (1.f / DM), s2 = 0.f;
#pragma unroll
            for (int j = 0; j < 4; ++j) { v[j] = v[j] - mean; s2 += (v[j].x * v[j].x + v[j].y * v[j].y) + (v[j].z * v[j].z + v[j].w * v[j].w); }
            float rstd = 1.f / sqrtf(wave_sum(s2) * (1.f / DM) + LN_EPS);
            s = 0.f;
#pragma unroll
            for (int j = 0; j < 4; ++j) { const f32x4 gg = ((const f32x4*)a.in[13])[lane + 64 * j], bb = ((const f32x4*)a.in[14])[lane + 64 * j];
                v[j] = (v[j] * rstd) * gg + bb; yr[64 * j] = v[j]; s += (v[j].x + v[j].y) + (v[j].z + v[j].w); }
            mean = wave_sum(s) * (1.f / DM); s2 = 0.f;
#pragma unroll
            for (int j = 0; j < 4; ++j) { v[j] = v[j] - mean; s2 += (v[j].x * v[j].x + v[j].y * v[j].y) + (v[j].z * v[j].z + v[j].w * v[j].w); }
            rstd = 1.f / sqrtf(wave_sum(s2) * (1.f / DM) + LN_EPS);
            u32x2* o8 = (u32x2*)(XM2 + m * 1024) + lane;
#pragma unroll
            for (int j = 0; j < 4; ++j) { const f32x4 h = ((const f32x4*)sh2)[lane + 64 * j], c = ((const f32x4*)sc2)[lane + 64 * j]; const f32x4 y = (v[j] * rstd) * (c + 1.f) + h;
                o8[64 * j] = (u32x2){cvt_pk_bf16(y.x, y.y), cvt_pk_bf16(y.z, y.w)}; }
        }
        VM_WAIT();
        f32x4 la[5];
#pragma unroll
        for (int nt = 0; nt < 5; ++nt) la[nt] = (f32x4){0.f, 0.f, 0.f, 0.f};
        const bf16* xp = XM2 + (size_t)(row0 + lq) * 1024 + 8 * g;
        const bf16* wp = WR + (size_t)lq * 1024 + 8 * g;
#pragma unroll 4
        for (int kk = 0; kk < 32; ++kk) {
            const bf16x8 xf = __builtin_nontemporal_load((const bf16x8*)(xp + 32 * kk));
#pragma unroll
            for (int nt = 0; nt < 5; ++nt) { const bf16x8 wf = *(const bf16x8*)(wp + (size_t)nt * 16 * 1024 + 32 * kk);
                la[nt] = __builtin_amdgcn_mfma_f32_16x16x32_bf16(wf, xf, la[nt], 0, 0, 0); }
        }
#pragma unroll
        for (int nt = 0; nt < 5; ++nt) *(LAS f32x4*)(lg + lq * 80 + 16 * nt + 4 * g) = la[nt];
        LDS_WAIT();
        if (lane < 16) {
            const LAS float* L = lg + lane * 80;
            float gl[8]; float gm = -1e30f; int gi = 0;
#pragma unroll
            for (int i = 0; i < 8; ++i) { gl[i] = L[i] + a.in[16][i]; if (gl[i] > gm) { gm = gl[i]; gi = i; } }
            float gs = 0.f;
#pragma unroll
            for (int i = 0; i < 8; ++i) gs += __expf(gl[i] - gm);
            const float pg = 1.f / gs;
            float v1 = -1e30f, v2 = -1e30f; int i1 = 0, i2 = 0;
#pragma unroll
            for (int i = 0; i < 8; ++i) { const float e = L[16 + gi * 8 + i] + a.in[18][gi * 8 + i];
                if (e > v1) { v2 = v1; i2 = i1; v1 = e; i1 = i; } else if (e > v2) { v2 = e; i2 = i; } }
            const float ex = __expf(v2 - v1), wA = pg / (1.f + ex), wB = pg * ex / (1.f + ex);
            const int eA = gi * 8 + i1, eB = gi * 8 + i2;
            const int pA = __hip_atomic_fetch_add(&hist[eA], 1, __ATOMIC_RELAXED, __HIP_MEMORY_SCOPE_WORKGROUP), pB = __hip_atomic_fetch_add(&hist[eB], 1, __ATOMIC_RELAXED, __HIP_MEMORY_SCOPE_WORKGROUP);
            LAS unsigned* rc = rec + ((nloc * 8 + F.wave) * 16 + lane) * 8;
            rc[0] = (unsigned)eA; rc[1] = (unsigned)pA; rc[2] = (unsigned)eB; rc[3] = (unsigned)pB; rc[4] = __float_as_uint(wA); rc[5] = __float_as_uint(wB); rc[6] = (unsigned)(row0 + lane);
        }
    }
    __syncthreads();
    if (tid < 64) base[tid] = (int)__hip_atomic_fetch_add(F.ctl + CW_CNT + 16 * tid, (unsigned)hist[tid], RLX_AGENT);
    __syncthreads();
    {
        int* TOKL = (int*)(F.ws + WS_TOKL); u32x4* ROUTE = (u32x4*)(F.ws + WS_ROUTE);
        const int ntile_max = (ML_ROWS / 16 + NGW - 1) / NGW;
        for (int i = tid; i < ntile_max * 128; i += 512) {
            const int nl = i >> 7, wv = (i >> 4) & 7;
            if ((long)(F.vcu * 8 + wv) + (long)nl * NGW >= ML_ROWS / 16) continue;
            const LAS unsigned* rc = rec + i * 8;
            const int eA = (int)rc[0], pA = (int)rc[1] + base[rc[0]], eB = (int)rc[2], pB = (int)rc[3] + base[rc[2]], tok = (int)rc[6];
            TOKL[(size_t)eA * 65536 + pA] = tok; TOKL[(size_t)eB * 65536 + pB] = tok;
            ROUTE[tok] = (u32x4){((unsigned)eA << 20) | (unsigned)pA, ((unsigned)eB << 20) | (unsigned)pB, rc[4], rc[5]};
        }
    }
}

__device__ __forceinline__ void moe_tables(Frame& F) {
    LAS int* cnt = (LAS int*)(F.lds + MISC_OFF + MS_CNT); LAS int* start = (LAS int*)(F.lds + MISC_OFF + MS_START); LAS int* tstart = (LAS int*)(F.lds + MISC_OFF + MS_TSTART);
    __syncthreads();
    if (F.tid < 64) cnt[F.tid] = (int)__hip_atomic_load(F.ctl + CW_CNT + 16 * F.tid, RLX_AGENT);
    __syncthreads();
    if (F.tid == 0) { int s = 0, t = 0; for (int e = 0; e < 64; ++e) { start[e] = s; tstart[e] = t; s += cnt[e]; t += (cnt[e] + 255) >> 8; } start[64] = s; tstart[64] = t; }
    __syncthreads();
}
struct MoeOrder {
    const LAS int* cnt; const LAS int* start; const LAS int* tstart; int G, c;
    __device__ __forceinline__ bool next(int i, pg8::Unit& u) const {
        const long L = (long)i * G + c; const int tile = (int)(L >> 2);
        if (tile >= tstart[64]) return false;
        int e = 0;
        for (int s = 32; s >= 1; s >>= 1) if (tstart[e + s] <= tile) e += s;
        while (cnt[e] == 0) --e;
        u.e = e; u.pm = tile - tstart[e]; u.pn = (int)(L & 3); const int rem = cnt[e] - u.pm * 256; u.cnt = rem < 256 ? rem : 256; return true;
    }
};
struct MoeSched1 {
    static constexpr bool GATHER = true;
    MoeOrder ord; const char* XM2; const char* W13; const int* TOKL;
    __device__ __forceinline__ bool next(int i, pg8::Unit& u) const { return ord.next(i, u); }
    __device__ __forceinline__ const char* a_ptr(const pg8::Unit&) const { return XM2; }
    __device__ __forceinline__ const char* b_ptr(const pg8::Unit& u) const { return W13 + ((size_t)u.e * 1024 + (size_t)u.pn * 256) * 2048; }
    __device__ __forceinline__ void a_voff(const pg8::Unit& u, unsigned (&v)[2][2], int R0, int R1, int C0, int C1) const {
        const int* tl = TOKL + (size_t)u.e * 65536 + u.pm * 256;
#pragma unroll
        for (int h = 0; h < 2; ++h) { const int r0 = h * 128 + R0, r1 = h * 128 + R1;
            const int t0 = r0 < u.cnt ? tl[r0] : 0, t1 = r1 < u.cnt ? tl[r1] : 0;
            v[h][0] = (unsigned)t0 * 2048u + (unsigned)C0 * 2u; v[h][1] = (unsigned)t1 * 2048u + (unsigned)C1 * 2u; }
    }
};
struct MoeSched2 {
    static constexpr bool GATHER = false;
    MoeOrder ord; const char* H; const char* W2;
    __device__ __forceinline__ bool next(int i, pg8::Unit& u) const { return ord.next(i, u); }
    __device__ __forceinline__ const char* a_ptr(const pg8::Unit& u) const { return H + (size_t)(ord.start[u.e] + u.pm * 256) * 1024; }
    __device__ __forceinline__ const char* b_ptr(const pg8::Unit& u) const { return W2 + ((size_t)u.e * 1024 + (size_t)u.pn * 256) * 1024; }
    __device__ __forceinline__ void a_voff(const pg8::Unit&, unsigned (&)[2][2], int, int, int, int) const {}
};
struct EpiH {
    static constexpr bool PERM = true;
    bf16* H; const LAS int* start;
    __device__ __forceinline__ void operator()(const f32x4 (&acc)[2][2][4][2], const pg8::Unit& u, int wr, int wc, int fr, int fq) const {
        const int r0 = wr * 64 + fr; const size_t slot0 = (size_t)start[u.e] + u.pm * 256;
        const int col0 = u.pn * 128 + wc * 32 + 8 * fq;
#pragma unroll
        for (int ai = 0; ai < 2; ++ai)
#pragma unroll
            for (int m = 0; m < 4; ++m) { const int r = r0 + ai * 128 + m * 16;
                if (r < u.cnt) { float o[8];
#pragma unroll
                    for (int n = 0; n < 2; ++n)
#pragma unroll
                        for (int j = 0; j < 4; ++j) { const float h1 = acc[ai][0][m][n][j], h3 = acc[ai][1][m][n][j]; o[4 * n + j] = h1 / (1.f + __expf(-h1)) * h3; }
                    *(u32x4*)(H + (slot0 + r) * 512 + col0) = (u32x4){cvt_pk_bf16(o[0], o[1]), cvt_pk_bf16(o[2], o[3]), cvt_pk_bf16(o[4], o[5]), cvt_pk_bf16(o[6], o[7])}; } }
    }
};
struct EpiY {
    static constexpr bool PERM = true;
    bf16* Y; const LAS int* start;
    __device__ __forceinline__ void operator()(const f32x4 (&acc)[2][2][4][2], const pg8::Unit& u, int wr, int wc, int fr, int fq) const {
        const int r0 = wr * 64 + fr; const size_t slot0 = (size_t)start[u.e] + u.pm * 256;
        const int col0 = u.pn * 256 + wc * 32 + 8 * fq;
#pragma unroll
        for (int ai = 0; ai < 2; ++ai)
#pragma unroll
            for (int m = 0; m < 4; ++m) { const int r = r0 + ai * 128 + m * 16;
                if (r < u.cnt) {
#pragma unroll
                    for (int bj = 0; bj < 2; ++bj) { const f32x4 v0 = acc[ai][bj][m][0], v1 = acc[ai][bj][m][1];
                        *(u32x4*)(Y + (slot0 + r) * 1024 + col0 + bj * 128) = (u32x4){cvt_pk_bf16(v0[0], v0[1]), cvt_pk_bf16(v0[2], v0[3]), cvt_pk_bf16(v1[0], v1[1]), cvt_pk_bf16(v1[2], v1[3])}; } } }
    }
};

__device__ __forceinline__ void p11_final(Frame& F, const Args& a) {
    const int gw = F.vcu * 8 + F.wave, NGW = F.G * 8, lane = F.lane;
    const float* XMID = (const float*)(F.ws + WS_Y1); const bf16* Y = (const bf16*)(F.ws + WS_YMOE); const u32x4* ROUTE = (const u32x4*)(F.ws + WS_ROUTE);
    const float* ada = (const float*)(F.ws + WS_ADA);
    const LAS int* start = (const LAS int*)(F.lds + MISC_OFF + MS_START);
    for (int m = gw; m < ML_ROWS; m += NGW) {
        const u32x4 rt = ROUTE[m];
        const size_t sA = (size_t)start[rt.x >> 20] + (rt.x & 0xfffffu), sB = (size_t)start[rt.y >> 20] + (rt.y & 0xfffffu);
        const float wA = __uint_as_float(rt.z), wB = __uint_as_float(rt.w);
        const f32x4* xr = (const f32x4*)(XMID + (size_t)m * 1024) + lane;
        const u32x2* ya = (const u32x2*)(Y + sA * 1024) + lane; const u32x2* yb = (const u32x2*)(Y + sB * 1024) + lane;
        const f32x4* g2 = (const f32x4*)(ada + (size_t)(m >> 13) * 6144 + 5120) + lane;
        f32x4 v[4]; float s = 0.f;
#pragma unroll
        for (int j = 0; j < 4; ++j) { const f32x4 xv = xr[64 * j]; const u32x2 pa = ya[64 * j], pb = yb[64 * j]; const f32x4 gg = g2[64 * j];
            f32x4 mo; mo.x = wA * bf_lo(pa.x) + wB * bf_lo(pb.x); mo.y = wA * bf_hi(pa.x) + wB * bf_hi(pb.x); mo.z = wA * bf_lo(pa.y) + wB * bf_lo(pb.y); mo.w = wA * bf_hi(pa.y) + wB * bf_hi(pb.y);
            v[j] = xv * DN_ALPHA + gg * mo; s += (v[j].x + v[j].y) + (v[j].z + v[j].w); }
        const float mean = wave_sum(s) * (1.f / DM); float s2 = 0.f;
#pragma unroll
        for (int j = 0; j < 4; ++j) { v[j] = v[j] - mean; s2 += (v[j].x * v[j].x + v[j].y * v[j].y) + (v[j].z * v[j].z + v[j].w * v[j].w); }
        const float rstd = 1.f / sqrtf(wave_sum(s2) * (1.f / DM) + LN_EPS);
        f32x4* o = (f32x4*)(a.out + (size_t)m * 1024) + lane;
#pragma unroll
        for (int j = 0; j < 4; ++j) { const f32x4 gg = ((const f32x4*)a.in[22])[lane + 64 * j], bb = ((const f32x4*)a.in[23])[lane + 64 * j]; o[64 * j] = (v[j] * rstd) * gg + bb; }
    }
}

__global__ void __launch_bounds__(512, 2) mk_fwd(Args args) {
    extern __shared__ __attribute__((aligned(16))) unsigned char lds_raw[];
    Frame F;
    F.lds = (LAS unsigned char*)lds_raw; F.ws = args.ws; F.ctl = (unsigned*)(args.ws + WS_CTL);
    F.tid = threadIdx.x; F.lane = F.tid & 63; F.wave = __builtin_amdgcn_readfirstlane(F.tid >> 6);
    F.G = gridDim.x; { const int bx = blockIdx.x; F.vcu = (F.G % 8 == 0) ? (bx % 8) * (F.G / 8) + bx / 8 : bx; }
    for (int u = F.tid; u < (LDS_BYTES - MISC_OFF) / 4; u += 512) ((LAS unsigned*)(F.lds + MISC_OFF))[u] = 0u;
    __syncthreads();
    XcdBarrier bar; bar.bar = F.ctl + CW_BAR; bar.x = 0; bar.st = nullptr;
    if (MK_N_LAUNCHES == 1) bar = xcd_barrier_post(F.ctl + CW_BAR, (volatile LAS unsigned*)(F.lds + MISC_OFF));
    const int lo = args.ph_lo, hi = args.ph_hi;
#define IN(k) (lo <= (k) && (k) < hi)
#define SEAM(k) do { if (IN(k) && IN((k) + 1)) xcd_barrier(bar); } while (0)

    if (IN(0)) { p0_prologue(F, args); } SEAM(0);
    if (IN(1)) { p1_ln_mod(F, args); } SEAM(1);
    if (IN(2)) {
        pg8::DenseSched S; S.A = (const char*)(F.ws + WS_XM); S.Bt = (const char*)(F.ws + WS_WIN); S.K = 1024; S.ord.init(MT, NZ, F.G, (int)blockIdx.x);
        EpiZ E{F.ws, args.in[9]};
        pg8::gemm_phase<EpiZ, pg8::DenseSched>(F.lds, 1024, S, E);
    } SEAM(2);
    if (IN(3)) { p3_qkprep(F, args); p3_na(F, args); } SEAM(3);
    if (IN(4)) {
        for (int u = blockIdx.x; u < 576; u += F.G) { if (u < 512) mlstm_unit<false>(F, u >> 3, u & 7); else mlstm_unit<false>(F, u - 512, -1); }
    } SEAM(4);
    if (IN(5)) {
        for (int u = blockIdx.x; u < 512; u += F.G) mlstm_unit<true>(F, u >> 3, u & 7);
    } SEAM(5);
    if (IN(6)) { p6_readout(F, args); } SEAM(6);
    if (IN(7)) {
        pg8::DenseSched S; S.A = (const char*)(F.ws + WS_MIX); S.Bt = (const char*)(F.ws + WS_WOUT); S.K = 1024; S.ord.init(ML_ROWS, 1024, F.G, (int)blockIdx.x);
        EpiY1 E{args.in[0], (const float*)(F.ws + WS_ADA), (float*)(F.ws + WS_Y1)};
        pg8::gemm_phase<EpiY1, pg8::DenseSched>(F.lds, 1024, S, E);
    } SEAM(7);
    if (IN(8)) { p8_mid(F, args); } SEAM(8);
    if (IN(9)) {
        moe_tables(F);
        MoeSched1 S; S.ord = MoeOrder{(const LAS int*)(F.lds + MISC_OFF + MS_CNT), (const LAS int*)(F.lds + MISC_OFF + MS_START), (const LAS int*)(F.lds + MISC_OFF + MS_TSTART), F.G, (int)blockIdx.x};
        S.XM2 = (const char*)(F.ws + WS_XM2); S.W13 = (const char*)(F.ws + WS_W13); S.TOKL = (const int*)(F.ws + WS_TOKL);
        EpiH E{(bf16*)(F.ws + WS_HMOE), (const LAS int*)(F.lds + MISC_OFF + MS_START)};
        pg8::gemm_phase<EpiH, MoeSched1>(F.lds, 1024, S, E);
    } SEAM(9);
    if (IN(10)) {
        moe_tables(F);
        MoeSched2 S; S.ord = MoeOrder{(const LAS int*)(F.lds + MISC_OFF + MS_CNT), (const LAS int*)(F.lds + MISC_OFF + MS_START), (const LAS int*)(F.lds + MISC_OFF + MS_TSTART), F.G, (int)blockIdx.x};
        S.H = (const char*)(F.ws + WS_HMOE); S.W2 = (const char*)(F.ws + WS_W2);
        EpiY E{(bf16*)(F.ws + WS_YMOE), (const LAS int*)(F.lds + MISC_OFF + MS_START)};
        pg8::gemm_phase<EpiY, MoeSched2>(F.lds, 512, S, E);
    } SEAM(10);
    if (IN(11)) { moe_tables(F); p11_final(F, args); }
#undef IN
#undef SEAM
}

extern "C" void kernel_launch(void* const* d_in, const int* in_sizes, int n_in, void* d_out, int out_size, void* d_ws, size_t ws_size, hipStream_t stream) {
    static int grid = 0;
    if (grid == 0) {
        if (n_in != 24 || out_size != ML_ROWS * DM || ws_size < WS_END) { fprintf(stderr, "kernel_launch: unexpected shapes (n_in %d out %d ws %zu)\n", n_in, out_size, ws_size); grid = -1; return; }
        int dev = 0, cus = 0, per_cu = 0;
        if (hipGetDevice(&dev) != hipSuccess || hipDeviceGetAttribute(&cus, hipDeviceAttributeMultiprocessorCount, dev) != hipSuccess) { grid = -1; return; }
        if (hipFuncSetAttribute((const void*)mk_fwd, hipFuncAttributeMaxDynamicSharedMemorySize, LDS_BYTES) != hipSuccess) { fprintf(stderr, "kernel_launch: hipFuncSetAttribute failed\n"); grid = -1; return; }
        if (hipOccupancyMaxActiveBlocksPerMultiprocessor(&per_cu, (const void*)mk_fwd, 512, LDS_BYTES) != hipSuccess || per_cu < 1) fprintf(stderr, "kernel_launch: occupancy query says %d\n", per_cu);
        (void)hipGetLastError();
        grid = cus;
    }
    if (grid < 0) return;
    if (hipMemsetAsync((char*)d_ws + WS_CTL, 0, CTL_ZERO_BYTES, stream) != hipSuccess) return;
    Args a{};
    for (int i = 0; i < 24; ++i) a.in[i] = (const float*)d_in[i];
    a.out = (float*)d_out; a.ws = (unsigned char*)d_ws;
    if (MK_N_LAUNCHES == 1) { a.ph_lo = 0; a.ph_hi = NPHASE; a.li = 0; hipLaunchKernelGGL(mk_fwd, dim3(grid), dim3(512), LDS_BYTES, stream, a); }
    else for (int p = 0; p < NPHASE; ++p) { a.ph_lo = p; a.ph_hi = p + 1; a.li = p; hipLaunchKernelGGL(mk_fwd, dim3(grid), dim3(512), LDS_BYTES, stream, a); }
}
```

```cpp
#include <hip/hip_runtime.h>
#include <cstdio>
#include <cstdint>

#ifndef MK_N_LAUNCHES
#define MK_N_LAUNCHES 1
#endif
#ifndef PROBE_DBL
#define PROBE_DBL -1
#endif

#define GAS __attribute__((address_space(1)))
#define LAS __attribute__((address_space(3)))
typedef unsigned short bf16;
typedef short bf16x8 __attribute__((ext_vector_type(8)));
typedef short bf16x4 __attribute__((ext_vector_type(4)));
typedef float f32x4 __attribute__((ext_vector_type(4)));
typedef float f32x2 __attribute__((ext_vector_type(2)));
typedef unsigned u32x4 __attribute__((ext_vector_type(4)));
typedef unsigned u32x2 __attribute__((ext_vector_type(2)));

constexpr int NB = 8, SEQ = 8192, DM = 1024, CTXL = 256;
constexpr int ML_ROWS = NB * SEQ, MC_ROWS = NB * CTXL, MT = ML_ROWS + MC_ROWS;
constexpr int IN_COLS = 3600, NZ = 3840;
constexpr int NEXP = 64, EH = 512;
constexpr float LN_EPS = 1e-5f;
constexpr float DN_ALPHA = 1.189207115002721f;
constexpr int NPHASE = 12;

constexpr size_t MiB = 1u << 20;
constexpr size_t WS_CTL = 0, CTL_ZERO_BYTES = 1 * MiB;
constexpr size_t WS_WIN = 1 * MiB;
constexpr size_t WS_WOUT = 9 * MiB;
constexpr size_t WS_W13 = 11 * MiB;
constexpr size_t WS_W2 = 139 * MiB;
constexpr size_t WS_ADA = 203 * MiB;
constexpr size_t WS_ROPE = 204 * MiB;
constexpr size_t WS_WR = 204 * MiB + 512 * 1024;
constexpr size_t WS_GATES = 205 * MiB;
constexpr size_t WS_TOKL = 210 * MiB;
constexpr size_t WS_ROUTE = 226 * MiB;
constexpr size_t WS_MLST = 227 * MiB;
constexpr int REC_FLOATS = 18688;
constexpr size_t WS_ZA = 270 * MiB;
constexpr size_t WS_ZQK = 468 * MiB;
constexpr size_t WS_ZV = 600 * MiB;
constexpr size_t WS_ZO = 666 * MiB;
constexpr size_t WS_XM = 732 * MiB;
constexpr size_t WS_MIX = 864 * MiB;
constexpr size_t WS_HB = 270 * MiB;
constexpr size_t WS_Y1 = 270 * MiB;
constexpr size_t WS_HMOE = 526 * MiB;
constexpr size_t WS_XM2 = 655 * MiB;
constexpr size_t WS_YMOE = 655 * MiB;
constexpr size_t WS_END = 992 * MiB;
static_assert(WS_MLST + (size_t)64 * 9 * REC_FLOATS * 4 <= WS_ZA, "ws map");
static_assert(WS_YMOE + (size_t)(131072 + 256) * 1024 * 2 <= WS_END, "ws map");
constexpr int CW_TMO = 0;
constexpr int CW_BAR = 4096;
constexpr int CW_CNT = 16384;

constexpr int PH_BYTES = 155648;
constexpr int MISC_OFF = PH_BYTES;
constexpr int LDS_BYTES = PH_BYTES + 4096;
constexpr int MS_TSTART = 64;
constexpr int MS_CNT = 384;
constexpr int MS_START = 704;
constexpr int MS_HIST = 1024;
constexpr int MS_BASE = 1280;

#define LDS_WAIT() asm volatile("s_waitcnt lgkmcnt(0)" ::: "memory")
#define VM_WAIT() asm volatile("s_waitcnt vmcnt(0)" ::: "memory")
#define RLX_AGENT __ATOMIC_RELAXED, __HIP_MEMORY_SCOPE_AGENT

__device__ __forceinline__ unsigned cvt_pk_bf16(float lo, float hi) { unsigned r; asm volatile("v_cvt_pk_bf16_f32 %0, %1, %2" : "=v"(r) : "v"(lo), "v"(hi)); return r; }
__device__ __forceinline__ float bf_lo(unsigned u) { return __builtin_bit_cast(float, u << 16); }
__device__ __forceinline__ float bf_hi(unsigned u) { return __builtin_bit_cast(float, u & 0xffff0000u); }
__device__ __forceinline__ float wave_sum(float v) {
#pragma unroll
    for (int o = 1; o < 64; o <<= 1) v += __shfl_xor(v, o);
    return v;
}
__device__ __forceinline__ bf16x4 tr_read(const LAS unsigned char* p) { return __builtin_amdgcn_ds_read_tr16_b64_v4i16((LAS bf16x4*)p); }
__device__ __forceinline__ bf16x8 cat4(bf16x4 a, bf16x4 b) { return (bf16x8){a[0], a[1], a[2], a[3], b[0], b[1], b[2], b[3]}; }
__device__ __forceinline__ bf16x8 as_bf16x8(u32x4 v) { return __builtin_bit_cast(bf16x8, v); }

#define XB_TMO      128
#define XB_XCNT(j)  (256  + 64 * (j))
#define XB_XSUB(j)  (1280 + 64 * (j))
#define XB_XGEN(j)  (2304 + 64 * (j))
#define XB_TOP      3328
#define XB_TOPGEN   3392
#define XCD_BAR_WORDS 3456
#define XB_SPIN_CAP (1u << 18)
__device__ __forceinline__ unsigned xb_ld(unsigned* p)              { return __hip_atomic_load(p, __ATOMIC_RELAXED, __HIP_MEMORY_SCOPE_AGENT); }
__device__ __forceinline__ unsigned xb_add(unsigned* p, unsigned v) { return __hip_atomic_fetch_add(p, v, __ATOMIC_RELAXED, __HIP_MEMORY_SCOPE_AGENT); }
__device__ __forceinline__ unsigned xb_xcc_id() { return (unsigned)__builtin_amdgcn_s_getreg((3 << 11) | 20) & 0xFu; }
#define XB_SPIN(cond, bar) do { unsigned _sp = 0; while (cond) { __builtin_amdgcn_s_sleep(1); \
    if ((++_sp & 255u) == 0u) { if (xb_ld(&(bar)[XB_TMO])) break; if (_sp > XB_SPIN_CAP) { atomicAdd(&(bar)[XB_TMO], 1u); break; } } } } while (0)
struct XcdBarrier { unsigned* bar; unsigned x; volatile LAS unsigned* st; };
__device__ __forceinline__ XcdBarrier xcd_barrier_post(unsigned* bar, volatile LAS unsigned* st) {
    XcdBarrier b; b.bar = bar; b.x = xb_xcc_id(); b.st = st;
    if (threadIdx.x == 0) (void)xb_add(&bar[XB_XCNT(b.x)], 1u);
    return b;
}
__device__ __forceinline__ void xcd_barrier_complete(unsigned* bar, unsigned x, unsigned& nloc, unsigned& nx) {
    const unsigned G = gridDim.x * gridDim.y * gridDim.z;
    unsigned sum, cnt, mine, sp = 0u;
    for (;;) {
        sum = 0u; cnt = 0u; mine = 0u;
#pragma unroll
        for (unsigned j = 0; j < 16; ++j) { const unsigned c = xb_ld(&bar[XB_XCNT(j)]); sum += c; cnt += (c > 0u) ? 1u : 0u; mine = (j == x) ? c : mine; }
        if (sum == G) break;
        __builtin_amdgcn_s_sleep(1);
        if ((++sp & 255u) == 0u) { if (xb_ld(&bar[XB_TMO])) break; if (sp > XB_SPIN_CAP) { atomicAdd(&bar[XB_TMO], 1u); break; } }
    }
    nloc = mine > 0u ? mine : 1u; nx = cnt > 0u ? cnt : 1u;
}
__device__ __forceinline__ void xcd_barrier(const XcdBarrier& b) {
    asm volatile("s_waitcnt vmcnt(0)" ::: "memory");
    __syncthreads();
    if (threadIdx.x == 0) {
        unsigned* bar = b.bar;
        __builtin_amdgcn_s_waitcnt(0);
        unsigned nloc = b.st[0], nx = b.st[1];
        if (nloc == 0u) { xcd_barrier_complete(bar, b.x, nloc, nx); b.st[0] = nloc; b.st[1] = nx; }
        const unsigned old = xb_add(&bar[XB_XSUB(b.x)], 1u);
        const unsigned gen = old / nloc;
        if (old + 1u == (gen + 1u) * nloc) {
            __builtin_amdgcn_fence(__ATOMIC_RELEASE, "agent");
            asm volatile("s_waitcnt vmcnt(0)" ::: "memory");
            const unsigned og = xb_add(&bar[XB_TOP], 1u);
            const unsigned tg = og / nx;
            if (og + 1u == (tg + 1u) * nx) xb_add(&bar[XB_TOPGEN], 1u);
            else XB_SPIN(xb_ld(&bar[XB_TOPGEN]) == tg, bar);
            __builtin_amdgcn_fence(__ATOMIC_ACQUIRE, "agent");
            xb_add(&bar[XB_XGEN(b.x)], 1u);
            asm volatile("s_waitcnt vmcnt(0)" ::: "memory");
        } else {
            XB_SPIN(xb_ld(&bar[XB_XGEN(b.x)]) == gen, bar);
            __builtin_amdgcn_fence(__ATOMIC_ACQUIRE, "agent");
            asm volatile("s_waitcnt vmcnt(0)" ::: "memory");
        }
    }
    __syncthreads();
}

namespace pg8 {
constexpr int BM = 256, BK = 64, HALF = 128, HTB = HALF * BK * 2, STAGE_BYTES = 8 * HTB, NXCD = 8, WGM = 8;
__host__ __device__ __forceinline__ int lds_byte(int r, int c) { const int st = (r >> 4) * 2 + (c >> 5), rr = r & 15, cc = c & 31, ob = rr * 64 + cc * 2; return st * 1024 + (ob ^ (((ob >> 9) & 1) << 5)); }
__host__ __device__ __forceinline__ void stage_rc(int b, int& R, int& C) { const int st = b / 1024, sb = b % 1024, swz = sb ^ (((sb >> 9) & 1) << 5); R = (st >> 1) * 16 + swz / 64; C = (st & 1) * 32 + (swz % 64) / 2; }
__host__ __device__ __forceinline__ int perm32(int rho) { const int n = rho >> 4, i = rho & 15; return 8 * (i >> 2) + 4 * n + (i & 3); }

struct Unit { int pm, pn, e, cnt; };

struct StaticOrder {
    int nM, nN, nwg, G, c;
    __device__ void init(int M, int N, int G_, int c_) { nM = M / BM; nN = N / BM; nwg = nM * nN; G = G_; c = c_; }
    __device__ bool next(int i, Unit& u) const {
        const long L = (long)i * G + c; if (L >= nwg) return false;
        int wgid = (int)L; { const int q = nwg / NXCD, r = nwg % NXCD, xcd = wgid % NXCD, off = wgid / NXCD; wgid = (xcd < r ? xcd * (q + 1) : r * (q + 1) + (xcd - r) * q) + off; }
        const int nig = WGM * nN, gid = wgid / nig, fm = gid * WGM, gsz = (nM - fm) < WGM ? (nM - fm) : WGM;
        u.pm = fm + ((wgid % nig) % gsz); u.pn = (wgid % nig) / gsz; u.e = 0; u.cnt = 256; return true;
    }
};
struct DenseSched {
    static constexpr bool GATHER = false;
    const char* A; const char* Bt; int K; StaticOrder ord;
    __device__ __forceinline__ bool next(int i, Unit& u) const { return ord.next(i, u); }
    __device__ __forceinline__ const char* a_ptr(const Unit& u) const { return A + (size_t)u.pm * BM * K * 2; }
    __device__ __forceinline__ const char* b_ptr(const Unit& u) const { return Bt + (size_t)u.pn * BM * K * 2; }
    __device__ __forceinline__ void a_voff(const Unit&, unsigned (&)[2][2], int, int, int, int) const {}
};

template <class Epi, class Sched, bool ALIGN_EPI = true>
__device__ __forceinline__ void gemm_phase(LAS unsigned char* lds, const int K, const Sched& S, const Epi& E) {
    const int tid = threadIdx.x, wid = __builtin_amdgcn_readfirstlane(tid >> 6), lane = tid & 63, wr = wid >> 2, wc = wid & 3, fr = lane & 15, fq = lane >> 4;
    const int nt = K / BK;
    unsigned voffA[2], voffB[2]; int RA[2], CA[2];
#pragma unroll
    for (int i = 0; i < 2; ++i) { int R, C; stage_rc(tid * 16 + i * 8192, R, C); const int Rb = Epi::PERM ? ((R & ~31) + perm32(R & 31)) : R;
        RA[i] = R; CA[i] = C; voffA[i] = (unsigned)(R * K + C) * 2u; voffB[i] = (unsigned)(Rb * K + C) * 2u; }
    const size_t kstep = (size_t)(BK * 2);
    const size_t hstep = (size_t)HALF * K * 2;
    const unsigned ldsw = (unsigned)wid * 1024u;
    const int aoff = lds_byte(wr * 64 + fr, fq * 8), boff = lds_byte(wc * 32 + fr, fq * 8);
#define PG8_SA(b, h) (((b) * 2 + (h)) * HTB)
#define PG8_SB(b, h) ((4 + (b) * 2 + (h)) * HTB)
#define PG8_STAGE(bufoff, gbase, voff) do { _Pragma("unroll") for (int _i = 0; _i < 2; ++_i) \
        __builtin_amdgcn_global_load_lds((const unsigned*)((const char*)(gbase) + (voff)[_i]), (LAS unsigned*)(lds + (bufoff) + ldsw + _i * 8192), 16, 0, 0); } while (0)
#define PG8_STAGE_A(b, h, ptr, gv) do { if constexpr (Sched::GATHER) { PG8_STAGE(PG8_SA(b, h), ptr, gv[h]); } else { PG8_STAGE(PG8_SA(b, h), (ptr) + ((h) ? hstep : 0), voffA); } } while (0)
#define PG8_LDA(dst, b, h) do { _Pragma("unroll") for (int m = 0; m < 4; ++m) _Pragma("unroll") for (int k = 0; k < 2; ++k) dst[m][k] = *(const LAS bf16x8*)(lds + PG8_SA(b, h) + aoff + m * 2048 + k * 1024); } while (0)
#define PG8_LDB(dst, b, h) do { _Pragma("unroll") for (int n = 0; n < 2; ++n) _Pragma("unroll") for (int k = 0; k < 2; ++k) dst[n][k] = *(const LAS bf16x8*)(lds + PG8_SB(b, h) + boff + n * 2048 + k * 1024); } while (0)
#define PG8_MMA(ai, bj, At, Bt) do { __builtin_amdgcn_s_setprio(1); _Pragma("unroll") for (int m = 0; m < 4; ++m) _Pragma("unroll") for (int n = 0; n < 2; ++n) _Pragma("unroll") for (int k = 0; k < 2; ++k) \
        acc[ai][bj][m][n] = __builtin_amdgcn_mfma_f32_16x16x32_bf16(Bt[n][k], At[m][k], acc[ai][bj][m][n], 0, 0, 0); __builtin_amdgcn_s_setprio(0); } while (0)
#define PG8_WAIT_V(n) asm volatile("s_waitcnt vmcnt(" #n ")" ::: "memory")
#define PG8_WAIT_L(n) asm volatile("s_waitcnt lgkmcnt(" #n ")" ::: "memory")
#define PG8_BAR __builtin_amdgcn_s_barrier()
#define PG8_SCHED __builtin_amdgcn_sched_barrier(0)
    Unit cur, nxt; int ui = 0;
    if (!S.next(0, cur)) return;
    f32x4 acc[2][2][4][2];
#pragma unroll
    for (int a = 0; a < 2; ++a)
#pragma unroll
        for (int b = 0; b < 2; ++b)
#pragma unroll
            for (int m = 0; m < 4; ++m)
#pragma unroll
                for (int n = 0; n < 2; ++n) acc[a][b][m][n] = (f32x4){0.f, 0.f, 0.f, 0.f};
    bf16x8 At[4][2], B0[2][2], B1[2][2];
    unsigned cv[2][2], nv[2][2];
    const char* cA = S.a_ptr(cur); const char* cB = S.b_ptr(cur);
    if constexpr (Sched::GATHER) { S.a_voff(cur, cv, RA[0], RA[1], CA[0], CA[1]);
#pragma unroll
        for (int h = 0; h < 2; ++h)
#pragma unroll
            for (int i = 0; i < 2; ++i) nv[h][i] = cv[h][i]; }
    PG8_STAGE(PG8_SB(0, 0), cB, voffB); PG8_STAGE(PG8_SB(0, 1), cB + hstep, voffB); PG8_STAGE_A(0, 0, cA, cv); PG8_STAGE_A(0, 1, cA, cv);
    if (wr == 1) PG8_BAR;
    PG8_WAIT_V(2); PG8_BAR;
    PG8_STAGE(PG8_SB(1, 0), cB + kstep, voffB); PG8_STAGE_A(1, 0, cA + kstep, cv); PG8_STAGE(PG8_SB(1, 1), cB + hstep + kstep, voffB);
    PG8_WAIT_V(6); PG8_BAR;
    for (;;) {
        const bool has_next = S.next(ui + 1, nxt);
        const char* nA = has_next ? S.a_ptr(nxt) : cA; const char* nB = has_next ? S.b_ptr(nxt) : cB;
        if constexpr (Sched::GATHER) { if (has_next) S.a_voff(nxt, nv, RA[0], RA[1], CA[0], CA[1]); }
        for (int t = 0; t < nt; t += 2) {
            const bool last = (t == nt - 2);
            const char* a1 = cA + (size_t)(t + 1) * kstep;
            const char* a2 = last ? nA : cA + (size_t)(t + 2) * kstep; const char* b2 = last ? nB : cB + (size_t)(t + 2) * kstep;
            const char* a3 = a2 + kstep; const char* b3 = b2 + kstep;
            unsigned v2[2][2];
            if constexpr (Sched::GATHER) {
#pragma unroll
                for (int h = 0; h < 2; ++h)
#pragma unroll
                    for (int i = 0; i < 2; ++i) v2[h][i] = last ? nv[h][i] : cv[h][i]; }
            PG8_LDB(B0, 0, 0); PG8_LDB(B1, 0, 1); PG8_SCHED; PG8_LDA(At, 0, 0); PG8_STAGE_A(1, 1, a1, cv);
            PG8_WAIT_V(8); PG8_WAIT_L(0); PG8_BAR; PG8_MMA(0, 0, At, B0); PG8_MMA(0, 1, At, B1); PG8_BAR; PG8_SCHED;
            PG8_LDA(At, 0, 1); PG8_STAGE(PG8_SB(0, 0), b2, voffB); PG8_STAGE(PG8_SB(0, 1), b2 + hstep, voffB); PG8_STAGE_A(0, 0, a2, v2);
            PG8_WAIT_V(8); PG8_WAIT_L(0); PG8_BAR; PG8_MMA(1, 0, At, B0); PG8_MMA(1, 1, At, B1); PG8_BAR; PG8_SCHED;
            PG8_LDB(B0, 1, 0); PG8_LDB(B1, 1, 1); PG8_SCHED; PG8_LDA(At, 1, 0); PG8_STAGE_A(0, 1, a2, v2);
            PG8_WAIT_V(8); PG8_WAIT_L(0); PG8_BAR; PG8_MMA(0, 0, At, B0); PG8_MMA(0, 1, At, B1); PG8_BAR; PG8_SCHED;
            PG8_LDA(At, 1, 1); PG8_STAGE(PG8_SB(1, 0), b3, voffB); PG8_STAGE(PG8_SB(1, 1), b3 + hstep, voffB); PG8_STAGE_A(1, 0, a3, v2);
            PG8_WAIT_V(8); PG8_WAIT_L(0); PG8_BAR; PG8_MMA(1, 0, At, B0); PG8_MMA(1, 1, At, B1); PG8_BAR; PG8_SCHED;
        }
        if constexpr (ALIGN_EPI) { if (wr == 0) PG8_BAR; }
        E(acc, cur, wr, wc, fr, fq);
        if (!has_next) break;
#pragma unroll
        for (int a = 0; a < 2; ++a)
#pragma unroll
            for (int b = 0; b < 2; ++b)
#pragma unroll
                for (int m = 0; m < 4; ++m)
#pragma unroll
                    for (int n = 0; n < 2; ++n) acc[a][b][m][n] = (f32x4){0.f, 0.f, 0.f, 0.f};
        cur = nxt; cA = nA; cB = nB; ++ui;
        if constexpr (Sched::GATHER) {
#pragma unroll
            for (int h = 0; h < 2; ++h)
#pragma unroll
                for (int i = 0; i < 2; ++i) cv[h][i] = nv[h][i]; }
        if constexpr (ALIGN_EPI) { if (wr == 1) PG8_BAR; }
    }
    PG8_WAIT_V(0);
    if constexpr (!ALIGN_EPI) { if (wr == 0) PG8_BAR; }
    PG8_BAR;
#undef PG8_SA
#undef PG8_SB
#undef PG8_STAGE
#undef PG8_STAGE_A
#undef PG8_LDA
#undef PG8_LDB
#undef PG8_MMA
#undef PG8_WAIT_V
#undef PG8_WAIT_L
#undef PG8_BAR
#undef PG8_SCHED
}
}

struct Args { const float* in[24]; float* out; unsigned char* ws; int ph_lo, ph_hi, li, pad; };
struct Frame {
    LAS unsigned char* lds;
    unsigned* ctl;
    int tid, lane, wave, vcu, G;
    unsigned char* ws;
};

__device__ __forceinline__ int rowmap(int mode, int n) { return mode == 0 ? n : ((n >> 7) * 256 + (n & 127) + (mode == 2 ? 128 : 0)); }
__device__ __forceinline__ void p0_transpose_item(const float* W, int K, int N, bf16* WT, int mode, LAS float* scr, int item, int lane) {
    const int nblk = (N + 31) / 32, kb = item / nblk, nb = item % nblk, k0 = 64 * kb, n0 = 32 * nb;
    const int nn = n0 + (lane & 31); const bool ok = nn < N;
#pragma unroll 8
    for (int i = 0; i < 32; ++i) { const int kk = 2 * i + (lane >> 5); scr[kk * 33 + (lane & 31)] = ok ? W[(size_t)(k0 + kk) * N + nn] : 0.f; }
    LDS_WAIT(); asm volatile("" ::: "memory");
    const int c = lane & 7;
#pragma unroll
    for (int j = 0; j < 4; ++j) { const int n = (lane >> 3) + 8 * j; const LAS float* s = scr + (8 * c) * 33 + n;
        u32x4 o; o.x = cvt_pk_bf16(s[0 * 33], s[1 * 33]); o.y = cvt_pk_bf16(s[2 * 33], s[3 * 33]); o.z = cvt_pk_bf16(s[4 * 33], s[5 * 33]); o.w = cvt_pk_bf16(s[6 * 33], s[7 * 33]);
        if (n0 + n < N) *(u32x4*)(WT + (size_t)rowmap(mode, n0 + n) * K + k0 + 8 * c) = o; }
    LDS_WAIT(); asm volatile("" ::: "memory");
}
__device__ __forceinline__ void p0_prologue(Frame& F, const Args& a) {
    const int gw = F.vcu * 8 + F.wave, NGW = F.G * 8, lane = F.lane, tid = F.tid;
    float* ada = (float*)(F.ws + WS_ADA);
    {
        LAS float* sS = (LAS float*)F.lds;
        LAS float* sP = (LAS float*)(F.lds + 36864);
        bool staged = false;
        for (int it = blockIdx.x; it < 192; it += F.G) {
            if (!staged) {
                for (int i = tid; i < 9 * 1024; i += 512) { const int r = i >> 10, k = i & 1023; const float v = r < 8 ? a.in[1][r * 1024 + k] : a.in[3][k]; sS[i] = v / (1.f + __expf(-v)); }
                staged = true;
            }
            __syncthreads();
            const int n = it * 32 + (lane & 31), kh = lane >> 5, kb = F.wave * 128;
            float acc[9];
#pragma unroll
            for (int r = 0; r < 9; ++r) acc[r] = 0.f;
            const float* W = a.in[4];
#pragma unroll 4
            for (int j = 0; j < 64; ++j) { const int k = kb + 2 * j + kh; const float w = W[(size_t)k * 6144 + n];
#pragma unroll
                for (int r = 0; r < 9; ++r) acc[r] += sS[r * 1024 + k] * w; }
#pragma unroll
            for (int r = 0; r < 9; ++r) { acc[r] += __shfl_xor(acc[r], 32); if (lane < 32) sP[(F.wave * 9 + r) * 32 + lane] = acc[r]; }
            __syncthreads();
            if (tid < 288) { const int r = tid >> 5, c = tid & 31; float s = a.in[5][it * 32 + c];
#pragma unroll
                for (int w = 0; w < 8; ++w) s += sP[(w * 9 + r) * 32 + c];
                ada[r * 6144 + it * 32 + c] = s; }
        }
        __syncthreads();
    }
    { float* rope = (float*)(F.ws + WS_ROPE);
      for (int i = blockIdx.x * 512 + tid; i < 128 * 32; i += F.G * 512) { const int pos = i >> 5, j = i & 31; const double ang = (double)pos * pow(10000.0, -(double)j / 32.0);
          rope[2 * i] = (float)cos(ang); rope[2 * i + 1] = (float)sin(ang); } }
    { bf16* wr = (bf16*)(F.ws + WS_WR);
      for (int i = blockIdx.x * 512 + tid; i < 80 * 1024; i += F.G * 512) { const int r = i >> 10, k = i & 1023; float v = 0.f;
          if (r < 8) v = a.in[15][k * 8 + r]; else if (r >= 16) v = a.in[17][k * 64 + (r - 16)];
          wr[i] = (bf16)(cvt_pk_bf16(v, 0.f) & 0xffffu); } }
    { u32x4* z = (u32x4*)((bf16*)(F.ws + WS_WIN) + (size_t)IN_COLS * 1024);
      for (int i = blockIdx.x * 512 + tid; i < (NZ - IN_COLS) * 1024 / 8; i += F.G * 512) z[i] = (u32x4){0u, 0u, 0u, 0u}; }
    LAS float* scr = (LAS float*)(F.lds + 49152 + F.wave * 8448);
    constexpr int I_IN = 16 * 113, I_OUT = 16 * 32, I_E = 256;
    constexpr int NITEMS = I_IN + I_OUT + 3 * NEXP * I_E;
    for (int it = gw; it < NITEMS; it += NGW) {
        int r = it;
        if (r < I_IN) { p0_transpose_item(a.in[6], 1024, IN_COLS, (bf16*)(F.ws + WS_WIN), 0, scr, r, lane); continue; } r -= I_IN;
        if (r < I_OUT) { p0_transpose_item(a.in[12], 1024, 1024, (bf16*)(F.ws + WS_WOUT), 0, scr, r, lane); continue; } r -= I_OUT;
        if (r < NEXP * I_E) { const int e = r >> 8; p0_transpose_item(a.in[19] + (size_t)e * 1024 * 512, 1024, 512, (bf16*)(F.ws + WS_W13) + (size_t)e * 1024 * 1024, 1, scr, r & 255, lane); continue; } r -= NEXP * I_E;
        if (r < NEXP * I_E) { const int e = r >> 8; p0_transpose_item(a.in[20] + (size_t)e * 1024 * 512, 1024, 512, (bf16*)(F.ws + WS_W13) + (size_t)e * 1024 * 1024, 2, scr, r & 255, lane); continue; } r -= NEXP * I_E;
        { const int e = r >> 8; p0_transpose_item(a.in[21] + (size_t)e * 512 * 1024, 512, 1024, (bf16*)(F.ws + WS_W2) + (size_t)e * 1024 * 512, 0, scr, r & 255, lane); }
    }
}

__device__ __forceinline__ void p1_ln_mod(Frame& F, const Args& a) {
    const int gw = F.vcu * 8 + F.wave, NGW = F.G * 8, lane = F.lane;
    const float* ada = (const float*)(F.ws + WS_ADA);
    bf16* XM = (bf16*)(F.ws + WS_XM);
    for (int m = gw; m < MT; m += NGW) {
        const float* xrow = m < ML_ROWS ? a.in[0] + (size_t)m * DM : a.in[2] + (size_t)(m - ML_ROWS) * DM;
        const int ab = m < ML_ROWS ? (m >> 13) : 8;
        const f32x4* xr = (const f32x4*)xrow + lane;
        const f32x4* sh = (const f32x4*)(ada + ab * 6144) + lane; const f32x4* sc = sh + 256;
        f32x4 v[4]; float s = 0.f;
#pragma unroll
        for (int j = 0; j < 4; ++j) { v[j] = xr[64 * j]; s += (v[j].x + v[j].y) + (v[j].z + v[j].w); }
        const float mean = wave_sum(s) * (1.f / DM); float s2 = 0.f;
#pragma unroll
        for (int j = 0; j < 4; ++j) { v[j] = v[j] - mean; s2 += (v[j].x * v[j].x + v[j].y * v[j].y) + (v[j].z * v[j].z + v[j].w * v[j].w); }
        const float rstd = 1.f / sqrtf(wave_sum(s2) * (1.f / DM) + LN_EPS);
        u32x2* o8 = (u32x2*)(XM + (size_t)m * DM) + lane;
#pragma unroll
        for (int j = 0; j < 4; ++j) { const f32x4 h = sh[64 * j], c = sc[64 * j]; const f32x4 y = (v[j] * rstd) * (c + 1.f) + h;
            o8[64 * j] = (u32x2){cvt_pk_bf16(y.x, y.y), cvt_pk_bf16(y.z, y.w)}; }
    }
}

struct EpiZ {
    static constexpr bool PERM = true;
    unsigned char* ws; const float* gate_b;
    __device__ __forceinline__ void operator()(const f32x4 (&acc)[2][2][4][2], const pg8::Unit& u, int wr, int wc, int fr, int fq) const {
        const int row0 = u.pm * 256 + wr * 64 + fr;
        if (u.pn < 14) {
            bf16* base; int ldc, colt;
            if (u.pn < 6) { base = (bf16*)(ws + WS_ZA); ldc = 1536; colt = u.pn * 256; }
            else if (u.pn < 10) { base = (bf16*)(ws + WS_ZQK); ldc = 1024; colt = (u.pn - 6) * 256; }
            else if (u.pn < 12) { base = (bf16*)(ws + WS_ZV); ldc = 512; colt = (u.pn - 10) * 256; }
            else { base = (bf16*)(ws + WS_ZO); ldc = 512; colt = (u.pn - 12) * 256; }
            const int col0 = colt + wc * 32 + 8 * fq;
#pragma unroll
            for (int ai = 0; ai < 2; ++ai)
#pragma unroll
                for (int m = 0; m < 4; ++m) { bf16* rowp = base + (size_t)(row0 + ai * 128 + m * 16) * ldc + col0;
#pragma unroll
                    for (int bj = 0; bj < 2; ++bj) { const f32x4 v0 = acc[ai][bj][m][0], v1 = acc[ai][bj][m][1];
                        u32x4 w; w.x = cvt_pk_bf16(v0[0], v0[1]); w.y = cvt_pk_bf16(v0[2], v0[3]); w.z = cvt_pk_bf16(v1[0], v1[1]); w.w = cvt_pk_bf16(v1[2], v1[3]);
                        *(u32x4*)(rowp + bj * 128) = w; } }
        } else if (wc == 0 && fq < 2) {
            float* G = (float*)(ws + WS_GATES);
            const f32x4 b0 = *(const f32x4*)(gate_b + 8 * fq), b1 = *(const f32x4*)(gate_b + 8 * fq + 4);
#pragma unroll
            for (int ai = 0; ai < 2; ++ai)
#pragma unroll
                for (int m = 0; m < 4; ++m) { float* rowp = G + (size_t)(row0 + ai * 128 + m * 16) * 16 + 8 * fq;
                    *(f32x4*)rowp = acc[ai][0][m][0] + b0; *(f32x4*)(rowp + 4) = acc[ai][0][m][1] + b1; }
        }
    }
};

__device__ __forceinline__ void p3_qkprep(Frame& F, const Args& a) {
    const int gw = F.vcu * 8 + F.wave, NGW = F.G * 8, lane = F.lane;
    const bf16* ZQK = (const bf16*)(F.ws + WS_ZQK); bf16* QKP = (bf16*)(F.ws + WS_XM);
    const float* rope = (const float*)(F.ws + WS_ROPE);
    const int blk = lane >> 2, i0 = (lane & 3) * 8, cA = blk * 64 + i0, cB = cA + 32;
    const bool is_k = blk >= 8, col_rot = (blk & 1) != 0;
    float wA[5][8], wB[5][8], bA[8], bB[8];
#pragma unroll
    for (int j = 0; j < 5; ++j)
#pragma unroll
        for (int e = 0; e < 8; ++e) { wA[j][e] = a.in[7][j * 1024 + cA + e]; wB[j][e] = a.in[7][j * 1024 + cB + e]; }
#pragma unroll
    for (int e = 0; e < 8; ++e) { bA[e] = a.in[8][cA + e]; bB[e] = a.in[8][cB + e]; }
    constexpr int RUN = 16, NITEM = MT / RUN;
    for (int it = gw; it < NITEM; it += NGW) {
        const int row0 = it * RUN;
        const bool lat = row0 < ML_ROWS;
        const int T = lat ? SEQ : CTXL, s0 = lat ? (row0 & (SEQ - 1)) : ((row0 - ML_ROWS) & (CTXL - 1));
        u32x4 winA[5], winB[5];
#pragma unroll
        for (int j = 0; j < 4; ++j) { const int s = s0 + j - 2; const bool ok = s >= 0 && s < T; const bf16* p = ZQK + (size_t)(row0 + j - 2) * 1024;
            winA[j + 1] = ok ? *(const u32x4*)(p + cA) : (u32x4){0u, 0u, 0u, 0u}; winB[j + 1] = ok ? *(const u32x4*)(p + cB) : (u32x4){0u, 0u, 0u, 0u}; }
#pragma unroll
        for (int r = 0; r < RUN; ++r) {
#pragma unroll
            for (int j = 0; j < 4; ++j) { winA[j] = winA[j + 1]; winB[j] = winB[j + 1]; }
            { const int s = s0 + r + 2; const bool ok = s < T; const bf16* p = ZQK + (size_t)(row0 + r + 2) * 1024;
              winA[4] = ok ? *(const u32x4*)(p + cA) : (u32x4){0u, 0u, 0u, 0u}; winB[4] = ok ? *(const u32x4*)(p + cB) : (u32x4){0u, 0u, 0u, 0u}; }
            float uA[8], uB[8];
#pragma unroll
            for (int e = 0; e < 8; ++e) { uA[e] = bA[e]; uB[e] = bB[e]; }
#pragma unroll
            for (int j = 0; j < 5; ++j)
#pragma unroll
                for (int q = 0; q < 4; ++q) { const unsigned xa = winA[j][q], xb = winB[j][q];
                    uA[2 * q] += wA[j][2 * q] * bf_lo(xa); uA[2 * q + 1] += wA[j][2 * q + 1] * bf_hi(xa);
                    uB[2 * q] += wB[j][2 * q] * bf_lo(xb); uB[2 * q + 1] += wB[j][2 * q + 1] * bf_hi(xb); }
#pragma unroll
            for (int e = 0; e < 8; ++e) { uA[e] = uA[e] / (1.f + __expf(-uA[e])); uB[e] = uB[e] / (1.f + __expf(-uB[e])); }
            if (lat) {
                const int s = s0 + r, pos = col_rot ? (s & 63) : (s >> 6);
                const f32x4* rp = (const f32x4*)(rope + (size_t)(pos * 32 + i0) * 2);
#pragma unroll
                for (int q = 0; q < 4; ++q) { const f32x4 cs = rp[q];
                    const float x1 = uA[2 * q], x2 = uB[2 * q], y1 = uA[2 * q + 1], y2 = uB[2 * q + 1];
                    uA[2 * q] = x1 * cs.x - x2 * cs.y; uB[2 * q] = x1 * cs.y + x2 * cs.x;
                    uA[2 * q + 1] = y1 * cs.z - y2 * cs.w; uB[2 * q + 1] = y1 * cs.w + y2 * cs.z; }
            }
            const float ksc = is_k ? 0.08838834764831845f : 1.f;
            u32x4 oA, oB;
#pragma unroll
            for (int q = 0; q < 4; ++q) { oA[q] = cvt_pk_bf16(uA[2 * q] * ksc, uA[2 * q + 1] * ksc); oB[q] = cvt_pk_bf16(uB[2 * q] * ksc, uB[2 * q + 1] * ksc); }
            bf16* o = QKP + (size_t)(row0 + r) * 1024;
            *(u32x4*)(o + cA) = oA; *(u32x4*)(o + cB) = oB;
        }
    }
}

constexpr int NA_VR = 0, NA_VC = 81920, NA_KC = 114688, NA_RPB = 147456;
static_assert(NA_RPB + 2048 <= PH_BYTES, "NA LDS");
__device__ __forceinline__ int na_r0(int r) { return r - 4 < 0 ? 0 : (r - 4 > 120 ? 120 : r - 4); }
__device__ __forceinline__ void p3_na(Frame& F, const Args& a) {
    const int w = F.wave, lane = F.lane, tid = F.tid, cg = w & 3, rsel = w >> 2, g = lane >> 4, lq = lane & 15, qp = lq >> 2, pp = lane & 3;
    const bf16* ZA = (const bf16*)(F.ws + WS_ZA); bf16* MIX = (bf16*)(F.ws + WS_MIX);
    LAS unsigned char* VR = F.lds + NA_VR; LAS unsigned char* VC = F.lds + NA_VC; LAS unsigned char* KC = F.lds + NA_KC; LAS float* RPB = (LAS float*)(F.lds + NA_RPB);
    const int cs = cg == 0 ? 0 : (cg == 1 ? 8 : (cg == 2 ? 24 : 32));
    const int qc = 16 * cg + lq, c0q = qc - 8 < 0 ? 0 : (qc - 8 > 48 ? 48 : qc - 8);
    const int sw = (4 * g + qp) & 7;
    unsigned voff[4], koff[2];
#pragma unroll
    for (int dt = 0; dt < 4; ++dt) voff[dt] = (unsigned)((((2 * dt + (pp >> 1)) ^ sw) * 16) + 8 * (pp & 1) + (4 * g + qp) * 128);
#pragma unroll
    for (int kk = 0; kk < 2; ++kk) koff[kk] = (unsigned)(lq * 128 + (((4 * kk + g) ^ ((lq >> 1) & 7)) * 16));
    unsigned cooff[2][4];
#pragma unroll
    for (int tt = 0; tt < 2; ++tt)
#pragma unroll
        for (int j = 0; j < 4; ++j) { const int kc = cs + 16 * tt + 4 * g + j; const bool valid = kc >= c0q && kc < c0q + 16; cooff[tt][j] = (unsigned)((valid ? kc - qc + 15 : 31) * 4); }
    const float CE = 0.125f * 1.4426950408889634f;
    const int sc = tid >> 3, sch = tid & 7;
    for (int su = blockIdx.x; su < 256; su += F.G) {
        const int bh = su >> 2, head = bh & 7, b = bh >> 3, R0 = (su & 3) * 32;
        __syncthreads();
#pragma unroll
        for (int i = 0; i < 4; ++i) { const int idx = tid + 512 * i, key = idx >> 3, ch = idx & 7; const bf16* src = ZA + ((size_t)(ML_ROWS + b * CTXL + key)) * 1536 + head * 64 + ch * 8;
            *(LAS u32x4*)(KC + key * 128 + ((ch ^ ((key >> 1) & 7)) * 16)) = *(const u32x4*)(src + 512);
            *(LAS u32x4*)(VC + key * 128 + ((ch ^ (key & 7)) * 16)) = *(const u32x4*)(src + 1024); }
        if (tid < 480) { const int rw = tid >> 5, co = tid & 31; RPB[tid] = co < 31 ? 8.f * a.in[10][head * 465 + rw * 31 + co] : -1e30f; }
        int hw = na_r0(R0); const int hi0 = na_r0(R0 + 1) + 8;
        for (int rho = hw; rho < hi0; ++rho) *(LAS u32x4*)(VR + ((rho % 10) * 64 + sc) * 128 + ((sch ^ (sc & 7)) * 16)) = *(const u32x4*)(ZA + ((size_t)(b * SEQ + rho * 64 + sc)) * 1536 + 1024 + head * 64 + sch * 8);
        hw = hi0;
        __syncthreads();
        for (int p = 0; p < 16; ++p) {
            const int ra = R0 + 2 * p, r = ra + rsel, r0 = na_r0(r);
            const int nhi = p < 15 ? na_r0(ra + 3) + 8 : hw, nnew = nhi - hw;
            u32x4 pre0 = (u32x4){0u, 0u, 0u, 0u}, pre1 = pre0;
            if (nnew > 0) pre0 = *(const u32x4*)(ZA + ((size_t)(b * SEQ + hw * 64 + sc)) * 1536 + 1024 + head * 64 + sch * 8);
            if (nnew > 1) pre1 = *(const u32x4*)(ZA + ((size_t)(b * SEQ + (hw + 1) * 64 + sc)) * 1536 + 1024 + head * 64 + sch * 8);
            const size_t qtok = (size_t)b * SEQ + r * 64 + qc;
            bf16x8 qf[2];
#pragma unroll
            for (int kk = 0; kk < 2; ++kk) qf[kk] = *(const bf16x8*)(ZA + qtok * 1536 + head * 64 + 32 * kk + 8 * g);
            f32x4 s[16], o[4];
#pragma unroll
            for (int dt = 0; dt < 4; ++dt) o[dt] = (f32x4){0.f, 0.f, 0.f, 0.f};
#pragma unroll
            for (int t = 0; t < 16; ++t) { f32x4 acc = (f32x4){0.f, 0.f, 0.f, 0.f};
#pragma unroll
                for (int kk = 0; kk < 2; ++kk) acc = __builtin_amdgcn_mfma_f32_16x16x32_bf16(*(const LAS bf16x8*)(KC + t * 2048 + koff[kk]), qf[kk], acc, 0, 0, 0);
                s[t] = acc; }
            float mx = -1e30f;
#pragma unroll
            for (int t = 0; t < 16; ++t) mx = fmaxf(mx, fmaxf(fmaxf(s[t][0], s[t][1]), fmaxf(s[t][2], s[t][3])));
            mx = fmaxf(mx, __shfl_xor(mx, 16)); mx = fmaxf(mx, __shfl_xor(mx, 32));
            float sum = 0.f;
            { const float nm = -mx * CE;
#pragma unroll
              for (int t = 0; t < 16; ++t)
#pragma unroll
                  for (int j = 0; j < 4; ++j) { const float pv = __builtin_amdgcn_exp2f(__builtin_fmaf(s[t][j], CE, nm)); s[t][j] = pv; sum += pv; } }
#pragma unroll
            for (int kp = 0; kp < 8; ++kp) {
                const bf16x8 pf = as_bf16x8((u32x4){cvt_pk_bf16(s[2 * kp][0], s[2 * kp][1]), cvt_pk_bf16(s[2 * kp][2], s[2 * kp][3]), cvt_pk_bf16(s[2 * kp + 1][0], s[2 * kp + 1][1]), cvt_pk_bf16(s[2 * kp + 1][2], s[2 * kp + 1][3])});
                const LAS unsigned char* vr = VC + kp * 4096;
#pragma unroll
                for (int dt = 0; dt < 4; ++dt) o[dt] = __builtin_amdgcn_mfma_f32_16x16x32_bf16(cat4(tr_read(vr + voff[dt]), tr_read(vr + 2048 + voff[dt])), pf, o[dt], 0, 0, 0);
            }
#pragma unroll
            for (int rr = 0; rr < 8; ++rr)
#pragma unroll
                for (int tt = 0; tt < 2; ++tt) {
                    const size_t ktok = (size_t)b * SEQ + (r0 + rr) * 64 + cs + 16 * tt + lq;
                    const bf16* kp = ZA + ktok * 1536 + 512 + head * 64 + 8 * g;
                    const bf16x8 k0 = *(const bf16x8*)kp, k1 = *(const bf16x8*)(kp + 32);
                    const LAS unsigned char* rb = (const LAS unsigned char*)RPB + (r0 + rr - r + 7) * 128;
                    f32x4 acc;
#pragma unroll
                    for (int j = 0; j < 4; ++j) acc[j] = *(const LAS float*)(rb + cooff[tt][j]);
                    acc = __builtin_amdgcn_mfma_f32_16x16x32_bf16(k0, qf[0], acc, 0, 0, 0);
                    acc = __builtin_amdgcn_mfma_f32_16x16x32_bf16(k1, qf[1], acc, 0, 0, 0);
                    s[rr * 2 + tt] = acc;
                }
            float m2 = -1e30f;
#pragma unroll
            for (int t = 0; t < 16; ++t) m2 = fmaxf(m2, fmaxf(fmaxf(s[t][0], s[t][1]), fmaxf(s[t][2], s[t][3])));
            m2 = fmaxf(m2, __shfl_xor(m2, 16)); m2 = fmaxf(m2, __shfl_xor(m2, 32));
            { const float M = fmaxf(mx, m2), al = __builtin_amdgcn_exp2f((mx - M) * CE), nm = -M * CE;
              sum *= al;
#pragma unroll
              for (int dt = 0; dt < 4; ++dt) o[dt] = o[dt] * al;
#pragma unroll
              for (int t = 0; t < 16; ++t)
#pragma unroll
                  for (int j = 0; j < 4; ++j) { const float pv = __builtin_amdgcn_exp2f(__builtin_fmaf(s[t][j], CE, nm)); s[t][j] = pv; sum += pv; } }
            { int slot = r0 % 10;
#pragma unroll
              for (int kp = 0; kp < 8; ++kp) {
                const bf16x8 pf = as_bf16x8((u32x4){cvt_pk_bf16(s[2 * kp][0], s[2 * kp][1]), cvt_pk_bf16(s[2 * kp][2], s[2 * kp][3]), cvt_pk_bf16(s[2 * kp + 1][0], s[2 * kp + 1][1]), cvt_pk_bf16(s[2 * kp + 1][2], s[2 * kp + 1][3])});
                const LAS unsigned char* vr = VR + (slot * 64 + cs) * 128;
#pragma unroll
                for (int dt = 0; dt < 4; ++dt) o[dt] = __builtin_amdgcn_mfma_f32_16x16x32_bf16(cat4(tr_read(vr + voff[dt]), tr_read(vr + 2048 + voff[dt])), pf, o[dt], 0, 0, 0);
                slot = slot == 9 ? 0 : slot + 1;
              } }
            sum += __shfl_xor(sum, 16); sum += __shfl_xor(sum, 32);
            { const float inv = 1.f / sum; bf16* op = MIX + qtok * 1024 + head * 64 + 4 * g;
#pragma unroll
              for (int dt = 0; dt < 4; ++dt) *(u32x2*)(op + 16 * dt) = (u32x2){cvt_pk_bf16(o[dt][0] * inv, o[dt][1] * inv), cvt_pk_bf16(o[dt][2] * inv, o[dt][3] * inv)}; }
            __syncthreads();
            if (nnew > 0) *(LAS u32x4*)(VR + ((hw % 10) * 64 + sc) * 128 + ((sch ^ (sc & 7)) * 16)) = pre0;
            if (nnew > 1) *(LAS u32x4*)(VR + (((hw + 1) % 10) * 64 + sc) * 128 + ((sch ^ (sc & 7)) * 16)) = pre1;
            hw = nhi;
            __syncthreads();
        }
    }
    __syncthreads();
}

constexpr int ML_QS = 0, ML_KS = 34816, ML_VS = 69632, ML_CS = 108544, ML_VEC = 147456;
constexpr int ML_QR = 272, ML_VR = 304;
static_assert(ML_VEC + 5 * 512 + 64 <= PH_BYTES, "mLSTM LDS");
template <bool OUT>
__device__ __forceinline__ void mlstm_unit(Frame& F, const int sc, const int grp  ) {
    const int w = F.wave, lane = F.lane, tid = F.tid, g = lane >> 4, lq = lane & 15, qp = lq >> 2, pp = lane & 3;
    const int dir = sc & 1, head = (sc >> 1) & 3, b = sc >> 3;
    const bf16* QKP = (const bf16*)(F.ws + WS_XM); const bf16* ZV = (const bf16*)(F.ws + WS_ZV); const float* GT = (const float*)(F.ws + WS_GATES);
    bf16* HB = (bf16*)(F.ws + WS_HB) + (size_t)dir * ML_ROWS * 512;
    float* REC = (float*)(F.ws + WS_MLST) + (size_t)sc * 9 * REC_FLOATS;
    LAS unsigned char* QS = F.lds + ML_QS; LAS unsigned char* KS = F.lds + ML_KS; LAS unsigned char* VS = F.lds + ML_VS; LAS unsigned char* CS = F.lds + ML_CS;
    LAS float* Va = (LAS float*)(F.lds + ML_VEC); LAS float* VA = Va + 128; LAS float* Vem = Va + 256; LAS float* Vin = Va + 384; LAS float* Vw = Va + 512; LAS float* Vs = Va + 640;
    const int nch = grp < 0 ? 2 : 8;
    const int T = grp < 0 ? CTXL : SEQ;
    const size_t rowbase = grp < 0 ? (size_t)ML_ROWS + b * CTXL : (size_t)b * SEQ;
    const int sig0 = grp < 0 ? 0 : grp * 1024;
    const int tt = w < 4 ? w : 11 - w;
    f32x4 Cacc[9];
#pragma unroll
    for (int vt = 0; vt < 9; ++vt) Cacc[vt] = (f32x4){0.f, 0.f, 0.f, 0.f};
    float m_prev = (grp < 0) ? 0.f : -1e30f, bsum = 0.f;
    if constexpr (OUT) {
        const float* R0 = REC;
        m_prev = R0[18432];
#pragma unroll
        for (int vt = 0; vt < 9; ++vt) Cacc[vt] = *(const f32x4*)(R0 + (16 * w + lq) * 144 + 16 * vt + 4 * g);
        for (int j = 0; j < grp; ++j) { const float* R = REC + (size_t)(1 + j) * REC_FLOATS; const float mj = R[18432], Bj = R[18433];
            const float mn = fmaxf(Bj + m_prev, mj), f = __expf(Bj + m_prev - mn), gc = __expf(mj - mn);
#pragma unroll
            for (int vt = 0; vt < 9; ++vt) Cacc[vt] = Cacc[vt] * f + *(const f32x4*)(R + (16 * w + lq) * 144 + 16 * vt + 4 * g) * gc;
            m_prev = mn; }
    }
    __syncthreads();
    if (tid < 384) { const int row = tid / 3, pc = tid % 3; u32x4 v = (u32x4){0u, 0u, 0u, 0u}; if (pc == 0) v.x = 0x3F80u; *(LAS u32x4*)(VS + row * ML_VR + 256 + pc * 16) = v; }
    if constexpr (OUT) {
#pragma unroll
        for (int vt = 0; vt < 9; ++vt) *(LAS u32x2*)(CS + (16 * w + lq) * ML_VR + (16 * vt + 4 * g) * 2) = (u32x2){cvt_pk_bf16(Cacc[vt][0], Cacc[vt][1]), cvt_pk_bf16(Cacc[vt][2], Cacc[vt][3])};
    }
    u32x4 pq[4], pk[4], pv[4]; float gi0 = 0.f, gi1 = 0.f, gf0 = 0.f, gf1 = 0.f;
    const int gcol_i = (2 * dir) * 4 + head, gcol_f = (2 * dir + 1) * 4 + head;
#define ML_TOK(sig) (dir ? (T - 1 - (sig)) : (sig))
#define ML_LOAD(k) do { _Pragma("unroll") for (int j = 0; j < 4; ++j) { const int id = tid + 512 * j, row = id >> 4, ch = id & 15; const size_t gr = rowbase + ML_TOK(sig0 + (k) * 128 + row); \
            if (OUT) pq[j] = *(const u32x4*)(QKP + gr * 1024 + head * 128 + ch * 8); \
            pk[j] = *(const u32x4*)(QKP + gr * 1024 + 512 + head * 128 + ch * 8); pv[j] = *(const u32x4*)(ZV + gr * 512 + head * 128 + ch * 8); } \
        if (w == 0) { const size_t g0 = rowbase + ML_TOK(sig0 + (k) * 128 + 2 * lane), g1 = rowbase + ML_TOK(sig0 + (k) * 128 + 2 * lane + 1); \
            gi0 = GT[g0 * 16 + gcol_i]; gf0 = GT[g0 * 16 + gcol_f]; gi1 = GT[g1 * 16 + gcol_i]; gf1 = GT[g1 * 16 + gcol_f]; } } while (0)
    ML_LOAD(0);
    for (int k = 0; k < nch; ++k) {
#pragma unroll
        for (int j = 0; j < 4; ++j) { const int id = tid + 512 * j, row = id >> 4, ch = id & 15;
            if (OUT) *(LAS u32x4*)(QS + row * ML_QR + ch * 16) = pq[j];
            *(LAS u32x4*)(KS + row * ML_QR + ch * 16) = pk[j]; *(LAS u32x4*)(VS + row * ML_VR + ch * 16) = pv[j]; }
        if (w == 0) {
            const float lf0 = fminf(gf0, 0.f) - log1pf(__expf(-fabsf(gf0))), lf1 = fminf(gf1, 0.f) - log1pf(__expf(-fabsf(gf1)));
            float P = lf0 + lf1;
#pragma unroll
            for (int o = 1; o < 64; o <<= 1) { const float t = __shfl_up(P, o); if (lane >= o) P += t; }
            const float b1 = P, b0 = P - lf1, a0 = gi0 - b0, a1 = gi1 - b1;
            float M = fmaxf(a0, a1);
#pragma unroll
            for (int o = 1; o < 64; o <<= 1) { const float t = __shfl_up(M, o); if (lane >= o) M = fmaxf(M, t); }
            float Mex = __shfl_up(M, 1); if (lane == 0) Mex = -1e30f;
            const float A0 = fmaxf(m_prev, fmaxf(Mex, a0)), A1 = fmaxf(m_prev, M);
            const float Aend = __shfl(A1, 63), bend = __shfl(b1, 63);
            *(LAS f32x2*)(Va + 2 * lane) = (f32x2){a0, a1}; *(LAS f32x2*)(VA + 2 * lane) = (f32x2){A0, A1};
            *(LAS f32x2*)(Vem + 2 * lane) = (f32x2){__expf(-(b0 + A0)), __expf(-(b1 + A1))};
            *(LAS f32x2*)(Vin + 2 * lane) = (f32x2){__expf(m_prev - A0), __expf(m_prev - A1)};
            *(LAS f32x2*)(Vw + 2 * lane) = (f32x2){__expf(a0 - Aend), __expf(a1 - Aend)};
            if (lane == 0) { Vs[0] = __expf(m_prev - Aend); Vs[1] = bend + Aend; Vs[2] = bend; }
        }
        if (k + 1 < nch) ML_LOAD(k + 1);
        __syncthreads();
        const float decay = Vs[0], m_new = Vs[1]; bsum += Vs[2];
        if constexpr (OUT) {
            const int t = 16 * tt + lq;
            bf16x8 qf[4];
#pragma unroll
            for (int kk = 0; kk < 4; ++kk) qf[kk] = *(const LAS bf16x8*)(QS + t * ML_QR + (32 * kk + 8 * g) * 2);
            f32x4 acc[9];
#pragma unroll
            for (int vt = 0; vt < 9; ++vt) acc[vt] = (f32x4){0.f, 0.f, 0.f, 0.f};
#pragma unroll
            for (int kk = 0; kk < 4; ++kk) { const LAS unsigned char* cr = CS + (32 * kk + 8 * g + qp) * ML_VR + 8 * pp;
#pragma unroll
                for (int vt = 0; vt < 9; ++vt) { const bf16x8 cf = cat4(tr_read(cr + 32 * vt), tr_read(cr + 4 * ML_VR + 32 * vt));
                    acc[vt] = __builtin_amdgcn_mfma_f32_16x16x32_bf16(cf, qf[kk], acc[vt], 0, 0, 0); } }
            { const float it = Vin[t];
#pragma unroll
              for (int vt = 0; vt < 9; ++vt) acc[vt] = acc[vt] * it; }
            const float At = VA[t];
            u32x2 pw[8];
#pragma unroll
            for (int st = 0; st < 8; ++st) {
                pw[st] = (u32x2){0u, 0u};
                if (st <= tt) {
                    f32x4 sa = (f32x4){0.f, 0.f, 0.f, 0.f};
#pragma unroll
                    for (int kk = 0; kk < 4; ++kk) { const bf16x8 kf = *(const LAS bf16x8*)(KS + (16 * st + lq) * ML_QR + (32 * kk + 8 * g) * 2);
                        sa = __builtin_amdgcn_mfma_f32_16x16x32_bf16(kf, qf[kk], sa, 0, 0, 0); }
                    const f32x4 av = *(const LAS f32x4*)(Va + 16 * st + 4 * g);
                    float p[4];
#pragma unroll
                    for (int j = 0; j < 4; ++j) { const int s = 16 * st + 4 * g + j; p[j] = (s <= t) ? sa[j] * __expf(av[j] - At) : 0.f; }
                    pw[st] = (u32x2){cvt_pk_bf16(p[0], p[1]), cvt_pk_bf16(p[2], p[3])};
                }
            }
#pragma unroll
            for (int kp = 0; kp < 4; ++kp) {
                if (2 * kp <= tt) {
                    const bf16x8 pf = as_bf16x8((u32x4){pw[2 * kp].x, pw[2 * kp].y, pw[2 * kp + 1].x, pw[2 * kp + 1].y});
                    const LAS unsigned char* vr = VS + (32 * kp + 4 * g + qp) * ML_VR + 8 * pp;
#pragma unroll
                    for (int vt = 0; vt < 9; ++vt) { const bf16x8 vf = cat4(tr_read(vr + 32 * vt), tr_read(vr + 16 * ML_VR + 32 * vt));
                        acc[vt] = __builtin_amdgcn_mfma_f32_16x16x32_bf16(vf, pf, acc[vt], 0, 0, 0); }
                }
            }
            const float den = __shfl(acc[8][0], lq);
            const float rd = 1.f / fmaxf(fabsf(den), Vem[t]);
            bf16* hp = HB + (rowbase + ML_TOK(sig0 + k * 128 + t)) * 512 + head * 128 + 4 * g;
#pragma unroll
            for (int vt = 0; vt < 8; ++vt) *(u32x2*)(hp + 16 * vt) = (u32x2){cvt_pk_bf16(acc[vt][0] * rd, acc[vt][1] * rd), cvt_pk_bf16(acc[vt][2] * rd, acc[vt][3] * rd)};
        }
#pragma unroll
        for (int vt = 0; vt < 9; ++vt) Cacc[vt] = Cacc[vt] * decay;
#pragma unroll
        for (int ks = 0; ks < 4; ++ks) {
            const LAS unsigned char* kr = KS + (32 * ks + 8 * g + qp) * ML_QR + (16 * w) * 2 + 8 * pp;
            const bf16x4 k0 = tr_read(kr), k1 = tr_read(kr + 4 * ML_QR);
            const f32x4 w0 = *(const LAS f32x4*)(Vw + 32 * ks + 8 * g), w1 = *(const LAS f32x4*)(Vw + 32 * ks + 8 * g + 4);
            const u32x2 ku0 = __builtin_bit_cast(u32x2, k0), ku1 = __builtin_bit_cast(u32x2, k1);
            const bf16x8 kf = as_bf16x8((u32x4){cvt_pk_bf16(bf_lo(ku0.x) * w0[0], bf_hi(ku0.x) * w0[1]), cvt_pk_bf16(bf_lo(ku0.y) * w0[2], bf_hi(ku0.y) * w0[3]),
                                                cvt_pk_bf16(bf_lo(ku1.x) * w1[0], bf_hi(ku1.x) * w1[1]), cvt_pk_bf16(bf_lo(ku1.y) * w1[2], bf_hi(ku1.y) * w1[3])});
            const LAS unsigned char* vr = VS + (32 * ks + 8 * g + qp) * ML_VR + 8 * pp;
#pragma unroll
            for (int vt = 0; vt < 9; ++vt) { const bf16x8 vf = cat4(tr_read(vr + 32 * vt), tr_read(vr + 4 * ML_VR + 32 * vt));
                Cacc[vt] = __builtin_amdgcn_mfma_f32_16x16x32_bf16(vf, kf, Cacc[vt], 0, 0, 0); }
        }
        m_prev = m_new;
        __syncthreads();
        if constexpr (OUT) {
#pragma unroll
            for (int vt = 0; vt < 9; ++vt) *(LAS u32x2*)(CS + (16 * w + lq) * ML_VR + (16 * vt + 4 * g) * 2) = (u32x2){cvt_pk_bf16(Cacc[vt][0], Cacc[vt][1]), cvt_pk_bf16(Cacc[vt][2], Cacc[vt][3])};
        }
    }
#undef ML_LOAD
#undef ML_TOK
    if constexpr (!OUT) {
        float* R = REC + (size_t)(grp < 0 ? 0 : 1 + grp) * REC_FLOATS;
#pragma unroll
        for (int vt = 0; vt < 9; ++vt) *(f32x4*)(R + (16 * w + lq) * 144 + 16 * vt + 4 * g) = Cacc[vt];
        if (tid == 0) { R[18432] = m_prev; R[18433] = bsum; }
    }
}

__device__ __forceinline__ void p6_readout(Frame& F, const Args& a) {
    const int gw = F.vcu * 8 + F.wave, NGW = F.G * 8, lane = F.lane;
    const bf16* HB0 = (const bf16*)(F.ws + WS_HB); const bf16* HB1 = HB0 + (size_t)ML_ROWS * 512; const bf16* ZO = (const bf16*)(F.ws + WS_ZO);
    bf16* MIX = (bf16*)(F.ws + WS_MIX);
    const f32x4 g0 = *(const f32x4*)(a.in[11] + 8 * lane), g1 = *(const f32x4*)(a.in[11] + 8 * lane + 4);
    for (int m = gw; m < ML_ROWS; m += NGW) {
        const u32x4 hf = *(const u32x4*)(HB0 + (size_t)m * 512 + 8 * lane), hb = *(const u32x4*)(HB1 + (size_t)m * 512 + 8 * lane), zo = *(const u32x4*)(ZO + (size_t)m * 512 + 8 * lane);
        float h[8]; float ss = 0.f;
#pragma unroll
        for (int q = 0; q < 4; ++q) { h[2 * q] = bf_lo(hf[q]) + bf_lo(hb[q]); h[2 * q + 1] = bf_hi(hf[q]) + bf_hi(hb[q]); ss += h[2 * q] * h[2 * q] + h[2 * q + 1] * h[2 * q + 1]; }
        ss += __shfl_xor(ss, 1); ss += __shfl_xor(ss, 2); ss += __shfl_xor(ss, 4); ss += __shfl_xor(ss, 8);
        const float rs = 1.f / sqrtf(ss * (1.f / 128.f) + LN_EPS);
        float o[8];
#pragma unroll
        for (int q = 0; q < 4; ++q) { const float z0 = bf_lo(zo[q]), z1 = bf_hi(zo[q]);
            o[2 * q] = h[2 * q] * rs * (q < 2 ? g0[2 * q] : g1[2 * q - 4]) / (1.f + __expf(-z0));
            o[2 * q + 1] = h[2 * q + 1] * rs * (q < 2 ? g0[2 * q + 1] : g1[2 * q - 3]) / (1.f + __expf(-z1)); }
        *(u32x4*)(MIX + (size_t)m * 1024 + 512 + 8 * lane) = (u32x4){cvt_pk_bf16(o[0], o[1]), cvt_pk_bf16(o[2], o[3]), cvt_pk_bf16(o[4], o[5]), cvt_pk_bf16(o[6], o[7])};
    }
}

struct EpiY1 {
    static constexpr bool PERM = false;
    const float* x; const float* ada; float* y1;
    __device__ __forceinline__ void operator()(const f32x4 (&acc)[2][2][4][2], const pg8::Unit& u, int wr, int wc, int fr, int fq) const {
        const int row0 = u.pm * 256 + wr * 64 + fr, col0 = u.pn * 256 + wc * 32 + 4 * fq;
        const float* g1 = ada + (size_t)(u.pm >> 5) * 6144 + 2048;
        f32x4 gv[2][2];
#pragma unroll
        for (int bj = 0; bj < 2; ++bj)
#pragma unroll
            for (int n = 0; n < 2; ++n) gv[bj][n] = *(const f32x4*)(g1 + col0 + bj * 128 + n * 16);
#pragma unroll
        for (int ai = 0; ai < 2; ++ai)
#pragma unroll
            for (int m = 0; m < 4; ++m) { const size_t off = (size_t)(row0 + ai * 128 + m * 16) * 1024 + col0;
#pragma unroll
                for (int bj = 0; bj < 2; ++bj)
#pragma unroll
                    for (int n = 0; n < 2; ++n) { const f32x4 xv = *(const f32x4*)(x + off + bj * 128 + n * 16);
                        *(f32x4*)(y1 + off + bj * 128 + n * 16) = xv * DN_ALPHA + gv[bj][n] * acc[ai][bj][m][n]; } }
    }
};

constexpr int P8_LG = 0;
constexpr int P8_REC = 40960;
__device__ __forceinline__ void p8_mid(Frame& F, const Args& a) {
    const int gw = F.vcu * 8 + F.wave, NGW = F.G * 8, lane = F.lane, tid = F.tid, g = lane >> 4, lq = lane & 15;
    float* Y1 = (float*)(F.ws + WS_Y1); bf16* XM2 = (bf16*)(F.ws + WS_XM2);
    const float* ada = (const float*)(F.ws + WS_ADA); const bf16* WR = (const bf16*)(F.ws + WS_WR);
    LAS float* lg = (LAS float*)(F.lds + P8_LG) + F.wave * 1280;
    LAS unsigned* rec = (LAS unsigned*)(F.lds + P8_REC);
    LAS int* hist = (LAS int*)(F.lds + MISC_OFF + MS_HIST); LAS int* base = (LAS int*)(F.lds + MISC_OFF + MS_BASE);
    if (tid < 64) hist[tid] = 0;
    __syncthreads();
    int nloc = 0;
    for (int wt = gw; wt < ML_ROWS / 16; wt += NGW, ++nloc) {
        const int row0 = wt * 16;
        const float* sh2 = ada + (size_t)(row0 >> 13) * 6144 + 3072; const float* sc2 = sh2 + 1024;
        for (int r = 0; r < 16; ++r) {
            const size_t m = (size_t)row0 + r;
            f32x4* yr = (f32x4*)(Y1 + m * 1024) + lane;
            f32x4 v[4]; float s = 0.f;
#pragma unroll
            for (int j = 0; j < 4; ++j) { v[j] = yr[64 * j]; s += (v[j].x + v[j].y) + (v[j].z + v[j].w); }
            float mean = wave_sum(s) * (1.f / DM), s2 = 0.f;
#pragma unroll
            for (int j = 0; j < 4; ++j) { v[j] = v[j] - mean; s2 += (v[j].x * v[j].x + v[j].y * v[j].y) + (v[j].z * v[j].z + v[j].w * v[j].w); }
            float rstd = 1.f / sqrtf(wave_sum(s2) * (1.f / DM) + LN_EPS);
            s = 0.f;
#pragma unroll
            for (int j = 0; j < 4; ++j) { const f32x4 gg = ((const f32x4*)a.in[13])[lane + 64 * j], bb = ((const f32x4*)a.in[14])[lane + 64 * j];
                v[j] = (v[j] * rstd) * gg + bb; yr[64 * j] = v[j]; s += (v[j].x + v[j].y) + (v[j].z + v[j].w); }
            mean = wave_sum(s) * (1.f / DM); s2 = 0.f;
#pragma unroll
            for (int j = 0; j < 4; ++j) { v[j] = v[j] - mean; s2 += (v[j].x * v[j].x + v[j].y * v[j].y) + (v[j].z * v[j].z + v[j].w * v[j].w); }
            rstd = 1.f / sqrtf(wave_sum(s2) * (1.f / DM) + LN_EPS);
            u32x2* o8 = (u32x2*)(XM2 + m * 1024) + lane;
#pragma unroll
            for (int j = 0; j < 4; ++j) { const f32x4 h = ((const f32x4*)sh2)[lane + 64 * j], c = ((const f32x4*)sc2)[lane + 64 * j]; const f32x4 y = (v[j] * rstd) * (c + 1.f) + h;
                o8[64 * j] = (u32x2){cvt_pk_bf16(y.x, y.y), cvt_pk_bf16(y.z, y.w)}; }
        }
        VM_WAIT();
        f32x4 la[5];
#pragma unroll
        for (int nt = 0; nt < 5; ++nt) la[nt] = (f32x4){0.f, 0.f, 0.f, 0.f};
        const bf16* xp = XM2 + (size_t)(row0 + lq) * 1024 + 8 * g;
        const bf16* wp = WR + (size_t)lq * 1024 + 8 * g;
#pragma unroll 4
        for (int kk = 0; kk < 32; ++kk) {
            const bf16x8 xf = __builtin_nontemporal_load((const bf16x8*)(xp + 32 * kk));
#pragma unroll
            for (int nt = 0; nt < 5; ++nt) { const bf16x8 wf = *(const bf16x8*)(wp + (size_t)nt * 16 * 1024 + 32 * kk);
                la[nt] = __builtin_amdgcn_mfma_f32_16x16x32_bf16(wf, xf, la[nt], 0, 0, 0); }
        }
#pragma unroll
        for (int nt = 0; nt < 5; ++nt) *(LAS f32x4*)(lg + lq * 80 + 16 * nt + 4 * g) = la[nt];
        LDS_WAIT();
        if (lane < 16) {
            const LAS float* L = lg + lane * 80;
            float gl[8]; float gm = -1e30f; int gi = 0;
#pragma unroll
            for (int i = 0; i < 8; ++i) { gl[i] = L[i] + a.in[16][i]; if (gl[i] > gm) { gm = gl[i]; gi = i; } }
            float gs = 0.f;
#pragma unroll
            for (int i = 0; i < 8; ++i) gs += __expf(gl[i] - gm);
            const float pg = 1.f / gs;
            float v1 = -1e30f, v2 = -1e30f; int i1 = 0, i2 = 0;
#pragma unroll
            for (int i = 0; i < 8; ++i) { const float e = L[16 + gi * 8 + i] + a.in[18][gi * 8 + i];
                if (e > v1) { v2 = v1; i2 = i1; v1 = e; i1 = i; } else if (e > v2) { v2 = e; i2 = i; } }
            const float ex = __expf(v2 - v1), wA = pg / (1.f + ex), wB = pg * ex / (1.f + ex);
            const int eA = gi * 8 + i1, eB = gi * 8 + i2;
            const int pA = __hip_atomic_fetch_add(&hist[eA], 1, __ATOMIC_RELAXED, __HIP_MEMORY_SCOPE_WORKGROUP), pB = __hip_atomic_fetch_add(&hist[eB], 1, __ATOMIC_RELAXED, __HIP_MEMORY_SCOPE_WORKGROUP);
            LAS unsigned* rc = rec + ((nloc * 8 + F.wave) * 16 + lane) * 8;
            rc[0] = (unsigned)eA; rc[1] = (unsigned)pA; rc[2] = (unsigned)eB; rc[3] = (unsigned)pB; rc[4] = __float_as_uint(wA); rc[5] = __float_as_uint(wB); rc[6] = (unsigned)(row0 + lane);
        }
    }
    __syncthreads();
    if (tid < 64) base[tid] = (int)__hip_atomic_fetch_add(F.ctl + CW_CNT + 16 * tid, (unsigned)hist[tid], RLX_AGENT);
    __syncthreads();
    {
        int* TOKL = (int*)(F.ws + WS_TOKL); u32x4* ROUTE = (u32x4*)(F.ws + WS_ROUTE);
        const int ntile_max = (ML_ROWS / 16 + NGW - 1) / NGW;
        for (int i = tid; i < ntile_max * 128; i += 512) {
            const int nl = i >> 7, wv = (i >> 4) & 7;
            if ((long)(F.vcu * 8 + wv) + (long)nl * NGW >= ML_ROWS / 16) continue;
            const LAS unsigned* rc = rec + i * 8;
            const int eA = (int)rc[0], pA = (int)rc[1] + base[rc[0]], eB = (int)rc[2], pB = (int)rc[3] + base[rc[2]], tok = (int)rc[6];
            TOKL[(size_t)eA * 65536 + pA] = tok; TOKL[(size_t)eB * 65536 + pB] = tok;
            ROUTE[tok] = (u32x4){((unsigned)eA << 20) | (unsigned)pA, ((unsigned)eB << 20) | (unsigned)pB, rc[4], rc[5]};
        }
    }
}

__device__ __forceinline__ void moe_tables(Frame& F) {
    LAS int* cnt = (LAS int*)(F.lds + MISC_OFF + MS_CNT); LAS int* start = (LAS int*)(F.lds + MISC_OFF + MS_START); LAS int* tstart = (LAS int*)(F.lds + MISC_OFF + MS_TSTART);
    __syncthreads();
    if (F.tid < 64) cnt[F.tid] = (int)__hip_atomic_load(F.ctl + CW_CNT + 16 * F.tid, RLX_AGENT);
    __syncthreads();
    if (F.tid == 0) { int s = 0, t = 0; for (int e = 0; e < 64; ++e) { start[e] = s; tstart[e] = t; s += cnt[e]; t += (cnt[e] + 255) >> 8; } start[64] = s; tstart[64] = t; }
    __syncthreads();
}
struct MoeOrder {
    const LAS int* cnt; const LAS int* start; const LAS int* tstart; int G, c;
    __device__ __forceinline__ bool next(int i, pg8::Unit& u) const {
        const long L = (long)i * G + c; const int tile = (int)(L >> 2);
        if (tile >= tstart[64]) return false;
        int e = 0;
        for (int s = 32; s >= 1; s >>= 1) if (tstart[e + s] <= tile) e += s;
        while (cnt[e] == 0) --e;
        u.e = e; u.pm = tile - tstart[e]; u.pn = (int)(L & 3); const int rem = cnt[e] - u.pm * 256; u.cnt = rem < 256 ? rem : 256; return true;
    }
};
struct MoeSched1 {
    static constexpr bool GATHER = true;
    MoeOrder ord; const char* XM2; const char* W13; const int* TOKL;
    __device__ __forceinline__ bool next(int i, pg8::Unit& u) const { return ord.next(i, u); }
    __device__ __forceinline__ const char* a_ptr(const pg8::Unit&) const { return XM2; }
    __device__ __forceinline__ const char* b_ptr(const pg8::Unit& u) const { return W13 + ((size_t)u.e * 1024 + (size_t)u.pn * 256) * 2048; }
    __device__ __forceinline__ void a_voff(const pg8::Unit& u, unsigned (&v)[2][2], int R0, int R1, int C0, int C1) const {
        const int* tl = TOKL + (size_t)u.e * 65536 + u.pm * 256;
#pragma unroll
        for (int h = 0; h < 2; ++h) { const int r0 = h * 128 + R0, r1 = h * 128 + R1;
            const int t0 = r0 < u.cnt ? tl[r0] : 0, t1 = r1 < u.cnt ? tl[r1] : 0;
            v[h][0] = (unsigned)t0 * 2048u + (unsigned)C0 * 2u; v[h][1] = (unsigned)t1 * 2048u + (unsigned)C1 * 2u; }
    }
};
struct MoeSched2 {
    static constexpr bool GATHER = false;
    MoeOrder ord; const char* H; const char* W2;
    __device__ __forceinline__ bool next(int i, pg8::Unit& u) const { return ord.next(i, u); }
    __device__ __forceinline__ const char* a_ptr(const pg8::Unit& u) const { return H + (size_t)(ord.start[u.e] + u.pm * 256) * 1024; }
    __device__ __forceinline__ const char* b_ptr(const pg8::Unit& u) const { return W2 + ((size_t)u.e * 1024 + (size_t)u.pn * 256) * 1024; }
    __device__ __forceinline__ void a_voff(const pg8::Unit&, unsigned (&)[2][2], int, int, int, int) const {}
};
struct EpiH {
    static constexpr bool PERM = true;
    bf16* H; const LAS int* start;
    __device__ __forceinline__ void operator()(const f32x4 (&acc)[2][2][4][2], const pg8::Unit& u, int wr, int wc, int fr, int fq) const {
        const int r0 = wr * 64 + fr; const size_t slot0 = (size_t)start[u.e] + u.pm * 256;
        const int col0 = u.pn * 128 + wc * 32 + 8 * fq;
#pragma unroll
        for (int ai = 0; ai < 2; ++ai)
#pragma unroll
            for (int m = 0; m < 4; ++m) { const int r = r0 + ai * 128 + m * 16;
                if (r < u.cnt) { float o[8];
#pragma unroll
                    for (int n = 0; n < 2; ++n)
#pragma unroll
                        for (int j = 0; j < 4; ++j) { const float h1 = acc[ai][0][m][n][j], h3 = acc[ai][1][m][n][j]; o[4 * n + j] = h1 / (1.f + __expf(-h1)) * h3; }
                    *(u32x4*)(H + (slot0 + r) * 512 + col0) = (u32x4){cvt_pk_bf16(o[0], o[1]), cvt_pk_bf16(o[2], o[3]), cvt_pk_bf16(o[4], o[5]), cvt_pk_bf16(o[6], o[7])}; } }
    }
};
struct EpiY {
    static constexpr bool PERM = true;
    bf16* Y; const LAS int* start;
    __device__ __forceinline__ void operator()(const f32x4 (&acc)[2][2][4][2], const pg8::Unit& u, int wr, int wc, int fr, int fq) const {
        const int r0 = wr * 64 + fr; const size_t slot0 = (size_t)start[u.e] + u.pm * 256;
        const int col0 = u.pn * 256 + wc * 32 + 8 * fq;
#pragma unroll
        for (int ai = 0; ai < 2; ++ai)
#pragma unroll
            for (int m = 0; m < 4; ++m) { const int r = r0 + ai * 128 + m * 16;
                if (r < u.cnt) {
#pragma unroll
                    for (int bj = 0; bj < 2; ++bj) { const f32x4 v0 = acc[ai][bj][m][0], v1 = acc[ai][bj][m][1];
                        *(u32x4*)(Y + (slot0 + r) * 1024 + col0 + bj * 128) = (u32x4){cvt_pk_bf16(v0[0], v0[1]), cvt_pk_bf16(v0[2], v0[3]), cvt_pk_bf16(v1[0], v1[1]), cvt_pk_bf16(v1[2], v1[3])}; } } }
    }
};

__device__ __forceinline__ void p11_final(Frame& F, const Args& a) {
    const int gw = F.vcu * 8 + F.wave, NGW = F.G * 8, lane = F.lane;
    const float* XMID = (const float*)(F.ws + WS_Y1); const bf16* Y = (const bf16*)(F.ws + WS_YMOE); const u32x4* ROUTE = (const u32x4*)(F.ws + WS_ROUTE);
    const float* ada = (const float*)(F.ws + WS_ADA);
    const LAS int* start = (const LAS int*)(F.lds + MISC_OFF + MS_START);
    for (int m = gw; m < ML_ROWS; m += NGW) {
        const u32x4 rt = ROUTE[m];
        const size_t sA = (size_t)start[rt.x >> 20] + (rt.x & 0xfffffu), sB = (size_t)start[rt.y >> 20] + (rt.y & 0xfffffu);
        const float wA = __uint_as_float(rt.z), wB = __uint_as_float(rt.w);
        const f32x4* xr = (const f32x4*)(XMID + (size_t)m * 1024) + lane;
        const u32x2* ya = (const u32x2*)(Y + sA * 1024) + lane; const u32x2* yb = (const u32x2*)(Y + sB * 1024) + lane;
        const f32x4* g2 = (const f32x4*)(ada + (size_t)(m >> 13) * 6144 + 5120) + lane;
        f32x4 v[4]; float s = 0.f;
#pragma unroll
        for (int j = 0; j < 4; ++j) { const f32x4 xv = xr[64 * j]; const u32x2 pa = ya[64 * j], pb = yb[64 * j]; const f32x4 gg = g2[64 * j];
            f32x4 mo; mo.x = wA * bf_lo(pa.x) + wB * bf_lo(pb.x); mo.y = wA * bf_hi(pa.x) + wB * bf_hi(pb.x); mo.z = wA * bf_lo(pa.y) + wB * bf_lo(pb.y); mo.w = wA * bf_hi(pa.y) + wB * bf_hi(pb.y);
            v[j] = xv * DN_ALPHA + gg * mo; s += (v[j].x + v[j].y) + (v[j].z + v[j].w); }
        const float mean = wave_sum(s) * (1.f / DM); float s2 = 0.f;
#pragma unroll
        for (int j = 0; j < 4; ++j) { v[j] = v[j] - mean; s2 += (v[j].x * v[j].x + v[j].y * v[j].y) + (v[j].z * v[j].z + v[j].w * v[j].w); }
        const float rstd = 1.f / sqrtf(wave_sum(s2) * (1.f / DM) + LN_EPS);
        f32x4* o = (f32x4*)(a.out + (size_t)m * 1024) + lane;
#pragma unroll
        for (int j = 0; j < 4; ++j) { const f32x4 gg = ((const f32x4*)a.in[22])[lane + 64 * j], bb = ((const f32x4*)a.in[23])[lane + 64 * j]; o[64 * j] = (v[j] * rstd) * gg + bb; }
    }
}

__global__ void __launch_bounds__(512, 2) mk_fwd(Args args) {
    extern __shared__ __attribute__((aligned(16))) unsigned char lds_raw[];
    Frame F;
    F.lds = (LAS unsigned char*)lds_raw; F.ws = args.ws; F.ctl = (unsigned*)(args.ws + WS_CTL);
    F.tid = threadIdx.x; F.lane = F.tid & 63; F.wave = __builtin_amdgcn_readfirstlane(F.tid >> 6);
    F.G = gridDim.x; { const int bx = blockIdx.x; F.vcu = (F.G % 8 == 0) ? (bx % 8) * (F.G / 8) + bx / 8 : bx; }
    for (int u = F.tid; u < (LDS_BYTES - MISC_OFF) / 4; u += 512) ((LAS unsigned*)(F.lds + MISC_OFF))[u] = 0u;
    __syncthreads();
    XcdBarrier bar; bar.bar = F.ctl + CW_BAR; bar.x = 0; bar.st = nullptr;
    if (MK_N_LAUNCHES == 1) bar = xcd_barrier_post(F.ctl + CW_BAR, (volatile LAS unsigned*)(F.lds + MISC_OFF));
    const int lo = args.ph_lo, hi = args.ph_hi;
#define IN(k) (lo <= (k) && (k) < hi)
#define SEAM(k) do { if (IN(k) && IN((k) + 1)) xcd_barrier(bar); } while (0)

    if (IN(0)) { p0_prologue(F, args); } SEAM(0);
    if (IN(1)) { p1_ln_mod(F, args); } SEAM(1);
    if (IN(2)) {
        pg8::DenseSched S; S.A = (const char*)(F.ws + WS_XM); S.Bt = (const char*)(F.ws + WS_WIN); S.K = 1024; S.ord.init(MT, NZ, F.G, (int)blockIdx.x);
        EpiZ E{F.ws, args.in[9]};
        pg8::gemm_phase<EpiZ, pg8::DenseSched>(F.lds, 1024, S, E);
    } SEAM(2);
    if (IN(3)) { if (args.pad != 2) p3_qkprep(F, args); if (args.pad != 1) p3_na(F, args); } SEAM(3);
    if (IN(4)) {
        for (int u = blockIdx.x; u < 576; u += F.G) { if (u < 512) mlstm_unit<false>(F, u >> 3, u & 7); else mlstm_unit<false>(F, u - 512, -1); }
    } SEAM(4);
    if (IN(5)) {
        for (int u = blockIdx.x; u < 512; u += F.G) mlstm_unit<true>(F, u >> 3, u & 7);
    } SEAM(5);
    if (IN(6)) { p6_readout(F, args); } SEAM(6);
    if (IN(7)) {
        pg8::DenseSched S; S.A = (const char*)(F.ws + WS_MIX); S.Bt = (const char*)(F.ws + WS_WOUT); S.K = 1024; S.ord.init(ML_ROWS, 1024, F.G, (int)blockIdx.x);
        EpiY1 E{args.in[0], (const float*)(F.ws + WS_ADA), (float*)(F.ws + WS_Y1)};
        pg8::gemm_phase<EpiY1, pg8::DenseSched>(F.lds, 1024, S, E);
    } SEAM(7);
    if (IN(8)) { p8_mid(F, args); } SEAM(8);
    if (IN(9)) {
        moe_tables(F);
        MoeSched1 S; S.ord = MoeOrder{(const LAS int*)(F.lds + MISC_OFF + MS_CNT), (const LAS int*)(F.lds + MISC_OFF + MS_START), (const LAS int*)(F.lds + MISC_OFF + MS_TSTART), F.G, (int)blockIdx.x};
        S.XM2 = (const char*)(F.ws + WS_XM2); S.W13 = (const char*)(F.ws + WS_W13); S.TOKL = (const int*)(F.ws + WS_TOKL);
        EpiH E{(bf16*)(F.ws + WS_HMOE), (const LAS int*)(F.lds + MISC_OFF + MS_START)};
        pg8::gemm_phase<EpiH, MoeSched1>(F.lds, 1024, S, E);
    } SEAM(9);
    if (IN(10)) {
        moe_tables(F);
        MoeSched2 S; S.ord = MoeOrder{(const LAS int*)(F.lds + MISC_OFF + MS_CNT), (const LAS int*)(F.lds + MISC_OFF + MS_START), (const LAS int*)(F.lds + MISC_OFF + MS_TSTART), F.G, (int)blockIdx.x};
        S.H = (const char*)(F.ws + WS_HMOE); S.W2 = (const char*)(F.ws + WS_W2);
        EpiY E{(bf16*)(F.ws + WS_YMOE), (const LAS int*)(F.lds + MISC_OFF + MS_START)};
        pg8::gemm_phase<EpiY, MoeSched2>(F.lds, 512, S, E);
    } SEAM(10);
    if (IN(11)) { moe_tables(F); p11_final(F, args); }
#undef IN
#undef SEAM
}

extern "C" void kernel_launch(void* const* d_in, const int* in_sizes, int n_in, void* d_out, int out_size, void* d_ws, size_t ws_size, hipStream_t stream) {
    static int grid = 0;
    if (grid == 0) {
        if (n_in != 24 || out_size != ML_ROWS * DM || ws_size < WS_END) { fprintf(stderr, "kernel_launch: unexpected shapes (n_in %d out %d ws %zu)\n", n_in, out_size, ws_size); grid = -1; return; }
        int dev = 0, cus = 0, per_cu = 0;
        if (hipGetDevice(&dev) != hipSuccess || hipDeviceGetAttribute(&cus, hipDeviceAttributeMultiprocessorCount, dev) != hipSuccess) { grid = -1; return; }
        if (hipFuncSetAttribute((const void*)mk_fwd, hipFuncAttributeMaxDynamicSharedMemorySize, LDS_BYTES) != hipSuccess) { fprintf(stderr, "kernel_launch: hipFuncSetAttribute failed\n"); grid = -1; return; }
        if (hipOccupancyMaxActiveBlocksPerMultiprocessor(&per_cu, (const void*)mk_fwd, 512, LDS_BYTES) != hipSuccess || per_cu < 1) fprintf(stderr, "kernel_launch: occupancy query says %d\n", per_cu);
        (void)hipGetLastError();
        grid = cus;
    }
    if (grid < 0) return;
    if (hipMemsetAsync((char*)d_ws + WS_CTL, 0, CTL_ZERO_BYTES, stream) != hipSuccess) return;
    Args a{};
    for (int i = 0; i < 24; ++i) a.in[i] = (const float*)d_in[i];
    a.out = (float*)d_out; a.ws = (unsigned char*)d_ws;
    if (MK_N_LAUNCHES == 1) { a.ph_lo = 0; a.ph_hi = NPHASE; a.li = 0; hipLaunchKernelGGL(mk_fwd, dim3(grid), dim3(512), LDS_BYTES, stream, a); }
    else for (int p = 0; p < NPHASE; ++p) { a.ph_lo = p; a.ph_hi = p + 1; a.li = p; a.pad = 0; hipLaunchKernelGGL(mk_fwd, dim3(grid), dim3(512), LDS_BYTES, stream, a);
        if (PROBE_DBL == p || (PROBE_DBL == 33 && p == 3)) { a.pad = (PROBE_DBL == 33) ? 2 : (p == 3 ? 1 : 0); hipLaunchKernelGGL(mk_fwd, dim3(grid), dim3(512), LDS_BYTES, stream, a); } }
}
```

```cpp
#include <hip/hip_runtime.h>
#include <cstdio>
#include <cstdint>

#ifndef MK_N_LAUNCHES
#define MK_N_LAUNCHES 1
#endif
#ifndef PROBE_DBL
#define PROBE_DBL -1
#endif
#ifndef PROBE_AMP
#define PROBE_AMP -1
#endif

#define GAS __attribute__((address_space(1)))
#define LAS __attribute__((address_space(3)))
typedef unsigned short bf16;
typedef short bf16x8 __attribute__((ext_vector_type(8)));
typedef short bf16x4 __attribute__((ext_vector_type(4)));
typedef float f32x4 __attribute__((ext_vector_type(4)));
typedef float f32x2 __attribute__((ext_vector_type(2)));
typedef unsigned u32x4 __attribute__((ext_vector_type(4)));
typedef unsigned u32x2 __attribute__((ext_vector_type(2)));

constexpr int NB = 8, SEQ = 8192, DM = 1024, CTXL = 256;
constexpr int ML_ROWS = NB * SEQ, MC_ROWS = NB * CTXL, MT = ML_ROWS + MC_ROWS;
constexpr int IN_COLS = 3600, NZ = 3584;
constexpr int NEXP = 64, EH = 512;
constexpr float LN_EPS = 1e-5f;
constexpr float DN_ALPHA = 1.189207115002721f;
constexpr int NPHASE = 12;

constexpr size_t MiB = 1u << 20;
constexpr size_t WS_CTL = 0, CTL_ZERO_BYTES = 1 * MiB;
constexpr size_t WS_WIN = 1 * MiB;
constexpr size_t WS_WOUT = 9 * MiB;
constexpr size_t WS_W13 = 11 * MiB;
constexpr size_t WS_W2 = 139 * MiB;
constexpr size_t WS_ADA = 203 * MiB;
constexpr size_t WS_ROPE = 204 * MiB;
constexpr size_t WS_WR = 204 * MiB + 512 * 1024;
constexpr size_t WS_GATES = 205 * MiB;
constexpr size_t WS_TOKL = 210 * MiB;
constexpr size_t WS_ROUTE = 226 * MiB;
constexpr size_t WS_MLST = 227 * MiB;
constexpr int REC_FLOATS = 18688;
constexpr size_t WS_ZA = 270 * MiB;
constexpr size_t WS_ZQK = 468 * MiB;
constexpr size_t WS_ZV = 600 * MiB;
constexpr size_t WS_ZO = 666 * MiB;
constexpr size_t WS_XM = 732 * MiB;
constexpr size_t WS_MIX = 864 * MiB;
constexpr size_t WS_HB = 270 * MiB;
constexpr size_t WS_Y1 = 270 * MiB;
constexpr size_t WS_HMOE = 526 * MiB;
constexpr size_t WS_XM2 = 655 * MiB;
constexpr size_t WS_YMOE = 655 * MiB;
constexpr size_t WS_END = 992 * MiB;
static_assert(WS_MLST + (size_t)64 * 9 * REC_FLOATS * 4 <= WS_ZA, "ws map");
static_assert(WS_YMOE + (size_t)(131072 + 256) * 1024 * 2 <= WS_END, "ws map");
constexpr int CW_TMO = 0;
constexpr int CW_BAR = 4096;
constexpr int CW_CNT = 16384;

constexpr int PH_BYTES = 155648;
constexpr int MISC_OFF = PH_BYTES;
constexpr int LDS_BYTES = PH_BYTES + 4096;
constexpr int MS_TSTART = 64;
constexpr int MS_CNT = 384;
constexpr int MS_START = 704;
constexpr int MS_HIST = 1024;
constexpr int MS_BASE = 1280;

#define LDS_WAIT() asm volatile("s_waitcnt lgkmcnt(0)" ::: "memory")
#define VM_WAIT() asm volatile("s_waitcnt vmcnt(0)" ::: "memory")
#define RLX_AGENT __ATOMIC_RELAXED, __HIP_MEMORY_SCOPE_AGENT

__device__ __forceinline__ unsigned cvt_pk_bf16(float lo, float hi) { unsigned r; asm volatile("v_cvt_pk_bf16_f32 %0, %1, %2" : "=v"(r) : "v"(lo), "v"(hi)); return r; }
__device__ __forceinline__ float bf_lo(unsigned u) { return __builtin_bit_cast(float, u << 16); }
__device__ __forceinline__ float bf_hi(unsigned u) { return __builtin_bit_cast(float, u & 0xffff0000u); }
__device__ __forceinline__ float wave_sum(float v) {
#pragma unroll
    for (int o = 1; o < 64; o <<= 1) v += __shfl_xor(v, o);
    return v;
}
__device__ __forceinline__ void wave_sum4(float (&v)[4]) {
#pragma unroll
    for (int o = 1; o < 64; o <<= 1) {
#pragma unroll
        for (int r = 0; r < 4; ++r) v[r] += __shfl_xor(v[r], o);
    }
}
__device__ __forceinline__ int opaque(int x) { asm volatile("" : "+v"(x)); return x; }
__device__ __forceinline__ bf16x4 tr_read(const LAS unsigned char* p) { return __builtin_amdgcn_ds_read_tr16_b64_v4i16((LAS bf16x4*)p); }
__device__ __forceinline__ bf16x8 cat4(bf16x4 a, bf16x4 b) { return (bf16x8){a[0], a[1], a[2], a[3], b[0], b[1], b[2], b[3]}; }
__device__ __forceinline__ bf16x8 as_bf16x8(u32x4 v) { return __builtin_bit_cast(bf16x8, v); }

#define XB_TMO      128
#define XB_XCNT(j)  (256  + 64 * (j))
#define XB_XSUB(j)  (1280 + 64 * (j))
#define XB_XGEN(j)  (2304 + 64 * (j))
#define XB_TOP      3328
#define XB_TOPGEN   3392
#define XCD_BAR_WORDS 3456
#define XB_SPIN_CAP (1u << 18)
__device__ __forceinline__ unsigned xb_ld(unsigned* p)              { return __hip_atomic_load(p, __ATOMIC_RELAXED, __HIP_MEMORY_SCOPE_AGENT); }
__device__ __forceinline__ unsigned xb_add(unsigned* p, unsigned v) { return __hip_atomic_fetch_add(p, v, __ATOMIC_RELAXED, __HIP_MEMORY_SCOPE_AGENT); }
__device__ __forceinline__ unsigned xb_xcc_id() { return (unsigned)__builtin_amdgcn_s_getreg((3 << 11) | 20) & 0xFu; }
#define XB_SPIN(cond, bar) do { unsigned _sp = 0; while (cond) { __builtin_amdgcn_s_sleep(1); \
    if ((++_sp & 255u) == 0u) { if (xb_ld(&(bar)[XB_TMO])) break; if (_sp > XB_SPIN_CAP) { atomicAdd(&(bar)[XB_TMO], 1u); break; } } } } while (0)
struct XcdBarrier { unsigned* bar; unsigned x; volatile LAS unsigned* st; };
__device__ __forceinline__ XcdBarrier xcd_barrier_post(unsigned* bar, volatile LAS unsigned* st) {
    XcdBarrier b; b.bar = bar; b.x = xb_xcc_id(); b.st = st;
    if (threadIdx.x == 0) (void)xb_add(&bar[XB_XCNT(b.x)], 1u);
    return b;
}
__device__ __forceinline__ void xcd_barrier_complete(unsigned* bar, unsigned x, unsigned& nloc, unsigned& nx) {
    const unsigned G = gridDim.x * gridDim.y * gridDim.z;
    unsigned sum, cnt, mine, sp = 0u;
    for (;;) {
        sum = 0u; cnt = 0u; mine = 0u;
#pragma unroll
        for (unsigned j = 0; j < 16; ++j) { const unsigned c = xb_ld(&bar[XB_XCNT(j)]); sum += c; cnt += (c > 0u) ? 1u : 0u; mine = (j == x) ? c : mine; }
        if (sum == G) break;
        __builtin_amdgcn_s_sleep(1);
        if ((++sp & 255u) == 0u) { if (xb_ld(&bar[XB_TMO])) break; if (sp > XB_SPIN_CAP) { atomicAdd(&bar[XB_TMO], 1u); break; } }
    }
    nloc = mine > 0u ? mine : 1u; nx = cnt > 0u ? cnt : 1u;
}
__device__ __forceinline__ void xcd_barrier(const XcdBarrier& b) {
    asm volatile("s_waitcnt vmcnt(0)" ::: "memory");
    __syncthreads();
    if (threadIdx.x == 0) {
        unsigned* bar = b.bar;
        __builtin_amdgcn_s_waitcnt(0);
        unsigned nloc = b.st[0], nx = b.st[1];
        if (nloc == 0u) { xcd_barrier_complete(bar, b.x, nloc, nx); b.st[0] = nloc; b.st[1] = nx; }
        const unsigned old = xb_add(&bar[XB_XSUB(b.x)], 1u);
        const unsigned gen = old / nloc;
        if (old + 1u == (gen + 1u) * nloc) {
            __builtin_amdgcn_fence(__ATOMIC_RELEASE, "agent");
            asm volatile("s_waitcnt vmcnt(0)" ::: "memory");
            const unsigned og = xb_add(&bar[XB_TOP], 1u);
            const unsigned tg = og / nx;
            if (og + 1u == (tg + 1u) * nx) xb_add(&bar[XB_TOPGEN], 1u);
            else XB_SPIN(xb_ld(&bar[XB_TOPGEN]) == tg, bar);
            __builtin_amdgcn_fence(__ATOMIC_ACQUIRE, "agent");
            xb_add(&bar[XB_XGEN(b.x)], 1u);
            asm volatile("s_waitcnt vmcnt(0)" ::: "memory");
        } else {
            XB_SPIN(xb_ld(&bar[XB_XGEN(b.x)]) == gen, bar);
            __builtin_amdgcn_fence(__ATOMIC_ACQUIRE, "agent");
            asm volatile("s_waitcnt vmcnt(0)" ::: "memory");
        }
    }
    __syncthreads();
}

namespace pg8 {
constexpr int BM = 256, BK = 64, HALF = 128, HTB = HALF * BK * 2, STAGE_BYTES = 8 * HTB, NXCD = 8, WGM = 8;
__host__ __device__ __forceinline__ int lds_byte(int r, int c) { const int st = (r >> 4) * 2 + (c >> 5), rr = r & 15, cc = c & 31, ob = rr * 64 + cc * 2; return st * 1024 + (ob ^ (((ob >> 9) & 1) << 5)); }
__host__ __device__ __forceinline__ void stage_rc(int b, int& R, int& C) { const int st = b / 1024, sb = b % 1024, swz = sb ^ (((sb >> 9) & 1) << 5); R = (st >> 1) * 16 + swz / 64; C = (st & 1) * 32 + (swz % 64) / 2; }
__host__ __device__ __forceinline__ int perm32(int rho) { const int n = rho >> 4, i = rho & 15; return 8 * (i >> 2) + 4 * n + (i & 3); }

struct Unit { int pm, pn, e, cnt; };

struct StaticOrder {
    int nM, nN, nwg, G, c;
    __device__ void init(int M, int N, int G_, int c_) { nM = M / BM; nN = N / BM; nwg = nM * nN; G = G_; c = c_; }
    __device__ bool next(int i, Unit& u) const {
        const long L = (long)i * G + c; if (L >= nwg) return false;
        int wgid = (int)L; { const int q = nwg / NXCD, r = nwg % NXCD, xcd = wgid % NXCD, off = wgid / NXCD; wgid = (xcd < r ? xcd * (q + 1) : r * (q + 1) + (xcd - r) * q) + off; }
        const int nig = WGM * nN, gid = wgid / nig, fm = gid * WGM, gsz = (nM - fm) < WGM ? (nM - fm) : WGM;
        u.pm = fm + ((wgid % nig) % gsz); u.pn = (wgid % nig) / gsz; u.e = 0; u.cnt = 256; return true;
    }
};
struct DenseSched {
    static constexpr bool GATHER = false;
    const char* A; const char* Bt; int K; StaticOrder ord;
    __device__ __forceinline__ bool next(int i, Unit& u) const { return ord.next(i, u); }
    __device__ __forceinline__ const char* a_ptr(const Unit& u) const { return A + (size_t)u.pm * BM * K * 2; }
    __device__ __forceinline__ const char* b_ptr(const Unit& u) const { return Bt + (size_t)u.pn * BM * K * 2; }
    __device__ __forceinline__ void a_voff(const Unit&, unsigned (&)[2][2], int, int, int, int) const {}
};

template <class Epi, class Sched, bool ALIGN_EPI = true>
__device__ __forceinline__ void gemm_phase(LAS unsigned char* lds, const int K, const Sched& S, const Epi& E) {
    const int tid = threadIdx.x, wid = __builtin_amdgcn_readfirstlane(tid >> 6), lane = tid & 63, wr = wid >> 2, wc = wid & 3, fr = lane & 15, fq = lane >> 4;
    const int nt = K / BK;
    unsigned voffA[2], voffB[2]; int RA[2], CA[2];
#pragma unroll
    for (int i = 0; i < 2; ++i) { int R, C; stage_rc(tid * 16 + i * 8192, R, C); const int Rb = Epi::PERM ? ((R & ~31) + perm32(R & 31)) : R;
        RA[i] = R; CA[i] = C; voffA[i] = (unsigned)(R * K + C) * 2u; voffB[i] = (unsigned)(Rb * K + C) * 2u; }
    const size_t kstep = (size_t)(BK * 2);
    const size_t hstep = (size_t)HALF * K * 2;
    const unsigned ldsw = (unsigned)wid * 1024u;
    const int aoff = lds_byte(wr * 64 + fr, fq * 8), boff = lds_byte(wc * 32 + fr, fq * 8);
#define PG8_SA(b, h) (((b) * 2 + (h)) * HTB)
#define PG8_SB(b, h) ((4 + (b) * 2 + (h)) * HTB)
#define PG8_STAGE(bufoff, gbase, voff) do { _Pragma("unroll") for (int _i = 0; _i < 2; ++_i) \
        __builtin_amdgcn_global_load_lds((const unsigned*)((const char*)(gbase) + (voff)[_i]), (LAS unsigned*)(lds + (bufoff) + ldsw + _i * 8192), 16, 0, 0); } while (0)
#define PG8_STAGE_A(b, h, ptr, gv) do { if constexpr (Sched::GATHER) { PG8_STAGE(PG8_SA(b, h), ptr, gv[h]); } else { PG8_STAGE(PG8_SA(b, h), (ptr) + ((h) ? hstep : 0), voffA); } } while (0)
#define PG8_LDA(dst, b, h) do { _Pragma("unroll") for (int m = 0; m < 4; ++m) _Pragma("unroll") for (int k = 0; k < 2; ++k) dst[m][k] = *(const LAS bf16x8*)(lds + PG8_SA(b, h) + aoff + m * 2048 + k * 1024); } while (0)
#define PG8_LDB(dst, b, h) do { _Pragma("unroll") for (int n = 0; n < 2; ++n) _Pragma("unroll") for (int k = 0; k < 2; ++k) dst[n][k] = *(const LAS bf16x8*)(lds + PG8_SB(b, h) + boff + n * 2048 + k * 1024); } while (0)
#define PG8_MMA(ai, bj, At, Bt) do { __builtin_amdgcn_s_setprio(1); _Pragma("unroll") for (int m = 0; m < 4; ++m) _Pragma("unroll") for (int n = 0; n < 2; ++n) _Pragma("unroll") for (int k = 0; k < 2; ++k) \
        acc[ai][bj][m][n] = __builtin_amdgcn_mfma_f32_16x16x32_bf16(Bt[n][k], At[m][k], acc[ai][bj][m][n], 0, 0, 0); __builtin_amdgcn_s_setprio(0); } while (0)
#define PG8_WAIT_V(n) asm volatile("s_waitcnt vmcnt(" #n ")" ::: "memory")
#define PG8_WAIT_L(n) asm volatile("s_waitcnt lgkmcnt(" #n ")" ::: "memory")
#define PG8_BAR __builtin_amdgcn_s_barrier()
#define PG8_SCHED __builtin_amdgcn_sched_barrier(0)
    Unit cur, nxt; int ui = 0;
    if (!S.next(0, cur)) return;
    f32x4 acc[2][2][4][2];
#pragma unroll
    for (int a = 0; a < 2; ++a)
#pragma unroll
        for (int b = 0; b < 2; ++b)
#pragma unroll
            for (int m = 0; m < 4; ++m)
#pragma unroll
                for (int n = 0; n < 2; ++n) acc[a][b][m][n] = (f32x4){0.f, 0.f, 0.f, 0.f};
    bf16x8 At[4][2], B0[2][2], B1[2][2];
    unsigned cv[2][2], nv[2][2];
    const char* cA = S.a_ptr(cur); const char* cB = S.b_ptr(cur);
    if constexpr (Sched::GATHER) { S.a_voff(cur, cv, RA[0], RA[1], CA[0], CA[1]);
#pragma unroll
        for (int h = 0; h < 2; ++h)
#pragma unroll
            for (int i = 0; i < 2; ++i) nv[h][i] = cv[h][i]; }
    PG8_STAGE(PG8_SB(0, 0), cB, voffB); PG8_STAGE(PG8_SB(0, 1), cB + hstep, voffB); PG8_STAGE_A(0, 0, cA, cv); PG8_STAGE_A(0, 1, cA, cv);
    if (wr == 1) PG8_BAR;
    PG8_WAIT_V(2); PG8_BAR;
    PG8_STAGE(PG8_SB(1, 0), cB + kstep, voffB); PG8_STAGE_A(1, 0, cA + kstep, cv); PG8_STAGE(PG8_SB(1, 1), cB + hstep + kstep, voffB);
    PG8_WAIT_V(6); PG8_BAR;
    for (;;) {
        const bool has_next = S.next(ui + 1, nxt);
        const char* nA = has_next ? S.a_ptr(nxt) : cA; const char* nB = has_next ? S.b_ptr(nxt) : cB;
        if constexpr (Sched::GATHER) { if (has_next) S.a_voff(nxt, nv, RA[0], RA[1], CA[0], CA[1]); }
        for (int t = 0; t < nt; t += 2) {
            const bool last = (t == nt - 2);
            const char* a1 = cA + (size_t)(t + 1) * kstep;
            const char* a2 = last ? nA : cA + (size_t)(t + 2) * kstep; const char* b2 = last ? nB : cB + (size_t)(t + 2) * kstep;
            const char* a3 = a2 + kstep; const char* b3 = b2 + kstep;
            unsigned v2[2][2];
            if constexpr (Sched::GATHER) {
#pragma unroll
                for (int h = 0; h < 2; ++h)
#pragma unroll
                    for (int i = 0; i < 2; ++i) v2[h][i] = last ? nv[h][i] : cv[h][i]; }
            PG8_LDB(B0, 0, 0); PG8_LDB(B1, 0, 1); PG8_SCHED; PG8_LDA(At, 0, 0); PG8_STAGE_A(1, 1, a1, cv);
            PG8_WAIT_V(8); PG8_WAIT_L(0); PG8_BAR; PG8_MMA(0, 0, At, B0); PG8_MMA(0, 1, At, B1); PG8_BAR; PG8_SCHED;
            PG8_LDA(At, 0, 1); PG8_STAGE(PG8_SB(0, 0), b2, voffB); PG8_STAGE(PG8_SB(0, 1), b2 + hstep, voffB); PG8_STAGE_A(0, 0, a2, v2);
            PG8_WAIT_V(8); PG8_WAIT_L(0); PG8_BAR; PG8_MMA(1, 0, At, B0); PG8_MMA(1, 1, At, B1); PG8_BAR; PG8_SCHED;
            PG8_LDB(B0, 1, 0); PG8_LDB(B1, 1, 1); PG8_SCHED; PG8_LDA(At, 1, 0); PG8_STAGE_A(0, 1, a2, v2);
            PG8_WAIT_V(8); PG8_WAIT_L(0); PG8_BAR; PG8_MMA(0, 0, At, B0); PG8_MMA(0, 1, At, B1); PG8_BAR; PG8_SCHED;
            PG8_LDA(At, 1, 1); PG8_STAGE(PG8_SB(1, 0), b3, voffB); PG8_STAGE(PG8_SB(1, 1), b3 + hstep, voffB); PG8_STAGE_A(1, 0, a3, v2);
            PG8_WAIT_V(8); PG8_WAIT_L(0); PG8_BAR; PG8_MMA(1, 0, At, B0); PG8_MMA(1, 1, At, B1); PG8_BAR; PG8_SCHED;
        }
        if constexpr (ALIGN_EPI) { if (wr == 0) PG8_BAR; }
        E(acc, cur, wr, wc, fr, fq);
        if (!has_next) break;
#pragma unroll
        for (int a = 0; a < 2; ++a)
#pragma unroll
            for (int b = 0; b < 2; ++b)
#pragma unroll
                for (int m = 0; m < 4; ++m)
#pragma unroll
                    for (int n = 0; n < 2; ++n) acc[a][b][m][n] = (f32x4){0.f, 0.f, 0.f, 0.f};
        cur = nxt; cA = nA; cB = nB; ++ui;
        if constexpr (Sched::GATHER) {
#pragma unroll
            for (int h = 0; h < 2; ++h)
#pragma unroll
                for (int i = 0; i < 2; ++i) cv[h][i] = nv[h][i]; }
        if constexpr (ALIGN_EPI) { if (wr == 1) PG8_BAR; }
    }
    PG8_WAIT_V(0);
    if constexpr (!ALIGN_EPI) { if (wr == 0) PG8_BAR; }
    PG8_BAR;
#undef PG8_SA
#undef PG8_SB
#undef PG8_STAGE
#undef PG8_STAGE_A
#undef PG8_LDA
#undef PG8_LDB
#undef PG8_MMA
#undef PG8_WAIT_V
#undef PG8_WAIT_L
#undef PG8_BAR
#undef PG8_SCHED
}
}

struct Args { const float* in[24]; float* out; unsigned char* ws; int ph_lo, ph_hi, li, pad; };
struct Frame {
    LAS unsigned char* lds;
    unsigned* ctl;
    int tid, lane, wave, vcu, G;
    unsigned char* ws;
};

#define AMP_SPIN(k) do { if (PROBE_AMP == (k)) { __syncthreads(); const unsigned long long t0_ = *(volatile LAS unsigned long long*)(F.lds + MISC_OFF + 32), t1_ = __builtin_amdgcn_s_memrealtime(), tg_ = t1_ + 3ull * (t1_ - t0_); \
            while (__builtin_amdgcn_s_memrealtime() < tg_) __builtin_amdgcn_s_sleep(20); __syncthreads(); } \
        if (PROBE_AMP >= 0) { if (F.tid == 0) *(volatile LAS unsigned long long*)(F.lds + MISC_OFF + 32) = __builtin_amdgcn_s_memrealtime(); } } while (0)

__device__ __forceinline__ int rowmap(int mode, int n) { return mode == 0 ? n : ((n >> 7) * 256 + (n & 127) + (mode == 2 ? 128 : 0)); }
__device__ __forceinline__ void p0_transpose_item(const float* W, int K, int N, bf16* WT, int mode, LAS float* scr, int item, int lane) {
    const int nblk = (N + 31) / 32, kb = item / nblk, nb = item % nblk, k0 = 64 * kb, n0 = 32 * nb;
    const int nn = n0 + (lane & 31); const bool ok = nn < N;
#pragma unroll 8
    for (int i = 0; i < 32; ++i) { const int kk = 2 * i + (lane >> 5); scr[kk * 33 + (lane & 31)] = ok ? W[(size_t)(k0 + kk) * N + nn] : 0.f; }
    LDS_WAIT(); asm volatile("" ::: "memory");
    const int c = lane & 7;
#pragma unroll
    for (int j = 0; j < 4; ++j) { const int n = (lane >> 3) + 8 * j; const LAS float* s = scr + (8 * c) * 33 + n;
        u32x4 o; o.x = cvt_pk_bf16(s[0 * 33], s[1 * 33]); o.y = cvt_pk_bf16(s[2 * 33], s[3 * 33]); o.z = cvt_pk_bf16(s[4 * 33], s[5 * 33]); o.w = cvt_pk_bf16(s[6 * 33], s[7 * 33]);
        if (n0 + n < N) *(u32x4*)(WT + (size_t)rowmap(mode, n0 + n) * K + k0 + 8 * c) = o; }
    LDS_WAIT(); asm volatile("" ::: "memory");
}
__device__ __forceinline__ void p0_prologue(Frame& F, const Args& a) {
    const int gw = F.vcu * 8 + F.wave, NGW = F.G * 8, lane = F.lane, tid = F.tid;
    float* ada = (float*)(F.ws + WS_ADA);
    {
        LAS float* sS = (LAS float*)F.lds;
        LAS float* sP = (LAS float*)(F.lds + 36864);
        bool staged = false;
        for (int it = blockIdx.x; it < 192; it += F.G) {
            if (!staged) {
                for (int i = tid; i < 9 * 1024; i += 512) { const int r = i >> 10, k = i & 1023; const float v = r < 8 ? a.in[1][r * 1024 + k] : a.in[3][k]; sS[i] = v / (1.f + __expf(-v)); }
                staged = true;
            }
            __syncthreads();
            const int n = it * 32 + (lane & 31), kh = lane >> 5, kb = F.wave * 128;
            float acc[9];
#pragma unroll
            for (int r = 0; r < 9; ++r) acc[r] = 0.f;
            const float* W = a.in[4];
#pragma unroll 4
            for (int j = 0; j < 64; ++j) { const int k = kb + 2 * j + kh; const float w = W[(size_t)k * 6144 + n];
#pragma unroll
                for (int r = 0; r < 9; ++r) acc[r] += sS[r * 1024 + k] * w; }
#pragma unroll
            for (int r = 0; r < 9; ++r) { acc[r] += __shfl_xor(acc[r], 32); if (lane < 32) sP[(F.wave * 9 + r) * 32 + lane] = acc[r]; }
            __syncthreads();
            if (tid < 288) { const int r = tid >> 5, c = tid & 31; float s = a.in[5][it * 32 + c];
#pragma unroll
                for (int w = 0; w < 8; ++w) s += sP[(w * 9 + r) * 32 + c];
                ada[r * 6144 + it * 32 + c] = s; }
        }
        __syncthreads();
    }
    { float* rope = (float*)(F.ws + WS_ROPE);
      for (int i = blockIdx.x * 512 + tid; i < 128 * 32; i += F.G * 512) { const int pos = i >> 5, j = i & 31; const double ang = (double)pos * pow(10000.0, -(double)j / 32.0);
          rope[2 * i] = (float)cos(ang); rope[2 * i + 1] = (float)sin(ang); } }
    { bf16* wr = (bf16*)(F.ws + WS_WR);
      for (int i = blockIdx.x * 512 + tid; i < 80 * 1024; i += F.G * 512) { const int r = i >> 10, k = i & 1023; float v = 0.f;
          if (r < 8) v = a.in[15][k * 8 + r]; else if (r >= 16) v = a.in[17][k * 64 + (r - 16)];
          wr[i] = (bf16)(cvt_pk_bf16(v, 0.f) & 0xffffu); } }
    LAS float* scr = (LAS float*)(F.lds + 49152 + F.wave * 8448);
    constexpr int I_IN = 16 * 113, I_OUT = 16 * 32, I_E = 256;
    constexpr int NITEMS = I_IN + I_OUT + 3 * NEXP * I_E;
    for (int it = gw; it < NITEMS; it += NGW) {
        int r = it;
        if (r < I_IN) { p0_transpose_item(a.in[6], 1024, IN_COLS, (bf16*)(F.ws + WS_WIN), 0, scr, r, lane); continue; } r -= I_IN;
        if (r < I_OUT) { p0_transpose_item(a.in[12], 1024, 1024, (bf16*)(F.ws + WS_WOUT), 0, scr, r, lane); continue; } r -= I_OUT;
        if (r < NEXP * I_E) { const int e = r >> 8; p0_transpose_item(a.in[19] + (size_t)e * 1024 * 512, 1024, 512, (bf16*)(F.ws + WS_W13) + (size_t)e * 1024 * 1024, 1, scr, r & 255, lane); continue; } r -= NEXP * I_E;
        if (r < NEXP * I_E) { const int e = r >> 8; p0_transpose_item(a.in[20] + (size_t)e * 1024 * 512, 1024, 512, (bf16*)(F.ws + WS_W13) + (size_t)e * 1024 * 1024, 2, scr, r & 255, lane); continue; } r -= NEXP * I_E;
        { const int e = r >> 8; p0_transpose_item(a.in[21] + (size_t)e * 512 * 1024, 512, 1024, (bf16*)(F.ws + WS_W2) + (size_t)e * 1024 * 512, 0, scr, r & 255, lane); }
    }
}

__device__ __forceinline__ void p1_ln_mod(Frame& F, const Args& a) {
    const int lane = F.lane, g = lane >> 4, lq = lane & 15;
    const float* ada = (const float*)(F.ws + WS_ADA);
    bf16* XM = (bf16*)(F.ws + WS_XM); float* GT = (float*)(F.ws + WS_GATES);
    const bf16* WG = (const bf16*)(F.ws + WS_WIN) + (size_t)3584 * 1024;
    const f32x4 gb = *(const f32x4*)(a.in[9] + 4 * g);
    const int RPB = (((MT + F.G - 1) / F.G) + 15) & ~15;
    const int rb0 = F.vcu * RPB, rb1 = rb0 + RPB < MT ? rb0 + RPB : MT;
    for (int m0 = rb0 + F.wave; m0 < rb1; m0 += 32) {
        f32x4 v[4][4]; float s[4]; bool ok[4]; int mm[4];
#pragma unroll
        for (int r = 0; r < 4; ++r) { const int m = m0 + 8 * r; ok[r] = m < rb1; mm[r] = ok[r] ? m : m0;
            const f32x4* xr = (const f32x4*)(mm[r] < ML_ROWS ? a.in[0] + (size_t)mm[r] * DM : a.in[2] + (size_t)(mm[r] - ML_ROWS) * DM) + lane;
#pragma unroll
            for (int j = 0; j < 4; ++j) v[r][j] = xr[64 * j]; }
#pragma unroll
        for (int r = 0; r < 4; ++r) { s[r] = 0.f;
#pragma unroll
            for (int j = 0; j < 4; ++j) s[r] += (v[r][j].x + v[r][j].y) + (v[r][j].z + v[r][j].w); }
        wave_sum4(s);
#pragma unroll
        for (int r = 0; r < 4; ++r) { const float mean = s[r] * (1.f / DM); s[r] = 0.f;
#pragma unroll
            for (int j = 0; j < 4; ++j) { v[r][j] = v[r][j] - mean; s[r] += (v[r][j].x * v[r][j].x + v[r][j].y * v[r][j].y) + (v[r][j].z * v[r][j].z + v[r][j].w * v[r][j].w); } }
        wave_sum4(s);
#pragma unroll
        for (int r = 0; r < 4; ++r) {
            const float rstd = 1.f / sqrtf(s[r] * (1.f / DM) + LN_EPS);
            const int ab = mm[r] < ML_ROWS ? (mm[r] >> 13) : 8;
            const f32x4* sh = (const f32x4*)(ada + ab * 6144) + lane; const f32x4* sc = sh + 256;
            u32x2* o8 = (u32x2*)(XM + (size_t)mm[r] * DM) + lane;
            if (ok[r]) {
#pragma unroll
                for (int j = 0; j < 4; ++j) { const f32x4 h = sh[64 * j], c = sc[64 * j]; const f32x4 y = (v[r][j] * rstd) * (c + 1.f) + h;
                    o8[64 * j] = (u32x2){cvt_pk_bf16(y.x, y.y), cvt_pk_bf16(y.z, y.w)}; } }
        }
    }
    VM_WAIT(); __syncthreads();
    for (int row0 = rb0 + 16 * F.wave; row0 < rb1; row0 += 128) {
        f32x4 ga = (f32x4){0.f, 0.f, 0.f, 0.f};
        const bf16* xp = XM + (size_t)(row0 + lq) * 1024 + 8 * g; const bf16* wp = WG + (size_t)lq * 1024 + 8 * g;
#pragma unroll 8
        for (int kk = 0; kk < 32; ++kk) ga = __builtin_amdgcn_mfma_f32_16x16x32_bf16(*(const bf16x8*)(wp + 32 * kk), __builtin_nontemporal_load((const bf16x8*)(xp + 32 * kk)), ga, 0, 0, 0);
        *(f32x4*)(GT + (size_t)(row0 + lq) * 16 + 4 * g) = ga + gb;
    }
}

struct EpiZ {
    static constexpr bool PERM = true;
    unsigned char* ws; const float* gate_b;
    __device__ __forceinline__ void operator()(const f32x4 (&acc)[2][2][4][2], const pg8::Unit& u, int wr, int wc, int fr, int fq) const {
        const int row0 = u.pm * 256 + wr * 64 + fr;
        {
            bf16* base; int ldc, colt;
            if (u.pn < 6) { base = (bf16*)(ws + WS_ZA); ldc = 1536; colt = u.pn * 256; }
            else if (u.pn < 10) { base = (bf16*)(ws + WS_ZQK); ldc = 1024; colt = (u.pn - 6) * 256; }
            else if (u.pn < 12) { base = (bf16*)(ws + WS_ZV); ldc = 512; colt = (u.pn - 10) * 256; }
            else { base = (bf16*)(ws + WS_ZO); ldc = 512; colt = (u.pn - 12) * 256; }
            const int col0 = colt + wc * 32 + 8 * fq;
#pragma unroll
            for (int ai = 0; ai < 2; ++ai)
#pragma unroll
                for (int m = 0; m < 4; ++m) { bf16* rowp = base + (size_t)(row0 + ai * 128 + m * 16) * ldc + col0;
#pragma unroll
                    for (int bj = 0; bj < 2; ++bj) { const f32x4 v0 = acc[ai][bj][m][0], v1 = acc[ai][bj][m][1];
                        u32x4 w; w.x = cvt_pk_bf16(v0[0], v0[1]); w.y = cvt_pk_bf16(v0[2], v0[3]); w.z = cvt_pk_bf16(v1[0], v1[1]); w.w = cvt_pk_bf16(v1[2], v1[3]);
                        *(u32x4*)(rowp + bj * 128) = w; } }
        }
    }
};

__device__ __forceinline__ void p3_qkprep(Frame& F, const Args& a) {
    const int lane = F.lane, half = F.wave & 1;
    const int gwh = (F.vcu * 8 + F.wave) >> 1, NGH = F.G * 4;
    const bf16* ZQK = (const bf16*)(F.ws + WS_ZQK); bf16* QKP = (bf16*)(F.ws + WS_XM);
    const float* rope = (const float*)(F.ws + WS_ROPE);
    const int ch0 = half * 512 + 8 * lane, i0 = 8 * (lane & 3);
    const bool col_rot = ((lane >> 3) & 1) != 0, second = ((lane >> 2) & 1) != 0;
    float w[5][8], bia[8];
#pragma unroll
    for (int j = 0; j < 5; ++j) { const f32x4 w0 = *(const f32x4*)(a.in[7] + j * 1024 + ch0), w1 = *(const f32x4*)(a.in[7] + j * 1024 + ch0 + 4);
#pragma unroll
        for (int e = 0; e < 4; ++e) { w[j][e] = w0[e]; w[j][4 + e] = w1[e]; } }
    { const f32x4 b0 = *(const f32x4*)(a.in[8] + ch0), b1 = *(const f32x4*)(a.in[8] + ch0 + 4);
#pragma unroll
      for (int e = 0; e < 4; ++e) { bia[e] = b0[e]; bia[4 + e] = b1[e]; } }
    float cst[8], sst[8];
#pragma unroll
    for (int q = 0; q < 4; ++q) { const f32x4 t = *(const f32x4*)(rope + (size_t)(32 + i0 + 2 * q) * 2);
        cst[2 * q] = col_rot ? t.x : 1.f; sst[2 * q] = col_rot ? t.y : 0.f; cst[2 * q + 1] = col_rot ? t.z : 1.f; sst[2 * q + 1] = col_rot ? t.w : 0.f; }
    const float ksc = half ? 0.08838834764831845f : 1.f;
    constexpr int RUN = 8, NITEM = MT / RUN;
    for (int it = gwh; it < NITEM; it += NGH) {
        const int row0 = it * RUN;
        const bool lat = row0 < ML_ROWS;
        const int T = lat ? SEQ : CTXL, s0 = lat ? (row0 & (SEQ - 1)) : ((row0 - ML_ROWS) & (CTXL - 1));
        u32x4 win[12];
#pragma unroll
        for (int j = 0; j < 12; ++j) { const int s = s0 + j - 2; const bool ok = s >= 0 && s < T;
            win[j] = ok ? *(const u32x4*)(ZQK + (size_t)(row0 + j - 2) * 1024 + ch0) : (u32x4){0u, 0u, 0u, 0u}; }
        float cc[8], ss[8];
        if (lat) { const int pos = col_rot ? (s0 & 63) : (s0 >> 6);
#pragma unroll
            for (int q = 0; q < 4; ++q) { const f32x4 t = *(const f32x4*)(rope + (size_t)(pos * 32 + i0 + 2 * q) * 2); cc[2 * q] = t.x; ss[2 * q] = t.y; cc[2 * q + 1] = t.z; ss[2 * q + 1] = t.w; }
        } else {
#pragma unroll
            for (int e = 0; e < 8; ++e) { cc[e] = 1.f; ss[e] = 0.f; }
        }
#pragma unroll
        for (int r = 0; r < RUN; ++r) {
            float u[8];
#pragma unroll
            for (int e = 0; e < 8; ++e) u[e] = bia[e];
#pragma unroll
            for (int j = 0; j < 5; ++j)
#pragma unroll
                for (int q = 0; q < 4; ++q) { const unsigned x = win[r + j][q]; u[2 * q] += w[j][2 * q] * bf_lo(x); u[2 * q + 1] += w[j][2 * q + 1] * bf_hi(x); }
            u32x4 o;
            float v[8];
#pragma unroll
            for (int e = 0; e < 8; ++e) { const float sv = u[e] * __builtin_amdgcn_rcpf(1.f + __expf(-u[e])); const float ot = __shfl_xor(sv, 4);
                v[e] = (sv * cc[e] + ot * (second ? ss[e] : -ss[e])) * ksc; }
#pragma unroll
            for (int q = 0; q < 4; ++q) o[q] = cvt_pk_bf16(v[2 * q], v[2 * q + 1]);
            *(u32x4*)(QKP + (size_t)(row0 + r) * 1024 + ch0) = o;
            if (lat && r + 1 < RUN) {
#pragma unroll
                for (int e = 0; e < 8; ++e) { const float c2 = cc[e] * cst[e] - ss[e] * sst[e], s2 = ss[e] * cst[e] + cc[e] * sst[e]; cc[e] = c2; ss[e] = s2; }
            }
        }
    }
}

constexpr int NA_VR = 0, NA_VC = 81920, NA_KC = 114688, NA_RPB = 147456;
static_assert(NA_RPB + 2048 <= PH_BYTES, "NA LDS");
__device__ __forceinline__ int na_r0(int r) { return r - 4 < 0 ? 0 : (r - 4 > 120 ? 120 : r - 4); }
__device__ __forceinline__ void p3_na(Frame& F, const Args& a) {
    const int w = F.wave, lane = F.lane, tid = F.tid, cg = w & 3, rsel = w >> 2, g = lane >> 4, lq = lane & 15, qp = lq >> 2, pp = lane & 3;
    const bf16* ZA = (const bf16*)(F.ws + WS_ZA); bf16* MIX = (bf16*)(F.ws + WS_MIX);
    LAS unsigned char* VR = F.lds + NA_VR; LAS unsigned char* VC = F.lds + NA_VC; LAS unsigned char* KC = F.lds + NA_KC; LAS float* RPB = (LAS float*)(F.lds + NA_RPB);
    const int cs = cg == 0 ? 0 : (cg == 1 ? 8 : (cg == 2 ? 24 : 32));
    const int qc = 16 * cg + lq, c0q = qc - 8 < 0 ? 0 : (qc - 8 > 48 ? 48 : qc - 8);
    const int sw = (4 * g + qp) & 7;
    unsigned voff[4], koff[2];
#pragma unroll
    for (int dt = 0; dt < 4; ++dt) voff[dt] = (unsigned)((((2 * dt + (pp >> 1)) ^ sw) * 16) + 8 * (pp & 1) + (4 * g + qp) * 128);
#pragma unroll
    for (int kk = 0; kk < 2; ++kk) koff[kk] = (unsigned)(lq * 128 + (((4 * kk + g) ^ ((lq >> 1) & 7)) * 16));
    unsigned cooff[2][4];
#pragma unroll
    for (int tt = 0; tt < 2; ++tt)
#pragma unroll
        for (int j = 0; j < 4; ++j) { const int kc = cs + 16 * tt + 4 * g + j; const bool valid = kc >= c0q && kc < c0q + 16; cooff[tt][j] = (unsigned)((valid ? kc - qc + 15 : 31) * 4); }
    const float CE = 0.125f * 1.4426950408889634f;
    const int sc = tid >> 3, sch = tid & 7;
    for (int su = blockIdx.x; su < 256; su += F.G) {
        const int bh = su >> 2, head = bh & 7, b = bh >> 3, R0 = (su & 3) * 32;
        __syncthreads();
#pragma unroll
        for (int i = 0; i < 4; ++i) { const int idx = tid + 512 * i, key = idx >> 3, ch = idx & 7; const bf16* src = ZA + ((size_t)(ML_ROWS + b * CTXL + key)) * 1536 + head * 64 + ch * 8;
            *(LAS u32x4*)(KC + key * 128 + ((ch ^ ((key >> 1) & 7)) * 16)) = *(const u32x4*)(src + 512);
            *(LAS u32x4*)(VC + key * 128 + ((ch ^ (key & 7)) * 16)) = *(const u32x4*)(src + 1024); }
        if (tid < 480) { const int rw = tid >> 5, co = tid & 31; RPB[tid] = co < 31 ? 8.f * a.in[10][head * 465 + rw * 31 + co] : -1e30f; }
        int hw = na_r0(R0); const int hi0 = na_r0(R0 + 1) + 8;
        for (int rho = hw; rho < hi0; ++rho) *(LAS u32x4*)(VR + ((rho % 10) * 64 + sc) * 128 + ((sch ^ (sc & 7)) * 16)) = *(const u32x4*)(ZA + ((size_t)(b * SEQ + rho * 64 + sc)) * 1536 + 1024 + head * 64 + sch * 8);
        hw = hi0;
        __syncthreads();
        for (int p = 0; p < 16; ++p) {
            const int ra = R0 + 2 * p, r = ra + rsel, r0 = na_r0(r);
            const int nhi = p < 15 ? na_r0(ra + 3) + 8 : hw, nnew = nhi - hw;
            u32x4 pre0 = (u32x4){0u, 0u, 0u, 0u}, pre1 = pre0;
            if (nnew > 0) pre0 = *(const u32x4*)(ZA + ((size_t)(b * SEQ + hw * 64 + sc)) * 1536 + 1024 + head * 64 + sch * 8);
            if (nnew > 1) pre1 = *(const u32x4*)(ZA + ((size_t)(b * SEQ + (hw + 1) * 64 + sc)) * 1536 + 1024 + head * 64 + sch * 8);
            const size_t qtok = (size_t)b * SEQ + r * 64 + qc;
            bf16x8 qf[2];
#pragma unroll
            for (int kk = 0; kk < 2; ++kk) qf[kk] = *(const bf16x8*)(ZA + qtok * 1536 + head * 64 + 32 * kk + 8 * g);
            f32x4 s[16], o[4];
#pragma unroll
            for (int dt = 0; dt < 4; ++dt) o[dt] = (f32x4){0.f, 0.f, 0.f, 0.f};
#pragma unroll
            for (int t = 0; t < 16; ++t) { f32x4 acc = (f32x4){0.f, 0.f, 0.f, 0.f};
#pragma unroll
                for (int kk = 0; kk < 2; ++kk) acc = __builtin_amdgcn_mfma_f32_16x16x32_bf16(*(const LAS bf16x8*)(KC + t * 2048 + koff[kk]), qf[kk], acc, 0, 0, 0);
                s[t] = acc; }
            float mx = -1e30f;
#pragma unroll
            for (int t = 0; t < 16; ++t) mx = fmaxf(mx, fmaxf(fmaxf(s[t][0], s[t][1]), fmaxf(s[t][2], s[t][3])));
            mx = fmaxf(mx, __shfl_xor(mx, 16)); mx = fmaxf(mx, __shfl_xor(mx, 32));
            float sum = 0.f;
            { const float nm = -mx * CE;
#pragma unroll
              for (int t = 0; t < 16; ++t)
#pragma unroll
                  for (int j = 0; j < 4; ++j) { const float pv = __builtin_amdgcn_exp2f(__builtin_fmaf(s[t][j], CE, nm)); s[t][j] = pv; sum += pv; } }
#pragma unroll
            for (int kp = 0; kp < 8; ++kp) {
                const bf16x8 pf = as_bf16x8((u32x4){cvt_pk_bf16(s[2 * kp][0], s[2 * kp][1]), cvt_pk_bf16(s[2 * kp][2], s[2 * kp][3]), cvt_pk_bf16(s[2 * kp + 1][0], s[2 * kp + 1][1]), cvt_pk_bf16(s[2 * kp + 1][2], s[2 * kp + 1][3])});
                const LAS unsigned char* vr = VC + kp * 4096;
#pragma unroll
                for (int dt = 0; dt < 4; ++dt) o[dt] = __builtin_amdgcn_mfma_f32_16x16x32_bf16(cat4(tr_read(vr + voff[dt]), tr_read(vr + 2048 + voff[dt])), pf, o[dt], 0, 0, 0);
            }
#pragma unroll
            for (int rr = 0; rr < 8; ++rr)
#pragma unroll
                for (int tt = 0; tt < 2; ++tt) {
                    const size_t ktok = (size_t)b * SEQ + (r0 + rr) * 64 + cs + 16 * tt + lq;
                    const bf16* kp = ZA + ktok * 1536 + 512 + head * 64 + 8 * g;
                    const bf16x8 k0 = *(const bf16x8*)kp, k1 = *(const bf16x8*)(kp + 32);
                    const LAS unsigned char* rb = (const LAS unsigned char*)RPB + (r0 + rr - r + 7) * 128;
                    f32x4 acc;
#pragma unroll
                    for (int j = 0; j < 4; ++j) acc[j] = *(const LAS float*)(rb + cooff[tt][j]);
                    acc = __builtin_amdgcn_mfma_f32_16x16x32_bf16(k0, qf[0], acc, 0, 0, 0);
                    acc = __builtin_amdgcn_mfma_f32_16x16x32_bf16(k1, qf[1], acc, 0, 0, 0);
                    s[rr * 2 + tt] = acc;
                }
            float m2 = -1e30f;
#pragma unroll
            for (int t = 0; t < 16; ++t) m2 = fmaxf(m2, fmaxf(fmaxf(s[t][0], s[t][1]), fmaxf(s[t][2], s[t][3])));
            m2 = fmaxf(m2, __shfl_xor(m2, 16)); m2 = fmaxf(m2, __shfl_xor(m2, 32));
            { const float M = fmaxf(mx, m2), al = __builtin_amdgcn_exp2f((mx - M) * CE), nm = -M * CE;
              sum *= al;
#pragma unroll
              for (int dt = 0; dt < 4; ++dt) o[dt] = o[dt] * al;
#pragma unroll
              for (int t = 0; t < 16; ++t)
#pragma unroll
                  for (int j = 0; j < 4; ++j) { const float pv = __builtin_amdgcn_exp2f(__builtin_fmaf(s[t][j], CE, nm)); s[t][j] = pv; sum += pv; } }
            { int slot = r0 % 10;
#pragma unroll
              for (int kp = 0; kp < 8; ++kp) {
                const bf16x8 pf = as_bf16x8((u32x4){cvt_pk_bf16(s[2 * kp][0], s[2 * kp][1]), cvt_pk_bf16(s[2 * kp][2], s[2 * kp][3]), cvt_pk_bf16(s[2 * kp + 1][0], s[2 * kp + 1][1]), cvt_pk_bf16(s[2 * kp + 1][2], s[2 * kp + 1][3])});
                const LAS unsigned char* vr = VR + (slot * 64 + cs) * 128;
#pragma unroll
                for (int dt = 0; dt < 4; ++dt) o[dt] = __builtin_amdgcn_mfma_f32_16x16x32_bf16(cat4(tr_read(vr + voff[dt]), tr_read(vr + 2048 + voff[dt])), pf, o[dt], 0, 0, 0);
                slot = slot == 9 ? 0 : slot + 1;
              } }
            sum += __shfl_xor(sum, 16); sum += __shfl_xor(sum, 32);
            { const float inv = 1.f / sum; bf16* op = MIX + qtok * 1024 + head * 64 + 4 * g;
#pragma unroll
              for (int dt = 0; dt < 4; ++dt) *(u32x2*)(op + 16 * dt) = (u32x2){cvt_pk_bf16(o[dt][0] * inv, o[dt][1] * inv), cvt_pk_bf16(o[dt][2] * inv, o[dt][3] * inv)}; }
            __syncthreads();
            if (nnew > 0) *(LAS u32x4*)(VR + ((hw % 10) * 64 + sc) * 128 + ((sch ^ (sc & 7)) * 16)) = pre0;
            if (nnew > 1) *(LAS u32x4*)(VR + (((hw + 1) % 10) * 64 + sc) * 128 + ((sch ^ (sc & 7)) * 16)) = pre1;
            hw = nhi;
            __syncthreads();
        }
    }
    __syncthreads();
}

constexpr int ML_QS = 0, ML_KS = 34816, ML_VS = 69632, ML_CS = 108544, ML_VEC = 147456;
constexpr int ML_QR = 272, ML_VR = 304;
static_assert(ML_VEC + 5 * 512 + 64 <= PH_BYTES, "mLSTM LDS");
template <bool OUT>
__device__ __forceinline__ void mlstm_unit(Frame& F, const Args& a, const int sc, const int grp  , const bool FINAL) {
    const int w = F.wave, tid = opaque(F.tid), lane = tid & 63, g = lane >> 4, lq = lane & 15, qp = lq >> 2, pp = lane & 3;
    const int dir = sc & 1, head = (sc >> 1) & 3, b = sc >> 3;
    const bf16* QKP = (const bf16*)(F.ws + WS_XM); const bf16* ZV = (const bf16*)(F.ws + WS_ZV); const float* GT = (const float*)(F.ws + WS_GATES);
    bf16* HB = (bf16*)(F.ws + WS_HB);
    float* REC = (float*)(F.ws + WS_MLST) + (size_t)sc * 9 * REC_FLOATS;
    LAS unsigned char* QS = F.lds + ML_QS; LAS unsigned char* KS = F.lds + ML_KS; LAS unsigned char* VS = F.lds + ML_VS; LAS unsigned char* CS = F.lds + ML_CS;
    LAS float* Va = (LAS float*)(F.lds + ML_VEC); LAS float* VA = Va + 128; LAS float* Vem = Va + 256; LAS float* Vin = Va + 384; LAS float* Vw = Va + 512; LAS float* Vs = Va + 640;
    const int nch = grp < 0 ? 2 : 8;
    const int T = grp < 0 ? CTXL : SEQ;
    const size_t rowbase = grp < 0 ? (size_t)ML_ROWS + b * CTXL : (size_t)b * SEQ;
    const int sig0 = grp < 0 ? 0 : grp * 1024;
    const int tt = w < 4 ? w : 11 - w;
    f32x4 Cacc[9];
#pragma unroll
    for (int vt = 0; vt < 9; ++vt) Cacc[vt] = (f32x4){0.f, 0.f, 0.f, 0.f};
    float m_prev = (grp < 0) ? 0.f : -1e30f, bsum = 0.f;
    if constexpr (OUT) {
        const float* R0 = REC;
        m_prev = R0[18432];
#pragma unroll
        for (int vt = 0; vt < 9; ++vt) Cacc[vt] = *(const f32x4*)(R0 + (16 * w + lq) * 144 + 16 * vt + 4 * g);
        for (int j = 0; j < grp; ++j) { const float* R = REC + (size_t)(1 + j) * REC_FLOATS; const float mj = R[18432], Bj = R[18433];
            const float mn = fmaxf(Bj + m_prev, mj), f = __expf(Bj + m_prev - mn), gc = __expf(mj - mn);
#pragma unroll
            for (int vt = 0; vt < 9; ++vt) Cacc[vt] = Cacc[vt] * f + *(const f32x4*)(R + (16 * w + lq) * 144 + 16 * vt + 4 * g) * gc;
            m_prev = mn; }
    }
    __syncthreads();
    if (tid < 384) { const int row = tid / 3, pc = tid % 3; u32x4 v = (u32x4){0u, 0u, 0u, 0u}; if (pc == 0) v.x = 0x3F80u; *(LAS u32x4*)(VS + row * ML_VR + 256 + pc * 16) = v; }
    if constexpr (OUT) {
#pragma unroll
        for (int vt = 0; vt < 9; ++vt) *(LAS u32x2*)(CS + (16 * w + lq) * ML_VR + (16 * vt + 4 * g) * 2) = (u32x2){cvt_pk_bf16(Cacc[vt][0], Cacc[vt][1]), cvt_pk_bf16(Cacc[vt][2], Cacc[vt][3])};
    }
    u32x4 pq[4], pk[4], pv[4]; float gi0 = 0.f, gi1 = 0.f, gf0 = 0.f, gf1 = 0.f;
    const int gcol_i = (2 * dir) * 4 + head, gcol_f = (2 * dir + 1) * 4 + head;
#define ML_TOK(sig) (dir ? (T - 1 - (sig)) : (sig))
#define ML_LOAD(k) do { _Pragma("unroll") for (int j = 0; j < 4; ++j) { const int id = tid + 512 * j, row = id >> 4, ch = id & 15; const size_t gr = rowbase + ML_TOK(sig0 + (k) * 128 + row); \
            if (OUT) pq[j] = *(const u32x4*)(QKP + gr * 1024 + head * 128 + ch * 8); \
            pk[j] = *(const u32x4*)(QKP + gr * 1024 + 512 + head * 128 + ch * 8); pv[j] = *(const u32x4*)(ZV + gr * 512 + head * 128 + ch * 8); } \
        if (w == 0) { const size_t g0 = rowbase + ML_TOK(sig0 + (k) * 128 + 2 * lane), g1 = rowbase + ML_TOK(sig0 + (k) * 128 + 2 * lane + 1); \
            gi0 = GT[g0 * 16 + gcol_i]; gf0 = GT[g0 * 16 + gcol_f]; gi1 = GT[g1 * 16 + gcol_i]; gf1 = GT[g1 * 16 + gcol_f]; } } while (0)
    ML_LOAD(0);
    for (int k = 0; k < nch; ++k) {
#pragma unroll
        for (int j = 0; j < 4; ++j) { const int id = tid + 512 * j, row = id >> 4, ch = id & 15;
            if (OUT) *(LAS u32x4*)(QS + row * ML_QR + ch * 16) = pq[j];
            *(LAS u32x4*)(KS + row * ML_QR + ch * 16) = pk[j]; *(LAS u32x4*)(VS + row * ML_VR + ch * 16) = pv[j]; }
        if (w == 0) {
            const float lf0 = fminf(gf0, 0.f) - log1pf(__expf(-fabsf(gf0))), lf1 = fminf(gf1, 0.f) - log1pf(__expf(-fabsf(gf1)));
            float P = lf0 + lf1;
#pragma unroll
            for (int o = 1; o < 64; o <<= 1) { const float t = __shfl_up(P, o); if (lane >= o) P += t; }
            const float b1 = P, b0 = P - lf1, a0 = gi0 - b0, a1 = gi1 - b1;
            float M = fmaxf(a0, a1);
#pragma unroll
            for (int o = 1; o < 64; o <<= 1) { const float t = __shfl_up(M, o); if (lane >= o) M = fmaxf(M, t); }
            float Mex = __shfl_up(M, 1); if (lane == 0) Mex = -1e30f;
            const float A0 = fmaxf(m_prev, fmaxf(Mex, a0)), A1 = fmaxf(m_prev, M);
            const float Aend = __shfl(A1, 63), bend = __shfl(b1, 63);
            *(LAS f32x2*)(Va + 2 * lane) = (f32x2){a0, a1}; *(LAS f32x2*)(VA + 2 * lane) = (f32x2){A0, A1};
            *(LAS f32x2*)(Vem + 2 * lane) = (f32x2){__expf(-(b0 + A0)), __expf(-(b1 + A1))};
            *(LAS f32x2*)(Vin + 2 * lane) = (f32x2){__expf(m_prev - A0), __expf(m_prev - A1)};
            *(LAS f32x2*)(Vw + 2 * lane) = (f32x2){__expf(a0 - Aend), __expf(a1 - Aend)};
            if (lane == 0) { Vs[0] = __expf(m_prev - Aend); Vs[1] = bend + Aend; Vs[2] = bend; }
        }
        if (k + 1 < nch) ML_LOAD(k + 1);
        __syncthreads();
        const float decay = Vs[0], m_new = Vs[1]; bsum += Vs[2];
        if constexpr (OUT) {
            const int t = 16 * tt + lq;
            bf16x8 qf[4];
#pragma unroll
            for (int kk = 0; kk < 4; ++kk) qf[kk] = *(const LAS bf16x8*)(QS + t * ML_QR + (32 * kk + 8 * g) * 2);
            f32x4 acc[9];
#pragma unroll
            for (int vt = 0; vt < 9; ++vt) acc[vt] = (f32x4){0.f, 0.f, 0.f, 0.f};
#pragma unroll
            for (int kk = 0; kk < 4; ++kk) { const LAS unsigned char* cr = CS + (32 * kk + 8 * g + qp) * ML_VR + 8 * pp;
#pragma unroll
                for (int vt = 0; vt < 9; ++vt) { const bf16x8 cf = cat4(tr_read(cr + 32 * vt), tr_read(cr + 4 * ML_VR + 32 * vt));
                    acc[vt] = __builtin_amdgcn_mfma_f32_16x16x32_bf16(cf, qf[kk], acc[vt], 0, 0, 0); } }
            { const float it = Vin[t];
#pragma unroll
              for (int vt = 0; vt < 9; ++vt) acc[vt] = acc[vt] * it; }
            const float At = VA[t];
            u32x2 pw[8];
#pragma unroll
            for (int st = 0; st < 8; ++st) {
                pw[st] = (u32x2){0u, 0u};
                if (st <= tt) {
                    f32x4 sa = (f32x4){0.f, 0.f, 0.f, 0.f};
#pragma unroll
                    for (int kk = 0; kk < 4; ++kk) { const bf16x8 kf = *(const LAS bf16x8*)(KS + (16 * st + lq) * ML_QR + (32 * kk + 8 * g) * 2);
                        sa = __builtin_amdgcn_mfma_f32_16x16x32_bf16(kf, qf[kk], sa, 0, 0, 0); }
                    const f32x4 av = *(const LAS f32x4*)(Va + 16 * st + 4 * g);
                    float p[4];
#pragma unroll
                    for (int j = 0; j < 4; ++j) { const int s_ = 16 * st + 4 * g + j; p[j] = (s_ <= t) ? sa[j] * __expf(av[j] - At) : 0.f; }
                    pw[st] = (u32x2){cvt_pk_bf16(p[0], p[1]), cvt_pk_bf16(p[2], p[3])};
                }
            }
#pragma unroll
            for (int kp = 0; kp < 4; ++kp) {
                if (2 * kp <= tt) {
                    const bf16x8 pf = as_bf16x8((u32x4){pw[2 * kp].x, pw[2 * kp].y, pw[2 * kp + 1].x, pw[2 * kp + 1].y});
                    const LAS unsigned char* vr = VS + (32 * kp + 4 * g + qp) * ML_VR + 8 * pp;
#pragma unroll
                    for (int vt = 0; vt < 9; ++vt) { const bf16x8 vf = cat4(tr_read(vr + 32 * vt), tr_read(vr + 16 * ML_VR + 32 * vt));
                        acc[vt] = __builtin_amdgcn_mfma_f32_16x16x32_bf16(vf, pf, acc[vt], 0, 0, 0); }
                }
            }
            const float den = __shfl(acc[8][0], lq);
            const float rd = 1.f / fmaxf(fabsf(den), Vem[t]);
            const size_t orow = rowbase + ML_TOK(sig0 + k * 128 + t);
            if (!FINAL) {
                bf16* hp = HB + orow * 512 + head * 128 + 4 * g;
#pragma unroll
                for (int vt = 0; vt < 8; ++vt) *(u32x2*)(hp + 16 * vt) = (u32x2){cvt_pk_bf16(acc[vt][0] * rd, acc[vt][1] * rd), cvt_pk_bf16(acc[vt][2] * rd, acc[vt][3] * rd)};
            } else {
                const bf16* hp = HB + orow * 512 + head * 128 + 4 * g; const bf16* zo = (const bf16*)(F.ws + WS_ZO) + orow * 512 + head * 128 + 4 * g;
                const float* gn = a.in[11] + head * 128 + 4 * g;
                float ss = 0.f;
#pragma unroll
                for (int vt = 0; vt < 8; ++vt) { const unsigned long long hq = __hip_atomic_load((const unsigned long long*)(hp + 16 * vt), RLX_AGENT); const u32x2 hf = (u32x2){(unsigned)hq, (unsigned)(hq >> 32)};
                    acc[vt][0] = acc[vt][0] * rd + bf_lo(hf.x); acc[vt][1] = acc[vt][1] * rd + bf_hi(hf.x); acc[vt][2] = acc[vt][2] * rd + bf_lo(hf.y); acc[vt][3] = acc[vt][3] * rd + bf_hi(hf.y);
                    ss += (acc[vt][0] * acc[vt][0] + acc[vt][1] * acc[vt][1]) + (acc[vt][2] * acc[vt][2] + acc[vt][3] * acc[vt][3]); }
                ss += __shfl_xor(ss, 16); ss += __shfl_xor(ss, 32);
                const float rs = 1.f / sqrtf(ss * (1.f / 128.f) + LN_EPS);
                bf16* mp = (bf16*)(F.ws + WS_MIX) + orow * 1024 + 512 + head * 128 + 4 * g;
#pragma unroll
                for (int vt = 0; vt < 8; ++vt) { const u32x2 zz = *(const u32x2*)(zo + 16 * vt); const f32x4 gg = *(const f32x4*)(gn + 16 * vt);
                    const float o0 = acc[vt][0] * rs * gg[0] / (1.f + __expf(-bf_lo(zz.x))), o1 = acc[vt][1] * rs * gg[1] / (1.f + __expf(-bf_hi(zz.x)));
                    const float o2 = acc[vt][2] * rs * gg[2] / (1.f + __expf(-bf_lo(zz.y))), o3 = acc[vt][3] * rs * gg[3] / (1.f + __expf(-bf_hi(zz.y)));
                    *(u32x2*)(mp + 16 * vt) = (u32x2){cvt_pk_bf16(o0, o1), cvt_pk_bf16(o2, o3)};
                    if (vt & 1) asm volatile("" ::: "memory"); }
            }
        }
#pragma unroll
        for (int vt = 0; vt < 9; ++vt) Cacc[vt] = Cacc[vt] * decay;
#pragma unroll
        for (int ks = 0; ks < 4; ++ks) {
            const LAS unsigned char* kr = KS + (32 * ks + 8 * g + qp) * ML_QR + (16 * w) * 2 + 8 * pp;
            const bf16x4 k0 = tr_read(kr), k1 = tr_read(kr + 4 * ML_QR);
            const f32x4 w0 = *(const LAS f32x4*)(Vw + 32 * ks + 8 * g), w1 = *(const LAS f32x4*)(Vw + 32 * ks + 8 * g + 4);
            const u32x2 ku0 = __builtin_bit_cast(u32x2, k0), ku1 = __builtin_bit_cast(u32x2, k1);
            const bf16x8 kf = as_bf16x8((u32x4){cvt_pk_bf16(bf_lo(ku0.x) * w0[0], bf_hi(ku0.x) * w0[1]), cvt_pk_bf16(bf_lo(ku0.y) * w0[2], bf_hi(ku0.y) * w0[3]),
                                                cvt_pk_bf16(bf_lo(ku1.x) * w1[0], bf_hi(ku1.x) * w1[1]), cvt_pk_bf16(bf_lo(ku1.y) * w1[2], bf_hi(ku1.y) * w1[3])});
            const LAS unsigned char* vr = VS + (32 * ks + 8 * g + qp) * ML_VR + 8 * pp;
#pragma unroll
            for (int vt = 0; vt < 9; ++vt) { const bf16x8 vf = cat4(tr_read(vr + 32 * vt), tr_read(vr + 4 * ML_VR + 32 * vt));
                Cacc[vt] = __builtin_amdgcn_mfma_f32_16x16x32_bf16(vf, kf, Cacc[vt], 0, 0, 0); }
        }
        m_prev = m_new;
        __syncthreads();
        if constexpr (OUT) {
#pragma unroll
            for (int vt = 0; vt < 9; ++vt) *(LAS u32x2*)(CS + (16 * w + lq) * ML_VR + (16 * vt + 4 * g) * 2) = (u32x2){cvt_pk_bf16(Cacc[vt][0], Cacc[vt][1]), cvt_pk_bf16(Cacc[vt][2], Cacc[vt][3])};
        }
    }
#undef ML_LOAD
#undef ML_TOK
    if (OUT && !FINAL) { VM_WAIT(); __syncthreads(); }
    if constexpr (!OUT) {
        float* R = REC + (size_t)(grp < 0 ? 0 : 1 + grp) * REC_FLOATS;
#pragma unroll
        for (int vt = 0; vt < 9; ++vt) *(f32x4*)(R + (16 * w + lq) * 144 + 16 * vt + 4 * g) = Cacc[vt];
        if (tid == 0) { R[18432] = m_prev; R[18433] = bsum; }
    }
}

__device__ __forceinline__ void p6_readout(Frame& F, const Args& a) {
    const int gw = F.vcu * 8 + F.wave, NGW = F.G * 8, lane = F.lane;
    const bf16* HB0 = (const bf16*)(F.ws + WS_HB); const bf16* HB1 = HB0 + (size_t)ML_ROWS * 512; const bf16* ZO = (const bf16*)(F.ws + WS_ZO);
    bf16* MIX = (bf16*)(F.ws + WS_MIX);
    const f32x4 g0 = *(const f32x4*)(a.in[11] + 8 * lane), g1 = *(const f32x4*)(a.in[11] + 8 * lane + 4);
    for (int m = gw; m < ML_ROWS; m += NGW) {
        const u32x4 hf = *(const u32x4*)(HB0 + (size_t)m * 512 + 8 * lane), hb = *(const u32x4*)(HB1 + (size_t)m * 512 + 8 * lane), zo = *(const u32x4*)(ZO + (size_t)m * 512 + 8 * lane);
        float h[8]; float ss = 0.f;
#pragma unroll
        for (int q = 0; q < 4; ++q) { h[2 * q] = bf_lo(hf[q]) + bf_lo(hb[q]); h[2 * q + 1] = bf_hi(hf[q]) + bf_hi(hb[q]); ss += h[2 * q] * h[2 * q] + h[2 * q + 1] * h[2 * q + 1]; }
        ss += __shfl_xor(ss, 1); ss += __shfl_xor(ss, 2); ss += __shfl_xor(ss, 4); ss += __shfl_xor(ss, 8);
        const float rs = 1.f / sqrtf(ss * (1.f / 128.f) + LN_EPS);
        float o[8];
#pragma unroll
        for (int q = 0; q < 4; ++q) { const float z0 = bf_lo(zo[q]), z1 = bf_hi(zo[q]);
            o[2 * q] = h[2 * q] * rs * (q < 2 ? g0[2 * q] : g1[2 * q - 4]) / (1.f + __expf(-z0));
            o[2 * q + 1] = h[2 * q + 1] * rs * (q < 2 ? g0[2 * q + 1] : g1[2 * q - 3]) / (1.f + __expf(-z1)); }
        *(u32x4*)(MIX + (size_t)m * 1024 + 512 + 8 * lane) = (u32x4){cvt_pk_bf16(o[0], o[1]), cvt_pk_bf16(o[2], o[3]), cvt_pk_bf16(o[4], o[5]), cvt_pk_bf16(o[6], o[7])};
    }
}

struct EpiY1 {
    static constexpr bool PERM = true;
    const float* x; const float* ada; bf16* y1;
    __device__ __forceinline__ void operator()(const f32x4 (&acc)[2][2][4][2], const pg8::Unit& u, int wr, int wc, int fr, int fq) const {
        const int row0 = u.pm * 256 + wr * 64 + fr, col0 = u.pn * 256 + wc * 32 + 8 * fq;
        const float* g1 = ada + (size_t)(u.pm >> 5) * 6144 + 2048;
        f32x4 gv[2][2];
#pragma unroll
        for (int bj = 0; bj < 2; ++bj)
#pragma unroll
            for (int n = 0; n < 2; ++n) gv[bj][n] = *(const f32x4*)(g1 + col0 + bj * 128 + 4 * n);
#pragma unroll
        for (int ai = 0; ai < 2; ++ai)
#pragma unroll
            for (int m = 0; m < 4; ++m) { const size_t off = (size_t)(row0 + ai * 128 + m * 16) * 1024 + col0;
#pragma unroll
                for (int bj = 0; bj < 2; ++bj) { const f32x4 x0 = *(const f32x4*)(x + off + bj * 128), x1 = *(const f32x4*)(x + off + bj * 128 + 4);
                    const f32x4 v0 = x0 * DN_ALPHA + gv[bj][0] * acc[ai][bj][m][0], v1 = x1 * DN_ALPHA + gv[bj][1] * acc[ai][bj][m][1];
                    *(u32x4*)(y1 + off + bj * 128) = (u32x4){cvt_pk_bf16(v0[0], v0[1]), cvt_pk_bf16(v0[2], v0[3]), cvt_pk_bf16(v1[0], v1[1]), cvt_pk_bf16(v1[2], v1[3])}; } }
    }
};

constexpr int P8_LG = 0;
constexpr int P8_REC = 81920;
__device__ __forceinline__ void p8_mid(Frame& F, const Args& a) {
    const int gw = F.vcu * 8 + F.wave, NGW = F.G * 8, lane = F.lane, tid = F.tid, g = lane >> 4, lq = lane & 15;
    bf16* Y1 = (bf16*)(F.ws + WS_Y1); bf16* XM2 = (bf16*)(F.ws + WS_XM2);
    const float* ada = (const float*)(F.ws + WS_ADA); const bf16* WR = (const bf16*)(F.ws + WS_WR);
    LAS float* lg = (LAS float*)(F.lds + P8_LG) + F.wave * 2560;
    LAS unsigned* rec = (LAS unsigned*)(F.lds + P8_REC);
    LAS int* hist = (LAS int*)(F.lds + MISC_OFF + MS_HIST); LAS int* base = (LAS int*)(F.lds + MISC_OFF + MS_BASE);
    if (tid < 64) hist[tid] = 0;
    __syncthreads();
    const f32x4 l1g[4] = {((const f32x4*)a.in[13])[lane], ((const f32x4*)a.in[13])[lane + 64], ((const f32x4*)a.in[13])[lane + 128], ((const f32x4*)a.in[13])[lane + 192]};
    const f32x4 l1b[4] = {((const f32x4*)a.in[14])[lane], ((const f32x4*)a.in[14])[lane + 64], ((const f32x4*)a.in[14])[lane + 128], ((const f32x4*)a.in[14])[lane + 192]};
    const int NT16 = ML_ROWS / 16;
    int nloc = 0;
    for (int wt = gw; wt < NT16; wt += 2 * NGW, nloc += 2) {
        const bool two = wt + NGW < NT16;
        const int rowA = wt * 16, rowB = two ? (wt + NGW) * 16 : rowA;
        for (int rr = 0; rr < (two ? 32 : 16); rr += 4) {
            const int rowbase = (rr < 16 ? rowA : rowB) + (rr & 15);
            const float* sh2 = ada + (size_t)(rowbase >> 13) * 6144 + 3072; const float* sc2 = sh2 + 1024;
            f32x4 v[4][4]; float sm[4];
#pragma unroll
            for (int r = 0; r < 4; ++r) { const u32x2* yr = (const u32x2*)(Y1 + (size_t)(rowbase + r) * 1024) + lane;
#pragma unroll
                for (int j = 0; j < 4; ++j) { const u32x2 pk = yr[64 * j]; v[r][j] = (f32x4){bf_lo(pk.x), bf_hi(pk.x), bf_lo(pk.y), bf_hi(pk.y)}; } }
#pragma unroll
            for (int r = 0; r < 4; ++r) { sm[r] = 0.f;
#pragma unroll
                for (int j = 0; j < 4; ++j) sm[r] += (v[r][j].x + v[r][j].y) + (v[r][j].z + v[r][j].w); }
            wave_sum4(sm);
#pragma unroll
            for (int r = 0; r < 4; ++r) { const float mean = sm[r] * (1.f / DM); sm[r] = 0.f;
#pragma unroll
                for (int j = 0; j < 4; ++j) { v[r][j] = v[r][j] - mean; sm[r] += (v[r][j].x * v[r][j].x + v[r][j].y * v[r][j].y) + (v[r][j].z * v[r][j].z + v[r][j].w * v[r][j].w); } }
            wave_sum4(sm);
#pragma unroll
            for (int r = 0; r < 4; ++r) { const float rstd = 1.f / sqrtf(sm[r] * (1.f / DM) + LN_EPS); sm[r] = 0.f;
                u32x2* yr = (u32x2*)(Y1 + (size_t)(rowbase + r) * 1024) + lane;
#pragma unroll
                for (int j = 0; j < 4; ++j) { v[r][j] = (v[r][j] * rstd) * l1g[j] + l1b[j]; yr[64 * j] = (u32x2){cvt_pk_bf16(v[r][j].x, v[r][j].y), cvt_pk_bf16(v[r][j].z, v[r][j].w)};
                    sm[r] += (v[r][j].x + v[r][j].y) + (v[r][j].z + v[r][j].w); } }
            wave_sum4(sm);
#pragma unroll
            for (int r = 0; r < 4; ++r) { const float mean = sm[r] * (1.f / DM); sm[r] = 0.f;
#pragma unroll
                for (int j = 0; j < 4; ++j) { v[r][j] = v[r][j] - mean; sm[r] += (v[r][j].x * v[r][j].x + v[r][j].y * v[r][j].y) + (v[r][j].z * v[r][j].z + v[r][j].w * v[r][j].w); } }
            wave_sum4(sm);
#pragma unroll
            for (int r = 0; r < 4; ++r) { const float rstd = 1.f / sqrtf(sm[r] * (1.f / DM) + LN_EPS);
                u32x2* o8 = (u32x2*)(XM2 + (size_t)(rowbase + r) * 1024) + lane;
#pragma unroll
                for (int j = 0; j < 4; ++j) { const f32x4 h = ((const f32x4*)sh2)[lane + 64 * j], c = ((const f32x4*)sc2)[lane + 64 * j]; const f32x4 y = (v[r][j] * rstd) * (c + 1.f) + h;
                    o8[64 * j] = (u32x2){cvt_pk_bf16(y.x, y.y), cvt_pk_bf16(y.z, y.w)}; } }
        }
        VM_WAIT();
        AMP_SPIN(80);
        f32x4 la[2][5];
#pragma unroll
        for (int t2 = 0; t2 < 2; ++t2)
#pragma unroll
            for (int nt = 0; nt < 5; ++nt) la[t2][nt] = (f32x4){0.f, 0.f, 0.f, 0.f};
        const bf16* xpA = XM2 + (size_t)(rowA + lq) * 1024 + 8 * g; const bf16* xpB = XM2 + (size_t)(rowB + lq) * 1024 + 8 * g;
        const bf16* wp = WR + (size_t)lq * 1024 + 8 * g;
#pragma unroll 4
        for (int kk = 0; kk < 32; ++kk) {
            const bf16x8 xfA = __builtin_nontemporal_load((const bf16x8*)(xpA + 32 * kk)), xfB = __builtin_nontemporal_load((const bf16x8*)(xpB + 32 * kk));
#pragma unroll
            for (int nt = 0; nt < 5; ++nt) { const bf16x8 wf = *(const bf16x8*)(wp + (size_t)nt * 16 * 1024 + 32 * kk);
                la[0][nt] = __builtin_amdgcn_mfma_f32_16x16x32_bf16(wf, xfA, la[0][nt], 0, 0, 0);
                la[1][nt] = __builtin_amdgcn_mfma_f32_16x16x32_bf16(wf, xfB, la[1][nt], 0, 0, 0); }
        }
#pragma unroll
        for (int t2 = 0; t2 < 2; ++t2)
#pragma unroll
            for (int nt = 0; nt < 5; ++nt) *(LAS f32x4*)(lg + (16 * t2 + lq) * 80 + 16 * nt + 4 * g) = la[t2][nt];
        LDS_WAIT();
        if (lane < 16 || (lane < 32 && two)) {
            const LAS float* L = lg + lane * 80;
            float gl[8]; float gm = -1e30f; int gi = 0;
#pragma unroll
            for (int i = 0; i < 8; ++i) { gl[i] = L[i] + a.in[16][i]; if (gl[i] > gm) { gm = gl[i]; gi = i; } }
            float gs = 0.f;
#pragma unroll
            for (int i = 0; i < 8; ++i) gs += __expf(gl[i] - gm);
            const float pg = 1.f / gs;
            float v1 = -1e30f, v2 = -1e30f; int i1 = 0, i2 = 0;
#pragma unroll
            for (int i = 0; i < 8; ++i) { const float e = L[16 + gi * 8 + i] + a.in[18][gi * 8 + i];
                if (e > v1) { v2 = v1; i2 = i1; v1 = e; i1 = i; } else if (e > v2) { v2 = e; i2 = i; } }
            const float ex = __expf(v2 - v1), wA = pg / (1.f + ex), wB = pg * ex / (1.f + ex);
            const int eA = gi * 8 + i1, eB = gi * 8 + i2;
            const int pA = __hip_atomic_fetch_add(&hist[eA], 1, __ATOMIC_RELAXED, __HIP_MEMORY_SCOPE_WORKGROUP), pB = __hip_atomic_fetch_add(&hist[eB], 1, __ATOMIC_RELAXED, __HIP_MEMORY_SCOPE_WORKGROUP);
            LAS unsigned* rc = rec + (((nloc + (lane >> 4)) * 8 + F.wave) * 16 + (lane & 15)) * 8;
            rc[0] = (unsigned)eA; rc[1] = (unsigned)pA; rc[2] = (unsigned)eB; rc[3] = (unsigned)pB; rc[4] = __float_as_uint(wA); rc[5] = __float_as_uint(wB); rc[6] = (unsigned)((lane < 16 ? rowA : rowB) + (lane & 15));
        }
        AMP_SPIN(81);
    }
    __syncthreads();
    if (tid < 64) base[tid] = (int)__hip_atomic_fetch_add(F.ctl + CW_CNT + 16 * tid, (unsigned)hist[tid], RLX_AGENT);
    __syncthreads();
    {
        int* TOKL = (int*)(F.ws + WS_TOKL); u32x4* ROUTE = (u32x4*)(F.ws + WS_ROUTE);
        const int ntile_max = (ML_ROWS / 16 + NGW - 1) / NGW;
        for (int i = tid; i < ntile_max * 128; i += 512) {
            const int nl = i >> 7, wv = (i >> 4) & 7;
            if ((long)(F.vcu * 8 + wv) + (long)nl * NGW >= ML_ROWS / 16) continue;
            const LAS unsigned* rc = rec + i * 8;
            const int eA = (int)rc[0], pA = (int)rc[1] + base[rc[0]], eB = (int)rc[2], pB = (int)rc[3] + base[rc[2]], tok = (int)rc[6];
            TOKL[(size_t)eA * 65536 + pA] = tok; TOKL[(size_t)eB * 65536 + pB] = tok;
            ROUTE[tok] = (u32x4){((unsigned)eA << 20) | (unsigned)pA, ((unsigned)eB << 20) | (unsigned)pB, rc[4], rc[5]};
        }
    }
}

__device__ __forceinline__ void moe_tables(Frame& F) {
    LAS int* cnt = (LAS int*)(F.lds + MISC_OFF + MS_CNT); LAS int* start = (LAS int*)(F.lds + MISC_OFF + MS_START); LAS int* tstart = (LAS int*)(F.lds + MISC_OFF + MS_TSTART);
    __syncthreads();
    if (F.tid < 64) cnt[F.tid] = (int)__hip_atomic_load(F.ctl + CW_CNT + 16 * F.tid, RLX_AGENT);
    __syncthreads();
    if (F.tid == 0) { int s = 0, t = 0; for (int e = 0; e < 64; ++e) { start[e] = s; tstart[e] = t; s += cnt[e]; t += (cnt[e] + 255) >> 8; } start[64] = s; tstart[64] = t; }
    __syncthreads();
}
struct MoeOrder {
    const LAS int* cnt; const LAS int* start; const LAS int* tstart; int G, c;
    __device__ __forceinline__ bool next(int i, pg8::Unit& u) const {
        const int tile = i * (G >> 2) + (c & 7) + 8 * (c >> 5), pnn = (c >> 3) & 3;
        if (tile >= tstart[64]) return false;
        int e = 0;
        for (int s = 32; s >= 1; s >>= 1) if (tstart[e + s] <= tile) e += s;
        while (cnt[e] == 0) --e;
        u.e = e; u.pm = tile - tstart[e]; u.pn = pnn; const int rem = cnt[e] - u.pm * 256; u.cnt = rem < 256 ? rem : 256; return true;
    }
};
struct MoeSched1 {
    static constexpr bool GATHER = true;
    MoeOrder ord; const char* XM2; const char* W13; const int* TOKL;
    __device__ __forceinline__ bool next(int i, pg8::Unit& u) const { return ord.next(i, u); }
    __device__ __forceinline__ const char* a_ptr(const pg8::Unit&) const { return XM2; }
    __device__ __forceinline__ const char* b_ptr(const pg8::Unit& u) const { return W13 + ((size_t)u.e * 1024 + (size_t)u.pn * 256) * 2048; }
    __device__ __forceinline__ void a_voff(const pg8::Unit& u, unsigned (&v)[2][2], int R0, int R1, int C0, int C1) const {
        const int* tl = TOKL + (size_t)u.e * 65536 + u.pm * 256;
#pragma unroll
        for (int h = 0; h < 2; ++h) { const int r0 = h * 128 + R0, r1 = h * 128 + R1;
            const int t0 = r0 < u.cnt ? tl[r0] : 0, t1 = r1 < u.cnt ? tl[r1] : 0;
            v[h][0] = (unsigned)t0 * 2048u + (unsigned)C0 * 2u; v[h][1] = (unsigned)t1 * 2048u + (unsigned)C1 * 2u; }
    }
};
struct MoeSched2 {
    static constexpr bool GATHER = false;
    MoeOrder ord; const char* H; const char* W2;
    __device__ __forceinline__ bool next(int i, pg8::Unit& u) const { return ord.next(i, u); }
    __device__ __forceinline__ const char* a_ptr(const pg8::Unit& u) const { return H + (size_t)(ord.start[u.e] + u.pm * 256) * 1024; }
    __device__ __forceinline__ const char* b_ptr(const pg8::Unit& u) const { return W2 + ((size_t)u.e * 1024 + (size_t)u.pn * 256) * 1024; }
    __device__ __forceinline__ void a_voff(const pg8::Unit&, unsigned (&)[2][2], int, int, int, int) const {}
};
struct EpiH {
    static constexpr bool PERM = true;
    bf16* H; const LAS int* start;
    __device__ __forceinline__ void operator()(const f32x4 (&acc)[2][2][4][2], const pg8::Unit& u, int wr, int wc, int fr, int fq) const {
        const int r0 = wr * 64 + fr; const size_t slot0 = (size_t)start[u.e] + u.pm * 256;
        const int col0 = u.pn * 128 + wc * 32 + 8 * fq;
#pragma unroll
        for (int ai = 0; ai < 2; ++ai)
#pragma unroll
            for (int m = 0; m < 4; ++m) { const int r = r0 + ai * 128 + m * 16;
                if (r < u.cnt) { float o[8];
#pragma unroll
                    for (int n = 0; n < 2; ++n)
#pragma unroll
                        for (int j = 0; j < 4; ++j) { const float h1 = acc[ai][0][m][n][j], h3 = acc[ai][1][m][n][j]; o[4 * n + j] = h1 / (1.f + __expf(-h1)) * h3; }
                    *(u32x4*)(H + (slot0 + r) * 512 + col0) = (u32x4){cvt_pk_bf16(o[0], o[1]), cvt_pk_bf16(o[2], o[3]), cvt_pk_bf16(o[4], o[5]), cvt_pk_bf16(o[6], o[7])}; } }
    }
};
struct EpiY {
    static constexpr bool PERM = true;
    bf16* Y; const LAS int* start;
    __device__ __forceinline__ void operator()(const f32x4 (&acc)[2][2][4][2], const pg8::Unit& u, int wr, int wc, int fr, int fq) const {
        const int r0 = wr * 64 + fr; const size_t slot0 = (size_t)start[u.e] + u.pm * 256;
        const int col0 = u.pn * 256 + wc * 32 + 8 * fq;
#pragma unroll
        for (int ai = 0; ai < 2; ++ai)
#pragma unroll
            for (int m = 0; m < 4; ++m) { const int r = r0 + ai * 128 + m * 16;
                if (r < u.cnt) {
#pragma unroll
                    for (int bj = 0; bj < 2; ++bj) { const f32x4 v0 = acc[ai][bj][m][0], v1 = acc[ai][bj][m][1];
                        *(u32x4*)(Y + (slot0 + r) * 1024 + col0 + bj * 128) = (u32x4){cvt_pk_bf16(v0[0], v0[1]), cvt_pk_bf16(v0[2], v0[3]), cvt_pk_bf16(v1[0], v1[1]), cvt_pk_bf16(v1[2], v1[3])}; } } }
    }
};

__device__ __forceinline__ void p11_final(Frame& F, const Args& a) {
    const int gw = F.vcu * 8 + F.wave, NGW = F.G * 8, lane = F.lane;
    const bf16* XMID = (const bf16*)(F.ws + WS_Y1); const bf16* Y = (const bf16*)(F.ws + WS_YMOE); const u32x4* ROUTE = (const u32x4*)(F.ws + WS_ROUTE);
    const float* ada = (const float*)(F.ws + WS_ADA);
    const LAS int* start = (const LAS int*)(F.lds + MISC_OFF + MS_START);
    int m = gw;
    u32x4 rt_n = m < ML_ROWS ? ROUTE[m] : (u32x4){0u, 0u, 0u, 0u};
    u32x2 xp[4], pa[4], pb[4]; float wA = 0.f, wB = 0.f;
    if (m < ML_ROWS) {
        const size_t sA = (size_t)start[rt_n.x >> 20] + (rt_n.x & 0xfffffu), sB = (size_t)start[rt_n.y >> 20] + (rt_n.y & 0xfffffu);
        wA = __uint_as_float(rt_n.z); wB = __uint_as_float(rt_n.w);
        const u32x2* xr = (const u32x2*)(XMID + (size_t)m * 1024) + lane; const u32x2* ya = (const u32x2*)(Y + sA * 1024) + lane; const u32x2* yb = (const u32x2*)(Y + sB * 1024) + lane;
#pragma unroll
        for (int j = 0; j < 4; ++j) { xp[j] = xr[64 * j]; pa[j] = ya[64 * j]; pb[j] = yb[64 * j]; }
        rt_n = (m + NGW < ML_ROWS) ? ROUTE[m + NGW] : rt_n;
    }
    for (; m < ML_ROWS; m += NGW) {
        const bool more = m + NGW < ML_ROWS;
        u32x2 nxp[4], npa[4], npb[4]; float nwA = 0.f, nwB = 0.f; u32x4 rt_nn = rt_n;
        if (more) {
            const size_t sA = (size_t)start[rt_n.x >> 20] + (rt_n.x & 0xfffffu), sB = (size_t)start[rt_n.y >> 20] + (rt_n.y & 0xfffffu);
            nwA = __uint_as_float(rt_n.z); nwB = __uint_as_float(rt_n.w);
            const u32x2* xr = (const u32x2*)(XMID + (size_t)(m + NGW) * 1024) + lane; const u32x2* ya = (const u32x2*)(Y + sA * 1024) + lane; const u32x2* yb = (const u32x2*)(Y + sB * 1024) + lane;
#pragma unroll
            for (int j = 0; j < 4; ++j) { nxp[j] = xr[64 * j]; npa[j] = ya[64 * j]; npb[j] = yb[64 * j]; }
            if (m + 2 * NGW < ML_ROWS) rt_nn = ROUTE[m + 2 * NGW];
        }
        const f32x4* g2 = (const f32x4*)(ada + (size_t)(m >> 13) * 6144 + 5120) + lane;
        f32x4 v[4]; float s = 0.f;
#pragma unroll
        for (int j = 0; j < 4; ++j) { const f32x4 xv = (f32x4){bf_lo(xp[j].x), bf_hi(xp[j].x), bf_lo(xp[j].y), bf_hi(xp[j].y)}; const f32x4 gg = g2[64 * j];
            f32x4 mo; mo.x = wA * bf_lo(pa[j].x) + wB * bf_lo(pb[j].x); mo.y = wA * bf_hi(pa[j].x) + wB * bf_hi(pb[j].x); mo.z = wA * bf_lo(pa[j].y) + wB * bf_lo(pb[j].y); mo.w = wA * bf_hi(pa[j].y) + wB * bf_hi(pb[j].y);
            v[j] = xv * DN_ALPHA + gg * mo; s += (v[j].x + v[j].y) + (v[j].z + v[j].w); }
        const float mean = wave_sum(s) * (1.f / DM); float s2 = 0.f;
#pragma unroll
        for (int j = 0; j < 4; ++j) { v[j] = v[j] - mean; s2 += (v[j].x * v[j].x + v[j].y * v[j].y) + (v[j].z * v[j].z + v[j].w * v[j].w); }
        const float rstd = 1.f / sqrtf(wave_sum(s2) * (1.f / DM) + LN_EPS);
        f32x4* o = (f32x4*)(a.out + (size_t)m * 1024) + lane;
#pragma unroll
        for (int j = 0; j < 4; ++j) { const f32x4 gg = ((const f32x4*)a.in[22])[lane + 64 * j], bb = ((const f32x4*)a.in[23])[lane + 64 * j]; o[64 * j] = (v[j] * rstd) * gg + bb; }
        if (more) { wA = nwA; wB = nwB; rt_n = rt_nn;
#pragma unroll
            for (int j = 0; j < 4; ++j) { xp[j] = nxp[j]; pa[j] = npa[j]; pb[j] = npb[j]; } }
    }
}

__global__ void __launch_bounds__(512, 2) mk_fwd(Args args) {
    extern __shared__ __attribute__((aligned(16))) unsigned char lds_raw[];
    Frame F;
    F.lds = (LAS unsigned char*)lds_raw; F.ws = args.ws; F.ctl = (unsigned*)(args.ws + WS_CTL);
    F.tid = threadIdx.x; F.lane = F.tid & 63; F.wave = __builtin_amdgcn_readfirstlane(F.tid >> 6);
    F.G = gridDim.x; { const int bx = blockIdx.x; F.vcu = (F.G % 8 == 0) ? (bx % 8) * (F.G / 8) + bx / 8 : bx; }
    for (int u = F.tid; u < (LDS_BYTES - MISC_OFF) / 4; u += 512) ((LAS unsigned*)(F.lds + MISC_OFF))[u] = 0u;
    __syncthreads();
    XcdBarrier bar; bar.bar = F.ctl + CW_BAR; bar.x = 0; bar.st = nullptr;
    if (MK_N_LAUNCHES == 1) bar = xcd_barrier_post(F.ctl + CW_BAR, (volatile LAS unsigned*)(F.lds + MISC_OFF));
    const int lo = args.ph_lo, hi = args.ph_hi;
#define IN(k) (lo <= (k) && (k) < hi)
#define SEAM(k) do { if (IN(k) && IN((k) + 1)) xcd_barrier(bar); AMP_SPIN(k); } while (0)
    if (PROBE_AMP >= 0) { if (F.tid == 0) *(volatile LAS unsigned long long*)(F.lds + MISC_OFF + 32) = __builtin_amdgcn_s_memrealtime(); }

    if (IN(0)) { p0_prologue(F, args); } SEAM(0);
    if (IN(1)) { p1_ln_mod(F, args); } SEAM(1);
    if (IN(2)) {
        pg8::DenseSched S; S.A = (const char*)(F.ws + WS_XM); S.Bt = (const char*)(F.ws + WS_WIN); S.K = 1024; S.ord.init(MT, NZ, F.G, (int)blockIdx.x);
        EpiZ E{F.ws, args.in[9]};
        pg8::gemm_phase<EpiZ, pg8::DenseSched>(F.lds, 1024, S, E);
    } SEAM(2);
    if (IN(3)) { if (args.pad != 2) p3_qkprep(F, args); if (args.pad != 1) p3_na(F, args); } SEAM(3);
    if (IN(4)) {
        for (int u = blockIdx.x; u < 576; u += F.G) { if (u < 512) mlstm_unit<false>(F, args, u >> 3, u & 7, false); else mlstm_unit<false>(F, args, u - 512, -1, false); }
    } SEAM(4);
    if (IN(5)) {
        for (int u = blockIdx.x; u < 256; u += F.G) { const int bh = u >> 3, gt = u & 7; for (int ps = 0; ps < 2; ++ps) mlstm_unit<true>(F, args, bh * 2 + ps, ps ? 7 - gt : gt, ps != 0); }
    } SEAM(5);
    if (IN(7)) {
        pg8::DenseSched S; S.A = (const char*)(F.ws + WS_MIX); S.Bt = (const char*)(F.ws + WS_WOUT); S.K = 1024; S.ord.init(ML_ROWS, 1024, F.G, (int)blockIdx.x);
        EpiY1 E{args.in[0], (const float*)(F.ws + WS_ADA), (bf16*)(F.ws + WS_Y1)};
        pg8::gemm_phase<EpiY1, pg8::DenseSched>(F.lds, 1024, S, E);
    } SEAM(7);
    if (IN(8)) { p8_mid(F, args); } SEAM(8);
    if (IN(9)) {
        moe_tables(F);
        MoeSched1 S; S.ord = MoeOrder{(const LAS int*)(F.lds + MISC_OFF + MS_CNT), (const LAS int*)(F.lds + MISC_OFF + MS_START), (const LAS int*)(F.lds + MISC_OFF + MS_TSTART), F.G, (int)blockIdx.x};
        S.XM2 = (const char*)(F.ws + WS_XM2); S.W13 = (const char*)(F.ws + WS_W13); S.TOKL = (const int*)(F.ws + WS_TOKL);
        EpiH E{(bf16*)(F.ws + WS_HMOE), (const LAS int*)(F.lds + MISC_OFF + MS_START)};
        pg8::gemm_phase<EpiH, MoeSched1>(F.lds, 1024, S, E);
    } SEAM(9);
    if (IN(10)) {
        moe_tables(F);
        MoeSched2 S; S.ord = MoeOrder{(const LAS int*)(F.lds + MISC_OFF + MS_CNT), (const LAS int*)(F.lds + MISC_OFF + MS_START), (const LAS int*)(F.lds + MISC_OFF + MS_TSTART), F.G, (int)blockIdx.x};
        S.H = (const char*)(F.ws + WS_HMOE); S.W2 = (const char*)(F.ws + WS_W2);
        EpiY E{(bf16*)(F.ws + WS_YMOE), (const LAS int*)(F.lds + MISC_OFF + MS_START)};
        pg8::gemm_phase<EpiY, MoeSched2>(F.lds, 512, S, E);
    } SEAM(10);
    if (IN(11)) { moe_tables(F); p11_final(F, args); }
    if (PROBE_AMP == 11) { VM_WAIT(); AMP_SPIN(11); }
#undef IN
#undef SEAM
}

extern "C" void kernel_launch(void* const* d_in, const int* in_sizes, int n_in, void* d_out, int out_size, void* d_ws, size_t ws_size, hipStream_t stream) {
    static int grid = 0;
    if (grid == 0) {
        if (n_in != 24 || out_size != ML_ROWS * DM || ws_size < WS_END) { fprintf(stderr, "kernel_launch: unexpected shapes (n_in %d out %d ws %zu)\n", n_in, out_size, ws_size); grid = -1; return; }
        int dev = 0, cus = 0, per_cu = 0;
        if (hipGetDevice(&dev) != hipSuccess || hipDeviceGetAttribute(&cus, hipDeviceAttributeMultiprocessorCount, dev) != hipSuccess) { grid = -1; return; }
        if (hipFuncSetAttribute((const void*)mk_fwd, hipFuncAttributeMaxDynamicSharedMemorySize, LDS_BYTES) != hipSuccess) { fprintf(stderr, "kernel_launch: hipFuncSetAttribute failed\n"); grid = -1; return; }
        if (hipOccupancyMaxActiveBlocksPerMultiprocessor(&per_cu, (const void*)mk_fwd, 512, LDS_BYTES) != hipSuccess || per_cu < 1) fprintf(stderr, "kernel_launch: occupancy query says %d\n", per_cu);
        (void)hipGetLastError();
        grid = cus;
    }
    if (grid < 0) return;
    if (hipMemsetAsync((char*)d_ws + WS_CTL, 0, CTL_ZERO_BYTES, stream) != hipSuccess) return;
    Args a{};
    for (int i = 0; i < 24; ++i) a.in[i] = (const float*)d_in[i];
    a.out = (float*)d_out; a.ws = (unsigned char*)d_ws;
    if (MK_N_LAUNCHES == 1) { a.ph_lo = 0; a.ph_hi = NPHASE; a.li = 0; hipLaunchKernelGGL(mk_fwd, dim3(grid), dim3(512), LDS_BYTES, stream, a); }
    else for (int p = 0; p < NPHASE; ++p) { a.ph_lo = p; a.ph_hi = p + 1; a.li = p; a.pad = 0; hipLaunchKernelGGL(mk_fwd, dim3(grid), dim3(512), LDS_BYTES, stream, a);
        if (PROBE_DBL == p || (PROBE_DBL == 33 && p == 3)) { a.pad = (PROBE_DBL == 33) ? 2 : (p == 3 ? 1 : 0); hipLaunchKernelGGL(mk_fwd, dim3(grid), dim3(512), LDS_BYTES, stream, a); } }
}
```

```cpp
#include <hip/hip_runtime.h>
#include <cstdio>
#include <cstdint>

#ifndef MK_N_LAUNCHES
#define MK_N_LAUNCHES 1
#endif
#ifndef PROBE_DBL
#define PROBE_DBL -1
#endif
#ifndef PROBE_AMP
#define PROBE_AMP -1
#endif

#define GAS __attribute__((address_space(1)))
#define LAS __attribute__((address_space(3)))
typedef unsigned short bf16;
typedef short bf16x8 __attribute__((ext_vector_type(8)));
typedef short bf16x4 __attribute__((ext_vector_type(4)));
typedef float f32x4 __attribute__((ext_vector_type(4)));
typedef float f32x2 __attribute__((ext_vector_type(2)));
typedef unsigned u32x4 __attribute__((ext_vector_type(4)));
typedef unsigned u32x2 __attribute__((ext_vector_type(2)));

constexpr int NB = 8, SEQ = 8192, DM = 1024, CTXL = 256;
constexpr int ML_ROWS = NB * SEQ, MC_ROWS = NB * CTXL, MT = ML_ROWS + MC_ROWS;
constexpr int IN_COLS = 3600, NZ = 3584;
constexpr int NEXP = 64, EH = 512;
constexpr float LN_EPS = 1e-5f;
constexpr float DN_ALPHA = 1.189207115002721f;
constexpr int NPHASE = 12;

constexpr size_t MiB = 1u << 20;
constexpr size_t WS_CTL = 0, CTL_ZERO_BYTES = 1 * MiB;
constexpr size_t WS_WIN = 1 * MiB;
constexpr size_t WS_WOUT = 9 * MiB;
constexpr size_t WS_W13 = 11 * MiB;
constexpr size_t WS_W2 = 139 * MiB;
constexpr size_t WS_ADA = 203 * MiB;
constexpr size_t WS_ROPE = 204 * MiB;
constexpr size_t WS_WR = 204 * MiB + 512 * 1024;
constexpr size_t WS_GATES = 205 * MiB;
constexpr size_t WS_TOKL = 210 * MiB;
constexpr size_t WS_ROUTE = 226 * MiB;
constexpr size_t WS_MLST = 227 * MiB;
constexpr int REC_FLOATS = 18688;
constexpr size_t WS_ZA = 270 * MiB;
constexpr size_t WS_ZQK = 468 * MiB;
constexpr size_t WS_ZV = 600 * MiB;
constexpr size_t WS_ZO = 666 * MiB;
constexpr size_t WS_XM = 732 * MiB;
constexpr size_t WS_MIX = 864 * MiB;
constexpr size_t WS_HB = 270 * MiB;
constexpr size_t WS_Y1 = 270 * MiB;
constexpr size_t WS_HMOE = 526 * MiB;
constexpr size_t WS_XM2 = 655 * MiB;
constexpr size_t WS_YMOE = 655 * MiB;
constexpr size_t WS_END = 992 * MiB;
static_assert(WS_MLST + (size_t)64 * 9 * REC_FLOATS * 4 <= WS_ZA, "ws map");
static_assert(WS_YMOE + (size_t)(131072 + 256) * 1024 * 2 <= WS_END, "ws map");
constexpr int CW_TMO = 0;
constexpr int CW_BAR = 4096;
constexpr int CW_CNT = 16384;

constexpr int PH_BYTES = 159744;
constexpr int MISC_OFF = PH_BYTES;
constexpr int LDS_BYTES = PH_BYTES + 4096;
constexpr int MS_TSTART = 64;
constexpr int MS_CNT = 384;
constexpr int MS_START = 704;
constexpr int MS_HIST = 1024;
constexpr int MS_BASE = 1280;

#define LDS_WAIT() asm volatile("s_waitcnt lgkmcnt(0)" ::: "memory")
#define VM_WAIT() asm volatile("s_waitcnt vmcnt(0)" ::: "memory")
#define RLX_AGENT __ATOMIC_RELAXED, __HIP_MEMORY_SCOPE_AGENT

__device__ __forceinline__ unsigned cvt_pk_bf16(float lo, float hi) { unsigned r; asm volatile("v_cvt_pk_bf16_f32 %0, %1, %2" : "=v"(r) : "v"(lo), "v"(hi)); return r; }
__device__ __forceinline__ int opaque(int x) { asm volatile("" : "+v"(x)); return x; }
__device__ __forceinline__ float bf_lo(unsigned u) { return __builtin_bit_cast(float, u << 16); }
__device__ __forceinline__ float bf_hi(unsigned u) { return __builtin_bit_cast(float, u & 0xffff0000u); }
__device__ __forceinline__ float wave_sum(float v) {
#pragma unroll
    for (int o = 1; o < 64; o <<= 1) v += __shfl_xor(v, o);
    return v;
}
__device__ __forceinline__ void wave_sum4(float (&v)[4]) {
#pragma unroll
    for (int o = 1; o < 64; o <<= 1) {
#pragma unroll
        for (int r = 0; r < 4; ++r) v[r] += __shfl_xor(v[r], o);
    }
}
__device__ __forceinline__ bf16x4 tr_read(const LAS unsigned char* p) { return __builtin_amdgcn_ds_read_tr16_b64_v4i16((LAS bf16x4*)p); }
__device__ __forceinline__ bf16x8 cat4(bf16x4 a, bf16x4 b) { return (bf16x8){a[0], a[1], a[2], a[3], b[0], b[1], b[2], b[3]}; }
__device__ __forceinline__ bf16x8 as_bf16x8(u32x4 v) { return __builtin_bit_cast(bf16x8, v); }

#define XB_TMO      128
#define XB_XCNT(j)  (256  + 64 * (j))
#define XB_XSUB(j)  (1280 + 64 * (j))
#define XB_XGEN(j)  (2304 + 64 * (j))
#define XB_TOP      3328
#define XB_TOPGEN   3392
#define XCD_BAR_WORDS 3456
#define XB_SPIN_CAP (1u << 18)
__device__ __forceinline__ unsigned xb_ld(unsigned* p)              { return __hip_atomic_load(p, __ATOMIC_RELAXED, __HIP_MEMORY_SCOPE_AGENT); }
__device__ __forceinline__ unsigned xb_add(unsigned* p, unsigned v) { return __hip_atomic_fetch_add(p, v, __ATOMIC_RELAXED, __HIP_MEMORY_SCOPE_AGENT); }
__device__ __forceinline__ unsigned xb_xcc_id() { return (unsigned)__builtin_amdgcn_s_getreg((3 << 11) | 20) & 0xFu; }
#define XB_SPIN(cond, bar) do { unsigned _sp = 0; while (cond) { __builtin_amdgcn_s_sleep(1); \
    if ((++_sp & 255u) == 0u) { if (xb_ld(&(bar)[XB_TMO])) break; if (_sp > XB_SPIN_CAP) { atomicAdd(&(bar)[XB_TMO], 1u); break; } } } } while (0)
struct XcdBarrier { unsigned* bar; unsigned x; volatile LAS unsigned* st; };
__device__ __forceinline__ XcdBarrier xcd_barrier_post(unsigned* bar, volatile LAS unsigned* st) {
    XcdBarrier b; b.bar = bar; b.x = xb_xcc_id(); b.st = st;
    if (threadIdx.x == 0) (void)xb_add(&bar[XB_XCNT(b.x)], 1u);
    return b;
}
__device__ __forceinline__ void xcd_barrier_complete(unsigned* bar, unsigned x, unsigned& nloc, unsigned& nx) {
    const unsigned G = gridDim.x * gridDim.y * gridDim.z;
    unsigned sum, cnt, mine, sp = 0u;
    for (;;) {
        sum = 0u; cnt = 0u; mine = 0u;
#pragma unroll
        for (unsigned j = 0; j < 16; ++j) { const unsigned c = xb_ld(&bar[XB_XCNT(j)]); sum += c; cnt += (c > 0u) ? 1u : 0u; mine = (j == x) ? c : mine; }
        if (sum == G) break;
        __builtin_amdgcn_s_sleep(1);
        if ((++sp & 255u) == 0u) { if (xb_ld(&bar[XB_TMO])) break; if (sp > XB_SPIN_CAP) { atomicAdd(&bar[XB_TMO], 1u); break; } }
    }
    nloc = mine > 0u ? mine : 1u; nx = cnt > 0u ? cnt : 1u;
}
__device__ __forceinline__ void xcd_barrier(const XcdBarrier& b) {
    asm volatile("s_waitcnt vmcnt(0)" ::: "memory");
    __syncthreads();
    if (threadIdx.x == 0) {
        unsigned* bar = b.bar;
        __builtin_amdgcn_s_waitcnt(0);
        unsigned nloc = b.st[0], nx = b.st[1];
        if (nloc == 0u) { xcd_barrier_complete(bar, b.x, nloc, nx); b.st[0] = nloc; b.st[1] = nx; }
        const unsigned old = xb_add(&bar[XB_XSUB(b.x)], 1u);
        const unsigned gen = old / nloc;
        if (old + 1u == (gen + 1u) * nloc) {
            __builtin_amdgcn_fence(__ATOMIC_RELEASE, "agent");
            asm volatile("s_waitcnt vmcnt(0)" ::: "memory");
            const unsigned og = xb_add(&bar[XB_TOP], 1u);
            const unsigned tg = og / nx;
            if (og + 1u == (tg + 1u) * nx) xb_add(&bar[XB_TOPGEN], 1u);
            else XB_SPIN(xb_ld(&bar[XB_TOPGEN]) == tg, bar);
            __builtin_amdgcn_fence(__ATOMIC_ACQUIRE, "agent");
            xb_add(&bar[XB_XGEN(b.x)], 1u);
            asm volatile("s_waitcnt vmcnt(0)" ::: "memory");
        } else {
            XB_SPIN(xb_ld(&bar[XB_XGEN(b.x)]) == gen, bar);
            __builtin_amdgcn_fence(__ATOMIC_ACQUIRE, "agent");
            asm volatile("s_waitcnt vmcnt(0)" ::: "memory");
        }
    }
    __syncthreads();
}

namespace pg8 {
constexpr int BM = 256, BK = 64, HALF = 128, HTB = HALF * BK * 2, STAGE_BYTES = 8 * HTB, NXCD = 8, WGM = 8;
__host__ __device__ __forceinline__ int lds_byte(int r, int c) { const int st = (r >> 4) * 2 + (c >> 5), rr = r & 15, cc = c & 31, ob = rr * 64 + cc * 2; return st * 1024 + (ob ^ (((ob >> 9) & 1) << 5)); }
__host__ __device__ __forceinline__ void stage_rc(int b, int& R, int& C) { const int st = b / 1024, sb = b % 1024, swz = sb ^ (((sb >> 9) & 1) << 5); R = (st >> 1) * 16 + swz / 64; C = (st & 1) * 32 + (swz % 64) / 2; }
__host__ __device__ __forceinline__ int perm32(int rho) { const int n = rho >> 4, i = rho & 15; return 8 * (i >> 2) + 4 * n + (i & 3); }

struct Unit { int pm, pn, e, cnt; };

struct StaticOrder {
    int nM, nN, nwg, G, c;
    __device__ void init(int M, int N, int G_, int c_) { nM = M / BM; nN = N / BM; nwg = nM * nN; G = G_; c = c_; }
    __device__ bool next(int i, Unit& u) const {
        const long L = (long)i * G + c; if (L >= nwg) return false;
        int wgid = (int)L; { const int q = nwg / NXCD, r = nwg % NXCD, xcd = wgid % NXCD, off = wgid / NXCD; wgid = (xcd < r ? xcd * (q + 1) : r * (q + 1) + (xcd - r) * q) + off; }
        const int nig = WGM * nN, gid = wgid / nig, fm = gid * WGM, gsz = (nM - fm) < WGM ? (nM - fm) : WGM;
        u.pm = fm + ((wgid % nig) % gsz); u.pn = (wgid % nig) / gsz; u.e = 0; u.cnt = 256; return true;
    }
};
struct DenseSched {
    static constexpr bool GATHER = false;
    const char* A; const char* Bt; int K; StaticOrder ord;
    __device__ __forceinline__ bool next(int i, Unit& u) const { return ord.next(i, u); }
    __device__ __forceinline__ const char* a_ptr(const Unit& u) const { return A + (size_t)u.pm * BM * K * 2; }
    __device__ __forceinline__ const char* b_ptr(const Unit& u) const { return Bt + (size_t)u.pn * BM * K * 2; }
    __device__ __forceinline__ void a_voff(const Unit&, unsigned (&)[2][2], int) const {}
};

template <class Epi, class Sched, bool ALIGN_EPI = true>
__device__ __forceinline__ void gemm_phase(LAS unsigned char* lds, const int K, const Sched& S, const Epi& E) {
    const int tid = opaque((int)threadIdx.x), wid = __builtin_amdgcn_readfirstlane(tid >> 6), lane = tid & 63, wr = wid >> 2, wc = wid & 3, fr = lane & 15, fq = lane >> 4;
    const int nt = K / BK;
    unsigned voffA[2], voffB[2];
#pragma unroll
    for (int i = 0; i < 2; ++i) { int R, C; stage_rc(tid * 16 + i * 8192, R, C); const int Rb = Epi::PERM ? ((R & ~31) + perm32(R & 31)) : R;
        voffA[i] = (unsigned)(R * K + C) * 2u; voffB[i] = (unsigned)(Rb * K + C) * 2u; }
    const size_t kstep = (size_t)(BK * 2);
    const size_t hstep = (size_t)HALF * K * 2;
    const unsigned ldsw = (unsigned)wid * 1024u;
    const int aoff = lds_byte(wr * 64 + fr, fq * 8), boff = lds_byte(wc * 32 + fr, fq * 8);
#define PG8_SA(b, h) (((b) * 2 + (h)) * HTB)
#define PG8_SB(b, h) ((4 + (b) * 2 + (h)) * HTB)
#define PG8_STAGE(bufoff, gbase, voff) do { _Pragma("unroll") for (int _i = 0; _i < 2; ++_i) \
        __builtin_amdgcn_global_load_lds((const unsigned*)((const char*)(gbase) + (voff)[_i]), (LAS unsigned*)(lds + (bufoff) + ldsw + _i * 8192), 16, 0, 0); } while (0)
#define PG8_STAGE_A(b, h, ptr, gv) do { if constexpr (Sched::GATHER) { PG8_STAGE(PG8_SA(b, h), ptr, gv[h]); } else { PG8_STAGE(PG8_SA(b, h), (ptr) + ((h) ? hstep : 0), voffA); } } while (0)
#define PG8_LDA(dst, b, h) do { _Pragma("unroll") for (int m = 0; m < 4; ++m) _Pragma("unroll") for (int k = 0; k < 2; ++k) dst[m][k] = *(const LAS bf16x8*)(lds + PG8_SA(b, h) + aoff + m * 2048 + k * 1024); } while (0)
#define PG8_LDB(dst, b, h) do { _Pragma("unroll") for (int n = 0; n < 2; ++n) _Pragma("unroll") for (int k = 0; k < 2; ++k) dst[n][k] = *(const LAS bf16x8*)(lds + PG8_SB(b, h) + boff + n * 2048 + k * 1024); } while (0)
#define PG8_MMA(ai, bj, At, Bt) do { __builtin_amdgcn_s_setprio(1); _Pragma("unroll") for (int m = 0; m < 4; ++m) _Pragma("unroll") for (int n = 0; n < 2; ++n) _Pragma("unroll") for (int k = 0; k < 2; ++k) \
        acc[ai][bj][m][n] = __builtin_amdgcn_mfma_f32_16x16x32_bf16(Bt[n][k], At[m][k], acc[ai][bj][m][n], 0, 0, 0); __builtin_amdgcn_s_setprio(0); } while (0)
#define PG8_WAIT_V(n) asm volatile("s_waitcnt vmcnt(" #n ")" ::: "memory")
#define PG8_WAIT_L(n) asm volatile("s_waitcnt lgkmcnt(" #n ")" ::: "memory")
#define PG8_BAR __builtin_amdgcn_s_barrier()
#define PG8_SCHED __builtin_amdgcn_sched_barrier(0)
    Unit cur, nxt; int ui = 0;
    if (!S.next(0, cur)) return;
    f32x4 acc[2][2][4][2];
#pragma unroll
    for (int a = 0; a < 2; ++a)
#pragma unroll
        for (int b = 0; b < 2; ++b)
#pragma unroll
            for (int m = 0; m < 4; ++m)
#pragma unroll
                for (int n = 0; n < 2; ++n) acc[a][b][m][n] = (f32x4){0.f, 0.f, 0.f, 0.f};
    bf16x8 At[4][2], B0[2][2], B1[2][2];
    unsigned cv[2][2], nv[2][2];
    const char* cA = S.a_ptr(cur); const char* cB = S.b_ptr(cur);
    if constexpr (Sched::GATHER) { S.a_voff(cur, cv, tid);
#pragma unroll
        for (int h = 0; h < 2; ++h)
#pragma unroll
            for (int i = 0; i < 2; ++i) nv[h][i] = cv[h][i]; }
    PG8_STAGE(PG8_SB(0, 0), cB, voffB); PG8_STAGE(PG8_SB(0, 1), cB + hstep, voffB); PG8_STAGE_A(0, 0, cA, cv); PG8_STAGE_A(0, 1, cA, cv);
    if (wr == 1) PG8_BAR;
    PG8_WAIT_V(2); PG8_BAR;
    PG8_STAGE(PG8_SB(1, 0), cB + kstep, voffB); PG8_STAGE_A(1, 0, cA + kstep, cv); PG8_STAGE(PG8_SB(1, 1), cB + hstep + kstep, voffB);
    PG8_WAIT_V(6); PG8_BAR;
    for (;;) {
        const bool has_next = S.next(ui + 1, nxt);
        const char* nA = has_next ? S.a_ptr(nxt) : cA; const char* nB = has_next ? S.b_ptr(nxt) : cB;
        if constexpr (Sched::GATHER) { if (has_next) S.a_voff(nxt, nv, tid); }
        for (int t = 0; t < nt; t += 2) {
            const bool last = (t == nt - 2);
            const char* a1 = cA + (size_t)(t + 1) * kstep;
            const char* a2 = last ? nA : cA + (size_t)(t + 2) * kstep; const char* b2 = last ? nB : cB + (size_t)(t + 2) * kstep;
            const char* a3 = a2 + kstep; const char* b3 = b2 + kstep;
            unsigned v2[2][2];
            if constexpr (Sched::GATHER) {
#pragma unroll
                for (int h = 0; h < 2; ++h)
#pragma unroll
                    for (int i = 0; i < 2; ++i) v2[h][i] = last ? nv[h][i] : cv[h][i]; }
            PG8_LDB(B0, 0, 0); PG8_LDB(B1, 0, 1); PG8_SCHED; PG8_LDA(At, 0, 0); PG8_STAGE_A(1, 1, a1, cv);
            PG8_WAIT_V(8); PG8_WAIT_L(0); PG8_BAR; PG8_MMA(0, 0, At, B0); PG8_MMA(0, 1, At, B1); PG8_BAR; PG8_SCHED;
            PG8_LDA(At, 0, 1); PG8_STAGE(PG8_SB(0, 0), b2, voffB); PG8_STAGE(PG8_SB(0, 1), b2 + hstep, voffB); PG8_STAGE_A(0, 0, a2, v2);
            PG8_WAIT_V(8); PG8_WAIT_L(0); PG8_BAR; PG8_MMA(1, 0, At, B0); PG8_MMA(1, 1, At, B1); PG8_BAR; PG8_SCHED;
            PG8_LDB(B0, 1, 0); PG8_LDB(B1, 1, 1); PG8_SCHED; PG8_LDA(At, 1, 0); PG8_STAGE_A(0, 1, a2, v2);
            PG8_WAIT_V(8); PG8_WAIT_L(0); PG8_BAR; PG8_MMA(0, 0, At, B0); PG8_MMA(0, 1, At, B1); PG8_BAR; PG8_SCHED;
            PG8_LDA(At, 1, 1); PG8_STAGE(PG8_SB(1, 0), b3, voffB); PG8_STAGE(PG8_SB(1, 1), b3 + hstep, voffB); PG8_STAGE_A(1, 0, a3, v2);
            PG8_WAIT_V(8); PG8_WAIT_L(0); PG8_BAR; PG8_MMA(1, 0, At, B0); PG8_MMA(1, 1, At, B1); PG8_BAR; PG8_SCHED;
        }
        if constexpr (ALIGN_EPI) { if (wr == 0) PG8_BAR; }
        E(acc, cur, wr, wc, fr, fq);
        if (!has_next) break;
#pragma unroll
        for (int a = 0; a < 2; ++a)
#pragma unroll
            for (int b = 0; b < 2; ++b)
#pragma unroll
                for (int m = 0; m < 4; ++m)
#pragma unroll
                    for (int n = 0; n < 2; ++n) acc[a][b][m][n] = (f32x4){0.f, 0.f, 0.f, 0.f};
        cur = nxt; cA = nA; cB = nB; ++ui;
        if constexpr (Sched::GATHER) {
#pragma unroll
            for (int h = 0; h < 2; ++h)
#pragma unroll
                for (int i = 0; i < 2; ++i) cv[h][i] = nv[h][i]; }
        if constexpr (ALIGN_EPI) { if (wr == 1) PG8_BAR; }
    }
    PG8_WAIT_V(0);
    if constexpr (!ALIGN_EPI) { if (wr == 0) PG8_BAR; }
    PG8_BAR;
#undef PG8_SA
#undef PG8_SB
#undef PG8_STAGE
#undef PG8_STAGE_A
#undef PG8_LDA
#undef PG8_LDB
#undef PG8_MMA
#undef PG8_WAIT_V
#undef PG8_WAIT_L
#undef PG8_BAR
#undef PG8_SCHED
}
}

struct Args { const float* in[24]; float* out; unsigned char* ws; int ph_lo, ph_hi, li, pad; };
struct Frame {
    LAS unsigned char* lds;
    unsigned* ctl;
    int wave, vcu, G;
    unsigned char* ws;
};
__device__ __forceinline__ int cur_lane() { int l; asm volatile("v_mbcnt_lo_u32_b32 %0, -1, 0\n\tv_mbcnt_hi_u32_b32 %0, -1, %0" : "=v"(l)); return l; }
#define FTID(F) ((F).wave * 64 + cur_lane())

#define AMP_SPIN(k) do { if (PROBE_AMP == (k)) { __syncthreads(); const unsigned long long t0_ = *(volatile LAS unsigned long long*)(F.lds + MISC_OFF + 32), t1_ = __builtin_amdgcn_s_memrealtime(), tg_ = t1_ + 3ull * (t1_ - t0_); \
            while (__builtin_amdgcn_s_memrealtime() < tg_) __builtin_amdgcn_s_sleep(20); __syncthreads(); } \
        if (PROBE_AMP >= 0) { if (FTID(F) == 0) *(volatile LAS unsigned long long*)(F.lds + MISC_OFF + 32) = __builtin_amdgcn_s_memrealtime(); } } while (0)

__device__ __forceinline__ int rowmap(int mode, int n) { return mode == 0 ? n : ((n >> 7) * 256 + (n & 127) + (mode == 2 ? 128 : 0)); }
__device__ __forceinline__ void p0_transpose_item(const float* W, int K, int N, bf16* WT, int mode, LAS float* scr, int item, int lane) {
    const int nblk = (N + 63) / 64, kb = item / nblk, nb = item % nblk, k0 = 64 * kb, n0 = 64 * nb;
    const int nn = n0 + lane; const bool ok = nn < N;
    float tv[64];
#pragma unroll
    for (int i = 0; i < 64; ++i) tv[i] = ok ? W[(size_t)(k0 + i) * N + nn] : 0.f;
#pragma unroll
    for (int i = 0; i < 64; ++i) scr[i * 65 + lane] = tv[i];
    LDS_WAIT(); asm volatile("" ::: "memory");
    const int c = lane & 7;
#pragma unroll
    for (int j = 0; j < 8; ++j) { const int n = (lane >> 3) + 8 * j; const LAS float* s = scr + (8 * c) * 65 + n;
        u32x4 o; o.x = cvt_pk_bf16(s[0 * 65], s[1 * 65]); o.y = cvt_pk_bf16(s[2 * 65], s[3 * 65]); o.z = cvt_pk_bf16(s[4 * 65], s[5 * 65]); o.w = cvt_pk_bf16(s[6 * 65], s[7 * 65]);
        if (n0 + n < N) *(u32x4*)(WT + (size_t)rowmap(mode, n0 + n) * K + k0 + 8 * c) = o; }
    LDS_WAIT(); asm volatile("" ::: "memory");
}
__device__ __forceinline__ void p0_prologue(Frame& F, const Args& a) {
    const int gw = F.vcu * 8 + F.wave, NGW = F.G * 8, lane = cur_lane(), tid = FTID(F);
    float* ada = (float*)(F.ws + WS_ADA);
    {
        LAS float* sS = (LAS float*)F.lds;
        LAS float* sP = (LAS float*)(F.lds + 36864);
        bool staged = false;
        for (int it = blockIdx.x; it < 192; it += F.G) {
            if (!staged) {
                for (int i = tid; i < 9 * 1024; i += 512) { const int r = i >> 10, k = i & 1023; const float v = r < 8 ? a.in[1][r * 1024 + k] : a.in[3][k]; sS[i] = v / (1.f + __expf(-v)); }
                staged = true;
            }
            __syncthreads();
            const int n = it * 32 + (lane & 31), kh = lane >> 5, kb = F.wave * 128;
            float acc[9];
#pragma unroll
            for (int r = 0; r < 9; ++r) acc[r] = 0.f;
            const float* W = a.in[4];
            for (int jb = 0; jb < 64; jb += 16) {
                float wv[16];
#pragma unroll
                for (int j = 0; j < 16; ++j) wv[j] = W[(size_t)(kb + 2 * (jb + j) + kh) * 6144 + n];
#pragma unroll
                for (int j = 0; j < 16; ++j) { const int k = kb + 2 * (jb + j) + kh;
#pragma unroll
                    for (int r = 0; r < 9; ++r) acc[r] += sS[r * 1024 + k] * wv[j]; }
            }
#pragma unroll
            for (int r = 0; r < 9; ++r) { acc[r] += __shfl_xor(acc[r], 32); if (lane < 32) sP[(F.wave * 9 + r) * 32 + lane] = acc[r]; }
            __syncthreads();
            if (tid < 288) { const int r = tid >> 5, c = tid & 31; float s = a.in[5][it * 32 + c];
#pragma unroll
                for (int w = 0; w < 8; ++w) s += sP[(w * 9 + r) * 32 + c];
                ada[r * 6144 + it * 32 + c] = s; }
        }
        __syncthreads();
    }
    { float* rope = (float*)(F.ws + WS_ROPE);
      for (int i = blockIdx.x * 512 + tid; i < 128 * 32; i += F.G * 512) { const int pos = i >> 5, j = i & 31; const double ang = (double)pos * pow(10000.0, -(double)j / 32.0);
          rope[2 * i] = (float)cos(ang); rope[2 * i + 1] = (float)sin(ang); } }
    { bf16* wr = (bf16*)(F.ws + WS_WR);
      for (int i = blockIdx.x * 512 + tid; i < 80 * 1024; i += F.G * 512) { const int r = i >> 10, k = i & 1023; float v = 0.f;
          if (r < 8) v = a.in[15][k * 8 + r]; else if (r >= 16) v = a.in[17][k * 64 + (r - 16)];
          wr[i] = (bf16)(cvt_pk_bf16(v, 0.f) & 0xffffu); } }
    LAS float* scr = (LAS float*)(F.lds + 16384 + F.wave * 16640);
    constexpr int B_IN = 4 * 29, B_OUT = 4 * 8, B_E = 16;
    constexpr int NBITEMS = B_IN + B_OUT + 3 * NEXP * B_E;
    const int wk = F.wave >> 1, wn = F.wave & 1;
    for (int bi = F.vcu; bi < NBITEMS; bi += F.G) {
        int r = bi;
        if (r < B_IN) { const int kb = 4 * (r / 29) + wk, nb = 2 * (r % 29) + wn; if (nb < 57) p0_transpose_item(a.in[6], 1024, IN_COLS, (bf16*)(F.ws + WS_WIN), 0, scr, kb * 57 + nb, lane); continue; } r -= B_IN;
        if (r < B_OUT) { const int kb = 4 * (r / 8) + wk, nb = 2 * (r % 8) + wn; p0_transpose_item(a.in[12], 1024, 1024, (bf16*)(F.ws + WS_WOUT), 0, scr, kb * 16 + nb, lane); continue; } r -= B_OUT;
        if (r < NEXP * B_E) { const int e = r >> 4, q = r & 15, kb = 4 * (q >> 2) + wk, nb = 2 * (q & 3) + wn; p0_transpose_item(a.in[19] + (size_t)e * 1024 * 512, 1024, 512, (bf16*)(F.ws + WS_W13) + (size_t)e * 1024 * 1024, 1, scr, kb * 8 + nb, lane); continue; } r -= NEXP * B_E;
        if (r < NEXP * B_E) { const int e = r >> 4, q = r & 15, kb = 4 * (q >> 2) + wk, nb = 2 * (q & 3) + wn; p0_transpose_item(a.in[20] + (size_t)e * 1024 * 512, 1024, 512, (bf16*)(F.ws + WS_W13) + (size_t)e * 1024 * 1024, 2, scr, kb * 8 + nb, lane); continue; } r -= NEXP * B_E;
        { const int e = r >> 4, q = r & 15, kb = 4 * (q >> 3) + wk, nb = 2 * (q & 7) + wn; p0_transpose_item(a.in[21] + (size_t)e * 512 * 1024, 512, 1024, (bf16*)(F.ws + WS_W2) + (size_t)e * 1024 * 512, 0, scr, kb * 16 + nb, lane); }
    }
}

__device__ __forceinline__ void p1_ln_mod(Frame& F, const Args& a) {
    const int lane = opaque(cur_lane()), g = lane >> 4, lq = lane & 15;
    const float* ada = (const float*)(F.ws + WS_ADA);
    bf16* XM = (bf16*)(F.ws + WS_XM); float* GT = (float*)(F.ws + WS_GATES);
    const bf16* WG = (const bf16*)(F.ws + WS_WIN) + (size_t)3584 * 1024;
    const f32x4 gb = *(const f32x4*)(a.in[9] + 4 * g);
    const int RPB = (((MT + F.G - 1) / F.G) + 15) & ~15;
    const int rb0 = F.vcu * RPB, rb1 = rb0 + RPB < MT ? rb0 + RPB : MT;
    for (int m0 = rb0 + F.wave; m0 < rb1; m0 += 32) {
        f32x4 v[4][4]; float s[4]; bool ok[4]; int mm[4];
#pragma unroll
        for (int r = 0; r < 4; ++r) { const int m = m0 + 8 * r; ok[r] = m < rb1; mm[r] = ok[r] ? m : m0;
            const f32x4* xr = (const f32x4*)(mm[r] < ML_ROWS ? a.in[0] + (size_t)mm[r] * DM : a.in[2] + (size_t)(mm[r] - ML_ROWS) * DM) + lane;
#pragma unroll
            for (int j = 0; j < 4; ++j) v[r][j] = xr[64 * j]; }
#pragma unroll
        for (int r = 0; r < 4; ++r) { s[r] = 0.f;
#pragma unroll
            for (int j = 0; j < 4; ++j) s[r] += (v[r][j].x + v[r][j].y) + (v[r][j].z + v[r][j].w); }
        wave_sum4(s);
#pragma unroll
        for (int r = 0; r < 4; ++r) { const float mean = s[r] * (1.f / DM); s[r] = 0.f;
#pragma unroll
            for (int j = 0; j < 4; ++j) { v[r][j] = v[r][j] - mean; s[r] += (v[r][j].x * v[r][j].x + v[r][j].y * v[r][j].y) + (v[r][j].z * v[r][j].z + v[r][j].w * v[r][j].w); } }
        wave_sum4(s);
#pragma unroll
        for (int r = 0; r < 4; ++r) {
            const float rstd = 1.f / sqrtf(s[r] * (1.f / DM) + LN_EPS);
            const int ab = mm[r] < ML_ROWS ? (mm[r] >> 13) : 8;
            const f32x4* sh = (const f32x4*)(ada + ab * 6144) + lane; const f32x4* sc = sh + 256;
            u32x2* o8 = (u32x2*)(XM + (size_t)mm[r] * DM) + lane;
            if (ok[r]) {
#pragma unroll
                for (int j = 0; j < 4; ++j) { const f32x4 h = sh[64 * j], c = sc[64 * j]; const f32x4 y = (v[r][j] * rstd) * (c + 1.f) + h;
                    o8[64 * j] = (u32x2){cvt_pk_bf16(y.x, y.y), cvt_pk_bf16(y.z, y.w)}; } }
        }
    }
    VM_WAIT(); __syncthreads();
    for (int row0 = rb0 + 16 * F.wave; row0 < rb1; row0 += 128) {
        f32x4 ga = (f32x4){0.f, 0.f, 0.f, 0.f};
        const bf16* xp = XM + (size_t)(row0 + lq) * 1024 + 8 * g; const bf16* wp = WG + (size_t)lq * 1024 + 8 * g;
#pragma unroll 8
        for (int kk = 0; kk < 32; ++kk) ga = __builtin_amdgcn_mfma_f32_16x16x32_bf16(*(const bf16x8*)(wp + 32 * kk), __builtin_nontemporal_load((const bf16x8*)(xp + 32 * kk)), ga, 0, 0, 0);
        *(f32x4*)(GT + (size_t)(row0 + lq) * 16 + 4 * g) = ga + gb;
    }
}

struct EpiZ {
    static constexpr bool PERM = true;
    unsigned char* ws; const float* gate_b;
    __device__ __forceinline__ void operator()(const f32x4 (&acc)[2][2][4][2], const pg8::Unit& u, int wr, int wc, int fr, int fq) const {
        const int row0 = u.pm * 256 + wr * 64 + fr;
        {
            bf16* base; int ldc, colt;
            if (u.pn < 6) { base = (bf16*)(ws + WS_ZA); ldc = 1536; colt = u.pn * 256; }
            else if (u.pn < 10) { base = (bf16*)(ws + WS_ZQK); ldc = 1024; colt = (u.pn - 6) * 256; }
            else if (u.pn < 12) { base = (bf16*)(ws + WS_ZV); ldc = 512; colt = (u.pn - 10) * 256; }
            else { base = (bf16*)(ws + WS_ZO); ldc = 512; colt = (u.pn - 12) * 256; }
            const int col0 = colt + wc * 32 + 8 * fq;
#pragma unroll
            for (int ai = 0; ai < 2; ++ai)
#pragma unroll
                for (int m = 0; m < 4; ++m) { bf16* rowp = base + (size_t)(row0 + ai * 128 + m * 16) * ldc + col0;
#pragma unroll
                    for (int bj = 0; bj < 2; ++bj) { const f32x4 v0 = acc[ai][bj][m][0], v1 = acc[ai][bj][m][1];
                        u32x4 w; w.x = cvt_pk_bf16(v0[0], v0[1]); w.y = cvt_pk_bf16(v0[2], v0[3]); w.z = cvt_pk_bf16(v1[0], v1[1]); w.w = cvt_pk_bf16(v1[2], v1[3]);
                        *(u32x4*)(rowp + bj * 128) = w; } }
        }
    }
};

__device__ __forceinline__ void p3_qkprep(Frame& F, const Args& a) {
    const int lane = cur_lane(), half = F.wave & 1;
    const int gwh = (F.vcu * 8 + F.wave) >> 1, NGH = F.G * 4;
    const bf16* ZQK = (const bf16*)(F.ws + WS_ZQK); bf16* QKP = (bf16*)(F.ws + WS_XM);
    const float* rope = (const float*)(F.ws + WS_ROPE);
    const int ch0 = half * 512 + 8 * lane, i0 = 8 * (lane & 3);
    const bool col_rot = ((lane >> 3) & 1) != 0, second = ((lane >> 2) & 1) != 0;
    float w[5][8], bia[8];
#pragma unroll
    for (int j = 0; j < 5; ++j) { const f32x4 w0 = *(const f32x4*)(a.in[7] + j * 1024 + ch0), w1 = *(const f32x4*)(a.in[7] + j * 1024 + ch0 + 4);
#pragma unroll
        for (int e = 0; e < 4; ++e) { w[j][e] = w0[e]; w[j][4 + e] = w1[e]; } }
    { const f32x4 b0 = *(const f32x4*)(a.in[8] + ch0), b1 = *(const f32x4*)(a.in[8] + ch0 + 4);
#pragma unroll
      for (int e = 0; e < 4; ++e) { bia[e] = b0[e]; bia[4 + e] = b1[e]; } }
    float cst[8], sst[8];
#pragma unroll
    for (int q = 0; q < 4; ++q) { const f32x4 t = *(const f32x4*)(rope + (size_t)(32 + i0 + 2 * q) * 2);
        cst[2 * q] = col_rot ? t.x : 1.f; sst[2 * q] = col_rot ? t.y : 0.f; cst[2 * q + 1] = col_rot ? t.z : 1.f; sst[2 * q + 1] = col_rot ? t.w : 0.f; }
    const float ksc = half ? 0.08838834764831845f : 1.f;
    constexpr int RUN = 8, NITEM = MT / RUN;
    for (int it = gwh; it < NITEM; it += NGH) {
        const int row0 = it * RUN;
        const bool lat = row0 < ML_ROWS;
        const int T = lat ? SEQ : CTXL, s0 = lat ? (row0 & (SEQ - 1)) : ((row0 - ML_ROWS) & (CTXL - 1));
        u32x4 win[12];
#pragma unroll
        for (int j = 0; j < 12; ++j) { const int s = s0 + j - 2; const bool ok = s >= 0 && s < T;
            win[j] = ok ? *(const u32x4*)(ZQK + (size_t)(row0 + j - 2) * 1024 + ch0) : (u32x4){0u, 0u, 0u, 0u}; }
        float cc[8], ss[8];
        if (lat) { const int pos = col_rot ? (s0 & 63) : (s0 >> 6);
#pragma unroll
            for (int q = 0; q < 4; ++q) { const f32x4 t = *(const f32x4*)(rope + (size_t)(pos * 32 + i0 + 2 * q) * 2); cc[2 * q] = t.x; ss[2 * q] = t.y; cc[2 * q + 1] = t.z; ss[2 * q + 1] = t.w; }
        } else {
#pragma unroll
            for (int e = 0; e < 8; ++e) { cc[e] = 1.f; ss[e] = 0.f; }
        }
#pragma unroll
        for (int r = 0; r < RUN; ++r) {
            float u[8];
#pragma unroll
            for (int e = 0; e < 8; ++e) u[e] = bia[e];
#pragma unroll
            for (int j = 0; j < 5; ++j)
#pragma unroll
                for (int q = 0; q < 4; ++q) { const unsigned x = win[r + j][q]; u[2 * q] += w[j][2 * q] * bf_lo(x); u[2 * q + 1] += w[j][2 * q + 1] * bf_hi(x); }
            u32x4 o;
            float v[8];
#pragma unroll
            for (int e = 0; e < 8; ++e) { const float sv = u[e] * __builtin_amdgcn_rcpf(1.f + __expf(-u[e])); const float ot = __shfl_xor(sv, 4);
                v[e] = (sv * cc[e] + ot * (second ? ss[e] : -ss[e])) * ksc; }
#pragma unroll
            for (int q = 0; q < 4; ++q) o[q] = cvt_pk_bf16(v[2 * q], v[2 * q + 1]);
            *(u32x4*)(QKP + (size_t)(row0 + r) * 1024 + ch0) = o;
            if (lat && r + 1 < RUN) {
#pragma unroll
                for (int e = 0; e < 8; ++e) { const float c2 = cc[e] * cst[e] - ss[e] * sst[e], s2 = ss[e] * cst[e] + cc[e] * sst[e]; cc[e] = c2; ss[e] = s2; }
            }
        }
    }
}

constexpr int NA_SLOTS = 11;
constexpr int NA_VR = 0, NA_VC = 90112, NA_KC = 122880, NA_RPB = 155648;
static_assert(NA_RPB + 2048 <= PH_BYTES, "NA LDS");
__device__ __forceinline__ int na_r0(int r) { return r - 4 < 0 ? 0 : (r - 4 > 120 ? 120 : r - 4); }
__device__ __forceinline__ void p3_na(Frame& F, const Args& a) {
    const int w = F.wave, lane = cur_lane(), tid = FTID(F), cg = w & 3, rsel = w >> 2, g = lane >> 4, lq = lane & 15, qp = lq >> 2, pp = lane & 3;
    const bf16* ZA = (const bf16*)(F.ws + WS_ZA); bf16* MIX = (bf16*)(F.ws + WS_MIX);
    LAS unsigned char* VR = F.lds + NA_VR; LAS unsigned char* VC = F.lds + NA_VC; LAS unsigned char* KC = F.lds + NA_KC; LAS float* RPB = (LAS float*)(F.lds + NA_RPB);
    const int cs = cg == 0 ? 0 : (cg == 1 ? 8 : (cg == 2 ? 24 : 32));
    const int qc = 16 * cg + lq, c0q = qc - 8 < 0 ? 0 : (qc - 8 > 48 ? 48 : qc - 8);
    const int sw = (4 * g + qp) & 7;
    unsigned voff[4], koff[2];
#pragma unroll
    for (int dt = 0; dt < 4; ++dt) voff[dt] = (unsigned)((((2 * dt + (pp >> 1)) ^ sw) * 16) + 8 * (pp & 1) + (4 * g + qp) * 128);
#pragma unroll
    for (int kk = 0; kk < 2; ++kk) koff[kk] = (unsigned)(lq * 128 + (((4 * kk + g) ^ ((lq >> 1) & 7)) * 16));
    unsigned cooff[2][4];
#pragma unroll
    for (int tt = 0; tt < 2; ++tt)
#pragma unroll
        for (int j = 0; j < 4; ++j) { const int kc = cs + 16 * tt + 4 * g + j; const bool valid = kc >= c0q && kc < c0q + 16; cooff[tt][j] = (unsigned)((valid ? kc - qc + 15 : 31) * 4); }
    const float CE = 0.125f * 1.4426950408889634f;
    const int sc = tid >> 3, sch = tid & 7;
    for (int su = blockIdx.x; su < 256; su += F.G) {
        const int bh = su >> 2, head = bh & 7, b = bh >> 3, R0 = (su & 3) * 32;
        __syncthreads();
#pragma unroll
        for (int i = 0; i < 4; ++i) { const int idx = tid + 512 * i, key = idx >> 3, ch = idx & 7; const bf16* src = ZA + ((size_t)(ML_ROWS + b * CTXL + key)) * 1536 + head * 64 + ch * 8;
            *(LAS u32x4*)(KC + key * 128 + ((ch ^ ((key >> 1) & 7)) * 16)) = *(const u32x4*)(src + 512);
            *(LAS u32x4*)(VC + key * 128 + ((ch ^ (key & 7)) * 16)) = *(const u32x4*)(src + 1024); }
        if (tid < 480) { const int rw = tid >> 5, co = tid & 31; RPB[tid] = co < 31 ? 8.f * a.in[10][head * 465 + rw * 31 + co] : -1e30f; }
        int hw = na_r0(R0); const int hi0 = na_r0(R0 + 1) + 8;
        for (int rho = hw; rho < hi0; ++rho) *(LAS u32x4*)(VR + ((rho % NA_SLOTS) * 64 + sc) * 128 + ((sch ^ (sc & 7)) * 16)) = *(const u32x4*)(ZA + ((size_t)(b * SEQ + rho * 64 + sc)) * 1536 + 1024 + head * 64 + sch * 8);
        hw = hi0;
        __syncthreads();
        for (int p = 0; p < 16; ++p) {
            const int ra = R0 + 2 * p, r = ra + rsel, r0 = na_r0(r);
            const int nhi = p < 15 ? na_r0(ra + 3) + 8 : hw, nnew = nhi - hw;
            u32x4 pre0 = (u32x4){0u, 0u, 0u, 0u}, pre1 = pre0;
            if (nnew > 0) pre0 = *(const u32x4*)(ZA + ((size_t)(b * SEQ + hw * 64 + sc)) * 1536 + 1024 + head * 64 + sch * 8);
            if (nnew > 1) pre1 = *(const u32x4*)(ZA + ((size_t)(b * SEQ + (hw + 1) * 64 + sc)) * 1536 + 1024 + head * 64 + sch * 8);
            const size_t qtok = (size_t)b * SEQ + r * 64 + qc;
            bf16x8 qf[2];
#pragma unroll
            for (int kk = 0; kk < 2; ++kk) qf[kk] = *(const bf16x8*)(ZA + qtok * 1536 + head * 64 + 32 * kk + 8 * g);
            f32x4 s[16], o[4];
#pragma unroll
            for (int dt = 0; dt < 4; ++dt) o[dt] = (f32x4){0.f, 0.f, 0.f, 0.f};
            {
                bf16x8 ka = *(const LAS bf16x8*)(KC + koff[0]), kb = *(const LAS bf16x8*)(KC + koff[1]);
#pragma unroll
                for (int t = 0; t < 16; ++t) {
                    bf16x8 na = ka, nb = kb;
                    if (t < 15) { na = *(const LAS bf16x8*)(KC + (t + 1) * 2048 + koff[0]); nb = *(const LAS bf16x8*)(KC + (t + 1) * 2048 + koff[1]); }
                    __builtin_amdgcn_sched_barrier(0);
                    f32x4 acc = (f32x4){0.f, 0.f, 0.f, 0.f};
                    acc = __builtin_amdgcn_mfma_f32_16x16x32_bf16(ka, qf[0], acc, 0, 0, 0);
                    acc = __builtin_amdgcn_mfma_f32_16x16x32_bf16(kb, qf[1], acc, 0, 0, 0);
                    s[t] = acc;
                    __builtin_amdgcn_sched_barrier(0);
                    ka = na; kb = nb;
                }
            }
            float mx = -1e30f;
#pragma unroll
            for (int t = 0; t < 16; ++t) mx = fmaxf(mx, fmaxf(fmaxf(s[t][0], s[t][1]), fmaxf(s[t][2], s[t][3])));
            mx = fmaxf(mx, __shfl_xor(mx, 16)); mx = fmaxf(mx, __shfl_xor(mx, 32));
            float sum = 0.f;
            { const float nm = -mx * CE;
#pragma unroll
              for (int t = 0; t < 16; ++t)
#pragma unroll
                  for (int j = 0; j < 4; ++j) { const float pv = __builtin_amdgcn_exp2f(__builtin_fmaf(s[t][j], CE, nm)); s[t][j] = pv; sum += pv; } }
            {
                bf16x4 va[4][2];
#pragma unroll
                for (int dt = 0; dt < 4; ++dt) { va[dt][0] = tr_read(VC + voff[dt]); va[dt][1] = tr_read(VC + 2048 + voff[dt]); }
#pragma unroll
                for (int kp = 0; kp < 8; ++kp) {
                    bf16x4 vn[4][2];
#pragma unroll
                    for (int dt = 0; dt < 4; ++dt) { vn[dt][0] = va[dt][0]; vn[dt][1] = va[dt][1]; }
                    if (kp < 7) {
#pragma unroll
                        for (int dt = 0; dt < 4; ++dt) { vn[dt][0] = tr_read(VC + (kp + 1) * 4096 + voff[dt]); vn[dt][1] = tr_read(VC + (kp + 1) * 4096 + 2048 + voff[dt]); } }
                    const bf16x8 pf = as_bf16x8((u32x4){cvt_pk_bf16(s[2 * kp][0], s[2 * kp][1]), cvt_pk_bf16(s[2 * kp][2], s[2 * kp][3]), cvt_pk_bf16(s[2 * kp + 1][0], s[2 * kp + 1][1]), cvt_pk_bf16(s[2 * kp + 1][2], s[2 * kp + 1][3])});
                    __builtin_amdgcn_sched_barrier(0);
#pragma unroll
                    for (int dt = 0; dt < 4; ++dt) o[dt] = __builtin_amdgcn_mfma_f32_16x16x32_bf16(cat4(va[dt][0], va[dt][1]), pf, o[dt], 0, 0, 0);
                    __builtin_amdgcn_sched_barrier(0);
#pragma unroll
                    for (int dt = 0; dt < 4; ++dt) { va[dt][0] = vn[dt][0]; va[dt][1] = vn[dt][1]; }
                }
            }
            {
                const bf16* kbase = ZA + ((size_t)b * SEQ + r0 * 64 + cs + lq) * 1536 + 512 + head * 64 + 8 * g;
                bf16x8 kc[2][2], kn[2][2];
#pragma unroll
                for (int tt = 0; tt < 2; ++tt) { kc[tt][0] = *(const bf16x8*)(kbase + (size_t)tt * 16 * 1536); kc[tt][1] = *(const bf16x8*)(kbase + (size_t)tt * 16 * 1536 + 32); }
#pragma unroll
                for (int tt = 0; tt < 2; ++tt) { kn[tt][0] = *(const bf16x8*)(kbase + (size_t)(64 + tt * 16) * 1536); kn[tt][1] = *(const bf16x8*)(kbase + (size_t)(64 + tt * 16) * 1536 + 32); }
#pragma unroll
                for (int rr = 0; rr < 8; ++rr) {
                    bf16x8 kf[2][2];
#pragma unroll
                    for (int tt = 0; tt < 2; ++tt) { kf[tt][0] = kn[tt][0]; kf[tt][1] = kn[tt][1]; }
                    if (rr < 6) {
#pragma unroll
                        for (int tt = 0; tt < 2; ++tt) { kf[tt][0] = *(const bf16x8*)(kbase + (size_t)((rr + 2) * 64 + tt * 16) * 1536); kf[tt][1] = *(const bf16x8*)(kbase + (size_t)((rr + 2) * 64 + tt * 16) * 1536 + 32); } }
                    const LAS unsigned char* rb = (const LAS unsigned char*)RPB + (r0 + rr - r + 7) * 128;
                    f32x4 ini[2];
#pragma unroll
                    for (int tt = 0; tt < 2; ++tt)
#pragma unroll
                        for (int j = 0; j < 4; ++j) ini[tt][j] = *(const LAS float*)(rb + cooff[tt][j]);
                    __builtin_amdgcn_sched_barrier(0);
#pragma unroll
                    for (int tt = 0; tt < 2; ++tt) { f32x4 acc = ini[tt];
                        acc = __builtin_amdgcn_mfma_f32_16x16x32_bf16(kc[tt][0], qf[0], acc, 0, 0, 0);
                        acc = __builtin_amdgcn_mfma_f32_16x16x32_bf16(kc[tt][1], qf[1], acc, 0, 0, 0);
                        s[rr * 2 + tt] = acc; }
                    __builtin_amdgcn_sched_barrier(0);
#pragma unroll
                    for (int tt = 0; tt < 2; ++tt) { kc[tt][0] = kn[tt][0]; kc[tt][1] = kn[tt][1]; kn[tt][0] = kf[tt][0]; kn[tt][1] = kf[tt][1]; }
                }
            }
            float m2 = -1e30f;
#pragma unroll
            for (int t = 0; t < 16; ++t) m2 = fmaxf(m2, fmaxf(fmaxf(s[t][0], s[t][1]), fmaxf(s[t][2], s[t][3])));
            m2 = fmaxf(m2, __shfl_xor(m2, 16)); m2 = fmaxf(m2, __shfl_xor(m2, 32));
            { const float M = fmaxf(mx, m2), al = __builtin_amdgcn_exp2f((mx - M) * CE), nm = -M * CE;
              sum *= al;
#pragma unroll
              for (int dt = 0; dt < 4; ++dt) o[dt] = o[dt] * al;
#pragma unroll
              for (int t = 0; t < 16; ++t)
#pragma unroll
                  for (int j = 0; j < 4; ++j) { const float pv = __builtin_amdgcn_exp2f(__builtin_fmaf(s[t][j], CE, nm)); s[t][j] = pv; sum += pv; } }
            {
                int slot = r0 % NA_SLOTS;
                const LAS unsigned char* vr = VR + (slot * 64 + cs) * 128;
                bf16x4 va[4][2];
#pragma unroll
                for (int dt = 0; dt < 4; ++dt) { va[dt][0] = tr_read(vr + voff[dt]); va[dt][1] = tr_read(vr + 2048 + voff[dt]); }
#pragma unroll
                for (int kp = 0; kp < 8; ++kp) {
                    slot = slot == NA_SLOTS - 1 ? 0 : slot + 1;
                    const LAS unsigned char* vx = VR + (slot * 64 + cs) * 128;
                    bf16x4 vn[4][2];
#pragma unroll
                    for (int dt = 0; dt < 4; ++dt) { vn[dt][0] = va[dt][0]; vn[dt][1] = va[dt][1]; }
                    if (kp < 7) {
#pragma unroll
                        for (int dt = 0; dt < 4; ++dt) { vn[dt][0] = tr_read(vx + voff[dt]); vn[dt][1] = tr_read(vx + 2048 + voff[dt]); } }
                    const bf16x8 pf = as_bf16x8((u32x4){cvt_pk_bf16(s[2 * kp][0], s[2 * kp][1]), cvt_pk_bf16(s[2 * kp][2], s[2 * kp][3]), cvt_pk_bf16(s[2 * kp + 1][0], s[2 * kp + 1][1]), cvt_pk_bf16(s[2 * kp + 1][2], s[2 * kp + 1][3])});
                    __builtin_amdgcn_sched_barrier(0);
#pragma unroll
                    for (int dt = 0; dt < 4; ++dt) o[dt] = __builtin_amdgcn_mfma_f32_16x16x32_bf16(cat4(va[dt][0], va[dt][1]), pf, o[dt], 0, 0, 0);
                    __builtin_amdgcn_sched_barrier(0);
#pragma unroll
                    for (int dt = 0; dt < 4; ++dt) { va[dt][0] = vn[dt][0]; va[dt][1] = vn[dt][1]; }
                }
            }
            sum += __shfl_xor(sum, 16); sum += __shfl_xor(sum, 32);
            { const float inv = 1.f / sum; bf16* op = MIX + qtok * 1024 + head * 64 + 4 * g;
#pragma unroll
              for (int dt = 0; dt < 4; ++dt) *(u32x2*)(op + 16 * dt) = (u32x2){cvt_pk_bf16(o[dt][0] * inv, o[dt][1] * inv), cvt_pk_bf16(o[dt][2] * inv, o[dt][3] * inv)}; }
            if (nnew > 0) *(LAS u32x4*)(VR + ((hw % NA_SLOTS) * 64 + sc) * 128 + ((sch ^ (sc & 7)) * 16)) = pre0;
            if (nnew > 1) *(LAS u32x4*)(VR + (((hw + 1) % NA_SLOTS) * 64 + sc) * 128 + ((sch ^ (sc & 7)) * 16)) = pre1;
            hw = nhi;
            __syncthreads();
        }
    }
    __syncthreads();
}

typedef float f32x16 __attribute__((ext_vector_type(16)));
constexpr int M2_QS = 0, M2_KS = 34816, M2_CT = 69632, M2_VS = 104448, M2_VEC = 145408;
constexpr int M2_RS = 272, M2_VR = 320;
static_assert(M2_VEC + 1040 * 4 <= PH_BYTES, "mLSTM LDS");
constexpr int REC_N = 16384, REC_S = 16512;
template <bool OUT>
__device__ __forceinline__ void mlstm_unit(Frame& F, const Args& a, const int sc, const int grp  , const bool FINAL) {
    const int w = F.wave, tid0 = opaque(FTID(F));
    int tid = tid0, lane = tid & 63, ln = lane & 31, h = lane >> 5, q4 = (lane & 15) >> 2, p4 = lane & 3, blk = (lane >> 4) & 1;
    const int dir = sc & 1, head = (sc >> 1) & 3, b = sc >> 3;
    const bf16* QKP = (const bf16*)(F.ws + WS_XM); const bf16* ZV = (const bf16*)(F.ws + WS_ZV); const float* GT = (const float*)(F.ws + WS_GATES);
    bf16* HB = (bf16*)(F.ws + WS_HB);
    float* REC = (float*)(F.ws + WS_MLST) + (size_t)sc * 9 * REC_FLOATS;
    LAS unsigned char* QS = F.lds + M2_QS; LAS unsigned char* KS = F.lds + M2_KS; LAS unsigned char* CT = F.lds + M2_CT; LAS unsigned char* VS = F.lds + M2_VS;
    LAS float* Va = (LAS float*)(F.lds + M2_VEC); LAS float* VA = Va + 128; LAS float* Vem = Va + 256; LAS float* Vin = Va + 384; LAS float* Vw = Va + 512; LAS float* Vn = Va + 640; LAS float* Vx = Va + 768; LAS float* Vs = Va + 1024;
    const int nch = grp < 0 ? 2 : 8;
    const int T = grp < 0 ? CTXL : SEQ;
    const size_t rowbase = grp < 0 ? (size_t)ML_ROWS + b * CTXL : (size_t)b * SEQ;
    const int sig0 = grp < 0 ? 0 : grp * 1024;
    const int tb = (int)((0x12032130u >> (4 * w)) & 3u), vh = w >> 2, db = w & 3;
    int trn = (8 * h + q4) * M2_VR + (16 * blk + 4 * p4) * 2;
    int trp = (4 * h + q4) * M2_VR + (16 * blk + 4 * p4) * 2;
    int trk = (8 * h + q4) * M2_RS + (16 * blk + 4 * p4) * 2;
    const bool nown = (vh == 0) && ((tid0 & 32) == 0);
    f32x16 Cacc[2]; float nreg = 0.f;
#pragma unroll
    for (int i = 0; i < 2; ++i)
#pragma unroll
        for (int r = 0; r < 16; ++r) Cacc[i][r] = 0.f;
    float m_prev = (grp < 0) ? 0.f : -1e30f, bsum = 0.f;
    if constexpr (OUT) {
        const float* R0 = REC;
        m_prev = R0[REC_S];
#pragma unroll
        for (int i = 0; i < 2; ++i)
#pragma unroll
            for (int qd = 0; qd < 4; ++qd) { const f32x4 t4 = *(const f32x4*)(R0 + (32 * (2 * vh + i) + ln) * 128 + 32 * db + 8 * qd + 4 * h);
                Cacc[i][4 * qd] = t4.x; Cacc[i][4 * qd + 1] = t4.y; Cacc[i][4 * qd + 2] = t4.z; Cacc[i][4 * qd + 3] = t4.w; }
        nreg = R0[REC_N + 32 * db + ln];
        for (int j = 0; j < grp; ++j) { const float* R = REC + (size_t)(1 + j) * REC_FLOATS; const float mj = R[REC_S], Bj = R[REC_S + 1];
            const float mn = fmaxf(Bj + m_prev, mj), f = __expf(Bj + m_prev - mn), gc = __expf(mj - mn);
#pragma unroll
            for (int i = 0; i < 2; ++i)
#pragma unroll
                for (int qd = 0; qd < 4; ++qd) { const f32x4 t4 = *(const f32x4*)(R + (32 * (2 * vh + i) + ln) * 128 + 32 * db + 8 * qd + 4 * h);
                    Cacc[i][4 * qd] = Cacc[i][4 * qd] * f + t4.x * gc; Cacc[i][4 * qd + 1] = Cacc[i][4 * qd + 1] * f + t4.y * gc; Cacc[i][4 * qd + 2] = Cacc[i][4 * qd + 2] * f + t4.z * gc; Cacc[i][4 * qd + 3] = Cacc[i][4 * qd + 3] * f + t4.w * gc; }
            nreg = nreg * f + R[REC_N + 32 * db + ln] * gc;
            m_prev = mn; }
    }
    __syncthreads();
    if constexpr (OUT) {
#pragma unroll
        for (int i = 0; i < 2; ++i)
#pragma unroll
            for (int qd = 0; qd < 4; ++qd) *(LAS u32x2*)(CT + (32 * (2 * vh + i) + ln) * M2_RS + (32 * db + 8 * qd + 4 * h) * 2) = (u32x2){cvt_pk_bf16(Cacc[i][4 * qd], Cacc[i][4 * qd + 1]), cvt_pk_bf16(Cacc[i][4 * qd + 2], Cacc[i][4 * qd + 3])};
        if (nown) Vn[32 * db + ln] = nreg;
    }
    u32x4 pq[4], pk[4], pv[4]; float gi0 = 0.f, gi1 = 0.f, gf0 = 0.f, gf1 = 0.f;
    const int gcol_i = (2 * dir) * 4 + head, gcol_f = (2 * dir + 1) * 4 + head;
#define ML_TOK(sig) (dir ? (T - 1 - (sig)) : (sig))
#define ML_LOAD(k) do { _Pragma("unroll") for (int j = 0; j < 4; ++j) { const int id = tid + 512 * j, row = id >> 4, ch = id & 15; const size_t gr = rowbase + ML_TOK(sig0 + (k) * 128 + row); \
            if (OUT) pq[j] = *(const u32x4*)(QKP + gr * 1024 + head * 128 + ch * 8); \
            pk[j] = *(const u32x4*)(QKP + gr * 1024 + 512 + head * 128 + ch * 8); pv[j] = *(const u32x4*)(ZV + gr * 512 + head * 128 + ch * 8); } \
        if (w == 0) { const size_t g0 = rowbase + ML_TOK(sig0 + (k) * 128 + 2 * lane), g1 = rowbase + ML_TOK(sig0 + (k) * 128 + 2 * lane + 1); \
            gi0 = GT[g0 * 16 + gcol_i]; gf0 = GT[g0 * 16 + gcol_f]; gi1 = GT[g1 * 16 + gcol_i]; gf1 = GT[g1 * 16 + gcol_f]; } } while (0)
    ML_LOAD(0);
    for (int k = 0; k < nch; ++k) {
        { const int z = *(volatile LAS int*)(F.lds + MISC_OFF + 48);
          tid = tid0 + z; lane = tid & 63; ln = lane & 31; h = lane >> 5; q4 = (lane & 15) >> 2; p4 = lane & 3; blk = (lane >> 4) & 1;
          trn = (8 * h + q4) * M2_VR + (16 * blk + 4 * p4) * 2; trp = (4 * h + q4) * M2_VR + (16 * blk + 4 * p4) * 2; trk = (8 * h + q4) * M2_RS + (16 * blk + 4 * p4) * 2; }
#pragma unroll
        for (int j = 0; j < 4; ++j) { const int id = tid + 512 * j, row = id >> 4, ch = id & 15;
            if (OUT) *(LAS u32x4*)(QS + row * M2_RS + ch * 16) = pq[j];
            *(LAS u32x4*)(KS + row * M2_RS + ch * 16) = pk[j]; *(LAS u32x4*)(VS + row * M2_VR + ch * 16) = pv[j]; }
        if (w == 0) {
            const float lf0 = fminf(gf0, 0.f) - log1pf(__expf(-fabsf(gf0))), lf1 = fminf(gf1, 0.f) - log1pf(__expf(-fabsf(gf1)));
            float P = lf0 + lf1;
#pragma unroll
            for (int o = 1; o < 64; o <<= 1) { const float t = __shfl_up(P, o); if (lane >= o) P += t; }
            const float b1 = P, b0 = P - lf1, a0 = gi0 - b0, a1 = gi1 - b1;
            float M = fmaxf(a0, a1);
#pragma unroll
            for (int o = 1; o < 64; o <<= 1) { const float t = __shfl_up(M, o); if (lane >= o) M = fmaxf(M, t); }
            float Mex = __shfl_up(M, 1); if (lane == 0) Mex = -1e30f;
            const float A0 = fmaxf(m_prev, fmaxf(Mex, a0)), A1 = fmaxf(m_prev, M);
            const float Aend = __shfl(A1, 63), bend = __shfl(b1, 63);
            *(LAS f32x2*)(Va + 2 * lane) = (f32x2){a0, a1}; *(LAS f32x2*)(VA + 2 * lane) = (f32x2){A0, A1};
            *(LAS f32x2*)(Vem + 2 * lane) = (f32x2){__expf(-(b0 + A0)), __expf(-(b1 + A1))};
            *(LAS f32x2*)(Vin + 2 * lane) = (f32x2){__expf(m_prev - A0), __expf(m_prev - A1)};
            *(LAS f32x2*)(Vw + 2 * lane) = (f32x2){__expf(a0 - Aend), __expf(a1 - Aend)};
            if (lane == 0) { Vs[0] = __expf(m_prev - Aend); Vs[1] = bend + Aend; Vs[2] = bend; }
        }
        const int knext = k + 1 < nch ? k + 1 : k;
        if constexpr (!OUT) { ML_LOAD(knext); }
        __syncthreads();
        const float decay = __builtin_bit_cast(float, __builtin_amdgcn_readfirstlane(__builtin_bit_cast(int, Vs[0]))), m_new = __builtin_bit_cast(float, __builtin_amdgcn_readfirstlane(__builtin_bit_cast(int, Vs[1])));
        if constexpr (!OUT) bsum += Vs[2];
        if constexpr (OUT) {
            const int t = 32 * tb + ln;
            const LAS unsigned char* qrow = QS + t * M2_RS + 16 * h;
            f32x16 acc[2];
#pragma unroll
            for (int i = 0; i < 2; ++i)
#pragma unroll
                for (int r = 0; r < 16; ++r) acc[i][r] = 0.f;
            const float it = Vin[t], At = VA[t];
            float qn = 0.f;
            {
                const LAS unsigned char* c0p = CT + (32 * (2 * vh) + ln) * M2_RS + 16 * h; const LAS unsigned char* c1p = c0p + 32 * M2_RS; const LAS float* np = Vn + 8 * h;
                bf16x8 qc = *(const LAS bf16x8*)(qrow), c0 = *(const LAS bf16x8*)(c0p), c1 = *(const LAS bf16x8*)(c1p);
#pragma unroll
                for (int ks = 0; ks < 8; ++ks) {
                    bf16x8 qx = qc, x0 = c0, x1 = c1;
                    const f32x4 n0 = *(const LAS f32x4*)(np + 16 * ks), n1 = *(const LAS f32x4*)(np + 16 * ks + 4);
                    if (ks < 7) { qx = *(const LAS bf16x8*)(qrow + 32 * (ks + 1)); x0 = *(const LAS bf16x8*)(c0p + 32 * (ks + 1)); x1 = *(const LAS bf16x8*)(c1p + 32 * (ks + 1)); }
                    __builtin_amdgcn_sched_barrier(0);
                    acc[0] = __builtin_amdgcn_mfma_f32_32x32x16_bf16(c0, qc, acc[0], 0, 0, 0);
                    acc[1] = __builtin_amdgcn_mfma_f32_32x32x16_bf16(c1, qc, acc[1], 0, 0, 0);
                    const u32x4 qu = __builtin_bit_cast(u32x4, qc);
                    qn += bf_lo(qu.x) * n0.x + bf_hi(qu.x) * n0.y + bf_lo(qu.y) * n0.z + bf_hi(qu.y) * n0.w + bf_lo(qu.z) * n1.x + bf_hi(qu.z) * n1.y + bf_lo(qu.w) * n1.z + bf_hi(qu.w) * n1.w;
                    __builtin_amdgcn_sched_barrier(0);
                    qc = qx; c0 = x0; c1 = x1;
                }
            }
#pragma unroll
            for (int i = 0; i < 2; ++i) acc[i] = acc[i] * it;
            float denp = 0.f;
#pragma unroll
            for (int sb = 0; sb < 4; ++sb) {
                if (sb <= tb) {
                    f32x16 sa;
#pragma unroll
                    for (int r = 0; r < 16; ++r) sa[r] = 0.f;
                    {
                        const LAS unsigned char* kp = KS + (32 * sb + ln) * M2_RS + 16 * h;
                        bf16x8 kc = *(const LAS bf16x8*)(kp), qc = *(const LAS bf16x8*)(qrow);
#pragma unroll
                        for (int ks = 0; ks < 8; ++ks) {
                            bf16x8 kx = kc, qx = qc;
                            if (ks < 7) { kx = *(const LAS bf16x8*)(kp + 32 * (ks + 1)); qx = *(const LAS bf16x8*)(qrow + 32 * (ks + 1)); }
                            __builtin_amdgcn_sched_barrier(0);
                            sa = __builtin_amdgcn_mfma_f32_32x32x16_bf16(kc, qc, sa, 0, 0, 0);
                            __builtin_amdgcn_sched_barrier(0);
                            kc = kx; qc = qx;
                        }
                    }
                    const LAS unsigned char* vr = VS + (32 * sb) * M2_VR + trp + 64 * (2 * vh);
                    const bf16x4 va00 = tr_read(vr), va01 = tr_read(vr + 8 * M2_VR), va10 = tr_read(vr + 64), va11 = tr_read(vr + 8 * M2_VR + 64);
                    u32x4 pw[2];
#pragma unroll
                    for (int qd = 0; qd < 4; ++qd) { const f32x4 av = *(const LAS f32x4*)(Va + 32 * sb + 8 * qd + 4 * h); float p[4];
#pragma unroll
                        for (int e = 0; e < 4; ++e) { const int s_ = 32 * sb + 8 * qd + 4 * h + e; p[e] = (s_ <= t) ? sa[4 * qd + e] * __expf(av[e] - At) : 0.f; denp += p[e]; }
                        pw[qd >> 1][2 * (qd & 1)] = cvt_pk_bf16(p[0], p[1]); pw[qd >> 1][2 * (qd & 1) + 1] = cvt_pk_bf16(p[2], p[3]); }
                    { const bf16x8 pf0 = as_bf16x8(pw[0]), pf1 = as_bf16x8(pw[1]);
                      const bf16x4 vb00 = tr_read(vr + 16 * M2_VR), vb01 = tr_read(vr + 24 * M2_VR), vb10 = tr_read(vr + 16 * M2_VR + 64), vb11 = tr_read(vr + 24 * M2_VR + 64);
                      __builtin_amdgcn_sched_barrier(0);
                      acc[0] = __builtin_amdgcn_mfma_f32_32x32x16_bf16(cat4(va00, va01), pf0, acc[0], 0, 0, 0);
                      acc[1] = __builtin_amdgcn_mfma_f32_32x32x16_bf16(cat4(va10, va11), pf0, acc[1], 0, 0, 0);
                      acc[0] = __builtin_amdgcn_mfma_f32_32x32x16_bf16(cat4(vb00, vb01), pf1, acc[0], 0, 0, 0);
                      acc[1] = __builtin_amdgcn_mfma_f32_32x32x16_bf16(cat4(vb10, vb11), pf1, acc[1], 0, 0, 0); }
                }
            }
            denp += __shfl_xor(denp, 32); qn += __shfl_xor(qn, 32);
            const float den = denp + it * qn;
            const float rd = 1.f / fmaxf(fabsf(den), Vem[t]);
            const size_t orow = rowbase + ML_TOK(sig0 + k * 128 + t);
            if (!FINAL) {
#pragma unroll
                for (int i = 0; i < 2; ++i) { bf16* hp = HB + orow * 512 + head * 128 + 32 * (2 * vh + i) + 4 * h;
#pragma unroll
                    for (int qd = 0; qd < 4; ++qd) *(u32x2*)(hp + 8 * qd) = (u32x2){cvt_pk_bf16(acc[i][4 * qd] * rd, acc[i][4 * qd + 1] * rd), cvt_pk_bf16(acc[i][4 * qd + 2] * rd, acc[i][4 * qd + 3] * rd)}; }
            } else {
                float ss = 0.f;
#pragma unroll
                for (int i = 0; i < 2; ++i) { const bf16* hp = HB + orow * 512 + head * 128 + 32 * (2 * vh + i) + 4 * h;
#pragma unroll
                    for (int qd = 0; qd < 4; ++qd) { const u32x2 hf = *(const u32x2*)(hp + 8 * qd);
                        acc[i][4 * qd] = acc[i][4 * qd] * rd + bf_lo(hf.x); acc[i][4 * qd + 1] = acc[i][4 * qd + 1] * rd + bf_hi(hf.x); acc[i][4 * qd + 2] = acc[i][4 * qd + 2] * rd + bf_lo(hf.y); acc[i][4 * qd + 3] = acc[i][4 * qd + 3] * rd + bf_hi(hf.y);
                        ss += (acc[i][4 * qd] * acc[i][4 * qd] + acc[i][4 * qd + 1] * acc[i][4 * qd + 1]) + (acc[i][4 * qd + 2] * acc[i][4 * qd + 2] + acc[i][4 * qd + 3] * acc[i][4 * qd + 3]); }
                    asm volatile("" ::: "memory"); }
                ss += __shfl_xor(ss, 32);
                if (h == 0) Vx[vh * 128 + t] = ss;
                __syncthreads();
                const float rs = 1.f / sqrtf((ss + Vx[(1 - vh) * 128 + t]) * (1.f / 128.f) + LN_EPS);
#pragma unroll
                for (int i = 0; i < 2; ++i) { const int c0 = head * 128 + 32 * (2 * vh + i) + 4 * h;
                    const bf16* zo = (const bf16*)(F.ws + WS_ZO) + orow * 512 + c0; const float* gn = a.in[11] + c0; bf16* mp = (bf16*)(F.ws + WS_MIX) + orow * 1024 + 512 + c0;
#pragma unroll
                    for (int qd = 0; qd < 4; ++qd) { const u32x2 zz = *(const u32x2*)(zo + 8 * qd); const f32x4 gg = *(const f32x4*)(gn + 8 * qd);
                        const float o0 = acc[i][4 * qd] * rs * gg[0] / (1.f + __expf(-bf_lo(zz.x))), o1 = acc[i][4 * qd + 1] * rs * gg[1] / (1.f + __expf(-bf_hi(zz.x)));
                        const float o2 = acc[i][4 * qd + 2] * rs * gg[2] / (1.f + __expf(-bf_lo(zz.y))), o3 = acc[i][4 * qd + 3] * rs * gg[3] / (1.f + __expf(-bf_hi(zz.y)));
                        *(u32x2*)(mp + 8 * qd) = (u32x2){cvt_pk_bf16(o0, o1), cvt_pk_bf16(o2, o3)};
                        if (qd & 1) asm volatile("" ::: "memory"); } }
            }
        }
        if constexpr (OUT) { ML_LOAD(knext); }
#pragma unroll
        for (int i = 0; i < 2; ++i) Cacc[i] = Cacc[i] * decay;
        float npart = 0.f;
        {
            const LAS unsigned char* kr = KS + trk + 64 * db; const LAS unsigned char* vr = VS + trn + 64 * (2 * vh); const LAS float* wp = Vw + 8 * h;
            bf16x4 k0 = tr_read(kr), k1 = tr_read(kr + 4 * M2_RS), v00 = tr_read(vr), v01 = tr_read(vr + 4 * M2_VR), v10 = tr_read(vr + 64), v11 = tr_read(vr + 4 * M2_VR + 64);
            f32x4 w0 = *(const LAS f32x4*)(wp), w1 = *(const LAS f32x4*)(wp + 4);
#pragma unroll
            for (int ks = 0; ks < 8; ++ks) {
                bf16x4 k0x = k0, k1x = k1, v00x = v00, v01x = v01, v10x = v10, v11x = v11; f32x4 w0x = w0, w1x = w1;
                if (ks < 7) { const LAS unsigned char* kn = kr + 16 * (ks + 1) * M2_RS; const LAS unsigned char* vn = vr + 16 * (ks + 1) * M2_VR;
                    k0x = tr_read(kn); k1x = tr_read(kn + 4 * M2_RS); v00x = tr_read(vn); v01x = tr_read(vn + 4 * M2_VR); v10x = tr_read(vn + 64); v11x = tr_read(vn + 4 * M2_VR + 64);
                    w0x = *(const LAS f32x4*)(wp + 16 * (ks + 1)); w1x = *(const LAS f32x4*)(wp + 16 * (ks + 1) + 4); }
                __builtin_amdgcn_sched_barrier(0);
                const u32x2 ku0 = __builtin_bit_cast(u32x2, k0), ku1 = __builtin_bit_cast(u32x2, k1);
                const float x0 = bf_lo(ku0.x) * w0[0], x1 = bf_hi(ku0.x) * w0[1], x2 = bf_lo(ku0.y) * w0[2], x3 = bf_hi(ku0.y) * w0[3];
                const float x4 = bf_lo(ku1.x) * w1[0], x5 = bf_hi(ku1.x) * w1[1], x6 = bf_lo(ku1.y) * w1[2], x7 = bf_hi(ku1.y) * w1[3];
                npart += ((x0 + x1) + (x2 + x3)) + ((x4 + x5) + (x6 + x7));
                const bf16x8 kf = as_bf16x8((u32x4){cvt_pk_bf16(x0, x1), cvt_pk_bf16(x2, x3), cvt_pk_bf16(x4, x5), cvt_pk_bf16(x6, x7)});
                Cacc[0] = __builtin_amdgcn_mfma_f32_32x32x16_bf16(kf, cat4(v00, v01), Cacc[0], 0, 0, 0);
                Cacc[1] = __builtin_amdgcn_mfma_f32_32x32x16_bf16(kf, cat4(v10, v11), Cacc[1], 0, 0, 0);
                __builtin_amdgcn_sched_barrier(0);
                k0 = k0x; k1 = k1x; v00 = v00x; v01 = v01x; v10 = v10x; v11 = v11x; w0 = w0x; w1 = w1x;
            }
        }
        npart += __shfl_xor(npart, 32);
        nreg = nreg * decay + npart;
        m_prev = m_new;
        __syncthreads();
        if constexpr (OUT) {
#pragma unroll
            for (int i = 0; i < 2; ++i)
#pragma unroll
                for (int qd = 0; qd < 4; ++qd) *(LAS u32x2*)(CT + (32 * (2 * vh + i) + ln) * M2_RS + (32 * db + 8 * qd + 4 * h) * 2) = (u32x2){cvt_pk_bf16(Cacc[i][4 * qd], Cacc[i][4 * qd + 1]), cvt_pk_bf16(Cacc[i][4 * qd + 2], Cacc[i][4 * qd + 3])};
            if (nown) Vn[32 * db + ln] = nreg;
        }
    }
#undef ML_LOAD
#undef ML_TOK
    if (OUT && !FINAL) { VM_WAIT(); __syncthreads(); }
    if constexpr (!OUT) {
        float* R = REC + (size_t)(grp < 0 ? 0 : 1 + grp) * REC_FLOATS;
#pragma unroll
        for (int i = 0; i < 2; ++i)
#pragma unroll
            for (int qd = 0; qd < 4; ++qd) *(f32x4*)(R + (32 * (2 * vh + i) + ln) * 128 + 32 * db + 8 * qd + 4 * h) = (f32x4){Cacc[i][4 * qd], Cacc[i][4 * qd + 1], Cacc[i][4 * qd + 2], Cacc[i][4 * qd + 3]};
        if (nown) R[REC_N + 32 * db + ln] = nreg;
        if (tid == 0) { R[REC_S] = m_prev; R[REC_S + 1] = bsum; }
    }
}

__device__ __forceinline__ void p6_readout(Frame& F, const Args& a) {
    const int gw = F.vcu * 8 + F.wave, NGW = F.G * 8, lane = cur_lane();
    const bf16* HB0 = (const bf16*)(F.ws + WS_HB); const bf16* HB1 = HB0 + (size_t)ML_ROWS * 512; const bf16* ZO = (const bf16*)(F.ws + WS_ZO);
    bf16* MIX = (bf16*)(F.ws + WS_MIX);
    const f32x4 g0 = *(const f32x4*)(a.in[11] + 8 * lane), g1 = *(const f32x4*)(a.in[11] + 8 * lane + 4);
    for (int m = gw; m < ML_ROWS; m += NGW) {
        const u32x4 hf = *(const u32x4*)(HB0 + (size_t)m * 512 + 8 * lane), hb = *(const u32x4*)(HB1 + (size_t)m * 512 + 8 * lane), zo = *(const u32x4*)(ZO + (size_t)m * 512 + 8 * lane);
        float h[8]; float ss = 0.f;
#pragma unroll
        for (int q = 0; q < 4; ++q) { h[2 * q] = bf_lo(hf[q]) + bf_lo(hb[q]); h[2 * q + 1] = bf_hi(hf[q]) + bf_hi(hb[q]); ss += h[2 * q] * h[2 * q] + h[2 * q + 1] * h[2 * q + 1]; }
        ss += __shfl_xor(ss, 1); ss += __shfl_xor(ss, 2); ss += __shfl_xor(ss, 4); ss += __shfl_xor(ss, 8);
        const float rs = 1.f / sqrtf(ss * (1.f / 128.f) + LN_EPS);
        float o[8];
#pragma unroll
        for (int q = 0; q < 4; ++q) { const float z0 = bf_lo(zo[q]), z1 = bf_hi(zo[q]);
            o[2 * q] = h[2 * q] * rs * (q < 2 ? g0[2 * q] : g1[2 * q - 4]) / (1.f + __expf(-z0));
            o[2 * q + 1] = h[2 * q + 1] * rs * (q < 2 ? g0[2 * q + 1] : g1[2 * q - 3]) / (1.f + __expf(-z1)); }
        *(u32x4*)(MIX + (size_t)m * 1024 + 512 + 8 * lane) = (u32x4){cvt_pk_bf16(o[0], o[1]), cvt_pk_bf16(o[2], o[3]), cvt_pk_bf16(o[4], o[5]), cvt_pk_bf16(o[6], o[7])};
    }
}

struct EpiY1 {
    static constexpr bool PERM = true;
    const float* x; const float* ada; bf16* y1;
    __device__ __forceinline__ void operator()(const f32x4 (&acc)[2][2][4][2], const pg8::Unit& u, int wr, int wc, int fr, int fq) const {
        const int row0 = u.pm * 256 + wr * 64 + fr, col0 = u.pn * 256 + wc * 32 + 8 * fq;
        const float* g1 = ada + (size_t)(u.pm >> 5) * 6144 + 2048;
        f32x4 gv[2][2];
#pragma unroll
        for (int bj = 0; bj < 2; ++bj)
#pragma unroll
            for (int n = 0; n < 2; ++n) gv[bj][n] = *(const f32x4*)(g1 + col0 + bj * 128 + 4 * n);
#pragma unroll
        for (int ai = 0; ai < 2; ++ai)
#pragma unroll
            for (int m = 0; m < 4; ++m) { const size_t off = (size_t)(row0 + ai * 128 + m * 16) * 1024 + col0;
#pragma unroll
                for (int bj = 0; bj < 2; ++bj) { const f32x4 x0 = *(const f32x4*)(x + off + bj * 128), x1 = *(const f32x4*)(x + off + bj * 128 + 4);
                    const f32x4 v0 = x0 * DN_ALPHA + gv[bj][0] * acc[ai][bj][m][0], v1 = x1 * DN_ALPHA + gv[bj][1] * acc[ai][bj][m][1];
                    *(u32x4*)(y1 + off + bj * 128) = (u32x4){cvt_pk_bf16(v0[0], v0[1]), cvt_pk_bf16(v0[2], v0[3]), cvt_pk_bf16(v1[0], v1[1]), cvt_pk_bf16(v1[2], v1[3])}; } }
    }
};

constexpr int P8_LG = 0;
constexpr int P8_REC = 81920;
__device__ __forceinline__ void p8_mid(Frame& F, const Args& a) {
    const int gw = F.vcu * 8 + F.wave, NGW = F.G * 8, lane = opaque(cur_lane()), tid = FTID(F), g = lane >> 4, lq = lane & 15;
    bf16* Y1 = (bf16*)(F.ws + WS_Y1); bf16* XM2 = (bf16*)(F.ws + WS_XM2);
    const float* ada = (const float*)(F.ws + WS_ADA); const bf16* WR = (const bf16*)(F.ws + WS_WR);
    LAS float* lg = (LAS float*)(F.lds + P8_LG) + F.wave * 2560;
    LAS unsigned* rec = (LAS unsigned*)(F.lds + P8_REC);
    LAS int* hist = (LAS int*)(F.lds + MISC_OFF + MS_HIST); LAS int* base = (LAS int*)(F.lds + MISC_OFF + MS_BASE);
    if (tid < 64) hist[tid] = 0;
    __syncthreads();
    const f32x4 l1g[4] = {((const f32x4*)a.in[13])[lane], ((const f32x4*)a.in[13])[lane + 64], ((const f32x4*)a.in[13])[lane + 128], ((const f32x4*)a.in[13])[lane + 192]};
    const f32x4 l1b[4] = {((const f32x4*)a.in[14])[lane], ((const f32x4*)a.in[14])[lane + 64], ((const f32x4*)a.in[14])[lane + 128], ((const f32x4*)a.in[14])[lane + 192]};
    const int NT16 = ML_ROWS / 16;
    int nloc = 0;
    for (int wt = gw; wt < NT16; wt += 2 * NGW, nloc += 2) {
        const bool two = wt + NGW < NT16;
        const int rowA = wt * 16, rowB = two ? (wt + NGW) * 16 : rowA;
        for (int rr = 0; rr < (two ? 32 : 16); rr += 4) {
            const int rowbase = (rr < 16 ? rowA : rowB) + (rr & 15);
            const float* sh2 = ada + (size_t)(rowbase >> 13) * 6144 + 3072; const float* sc2 = sh2 + 1024;
            f32x4 v[4][4]; float sm[4];
#pragma unroll
            for (int r = 0; r < 4; ++r) { const u32x2* yr = (const u32x2*)(Y1 + (size_t)(rowbase + r) * 1024) + lane;
#pragma unroll
                for (int j = 0; j < 4; ++j) { const u32x2 pk = yr[64 * j]; v[r][j] = (f32x4){bf_lo(pk.x), bf_hi(pk.x), bf_lo(pk.y), bf_hi(pk.y)}; } }
#pragma unroll
            for (int r = 0; r < 4; ++r) { sm[r] = 0.f;
#pragma unroll
                for (int j = 0; j < 4; ++j) sm[r] += (v[r][j].x + v[r][j].y) + (v[r][j].z + v[r][j].w); }
            wave_sum4(sm);
#pragma unroll
            for (int r = 0; r < 4; ++r) { const float mean = sm[r] * (1.f / DM); sm[r] = 0.f;
#pragma unroll
                for (int j = 0; j < 4; ++j) { v[r][j] = v[r][j] - mean; sm[r] += (v[r][j].x * v[r][j].x + v[r][j].y * v[r][j].y) + (v[r][j].z * v[r][j].z + v[r][j].w * v[r][j].w); } }
            wave_sum4(sm);
#pragma unroll
            for (int r = 0; r < 4; ++r) { const float rstd = 1.f / sqrtf(sm[r] * (1.f / DM) + LN_EPS); sm[r] = 0.f;
                u32x2* yr = (u32x2*)(Y1 + (size_t)(rowbase + r) * 1024) + lane;
#pragma unroll
                for (int j = 0; j < 4; ++j) { v[r][j] = (v[r][j] * rstd) * l1g[j] + l1b[j]; yr[64 * j] = (u32x2){cvt_pk_bf16(v[r][j].x, v[r][j].y), cvt_pk_bf16(v[r][j].z, v[r][j].w)};
                    sm[r] += (v[r][j].x + v[r][j].y) + (v[r][j].z + v[r][j].w); } }
            wave_sum4(sm);
#pragma unroll
            for (int r = 0; r < 4; ++r) { const float mean = sm[r] * (1.f / DM); sm[r] = 0.f;
#pragma unroll
                for (int j = 0; j < 4; ++j) { v[r][j] = v[r][j] - mean; sm[r] += (v[r][j].x * v[r][j].x + v[r][j].y * v[r][j].y) + (v[r][j].z * v[r][j].z + v[r][j].w * v[r][j].w); } }
            wave_sum4(sm);
#pragma unroll
            for (int r = 0; r < 4; ++r) { const float rstd = 1.f / sqrtf(sm[r] * (1.f / DM) + LN_EPS);
                u32x2* o8 = (u32x2*)(XM2 + (size_t)(rowbase + r) * 1024) + lane;
#pragma unroll
                for (int j = 0; j < 4; ++j) { const f32x4 h = ((const f32x4*)sh2)[lane + 64 * j], c = ((const f32x4*)sc2)[lane + 64 * j]; const f32x4 y = (v[r][j] * rstd) * (c + 1.f) + h;
                    o8[64 * j] = (u32x2){cvt_pk_bf16(y.x, y.y), cvt_pk_bf16(y.z, y.w)}; } }
        }
        VM_WAIT();
        AMP_SPIN(80);
        f32x4 la[2][5];
#pragma unroll
        for (int t2 = 0; t2 < 2; ++t2)
#pragma unroll
            for (int nt = 0; nt < 5; ++nt) la[t2][nt] = (f32x4){0.f, 0.f, 0.f, 0.f};
        const bf16* xpA = XM2 + (size_t)(rowA + lq) * 1024 + 8 * g; const bf16* xpB = XM2 + (size_t)(rowB + lq) * 1024 + 8 * g;
        const bf16* wp = WR + (size_t)lq * 1024 + 8 * g;
#pragma unroll 4
        for (int kk = 0; kk < 32; ++kk) {
            const bf16x8 xfA = __builtin_nontemporal_load((const bf16x8*)(xpA + 32 * kk)), xfB = __builtin_nontemporal_load((const bf16x8*)(xpB + 32 * kk));
#pragma unroll
            for (int nt = 0; nt < 5; ++nt) { const bf16x8 wf = *(const bf16x8*)(wp + (size_t)nt * 16 * 1024 + 32 * kk);
                la[0][nt] = __builtin_amdgcn_mfma_f32_16x16x32_bf16(wf, xfA, la[0][nt], 0, 0, 0);
                la[1][nt] = __builtin_amdgcn_mfma_f32_16x16x32_bf16(wf, xfB, la[1][nt], 0, 0, 0); }
        }
#pragma unroll
        for (int t2 = 0; t2 < 2; ++t2)
#pragma unroll
            for (int nt = 0; nt < 5; ++nt) *(LAS f32x4*)(lg + (16 * t2 + lq) * 80 + 16 * nt + 4 * g) = la[t2][nt];
        LDS_WAIT();
        if (lane < 16 || (lane < 32 && two)) {
            const LAS float* L = lg + lane * 80;
            float gl[8]; float gm = -1e30f; int gi = 0;
#pragma unroll
            for (int i = 0; i < 8; ++i) { gl[i] = L[i] + a.in[16][i]; if (gl[i] > gm) { gm = gl[i]; gi = i; } }
            float gs = 0.f;
#pragma unroll
            for (int i = 0; i < 8; ++i) gs += __expf(gl[i] - gm);
            const float pg = 1.f / gs;
            float v1 = -1e30f, v2 = -1e30f; int i1 = 0, i2 = 0;
#pragma unroll
            for (int i = 0; i < 8; ++i) { const float e = L[16 + gi * 8 + i] + a.in[18][gi * 8 + i];
                if (e > v1) { v2 = v1; i2 = i1; v1 = e; i1 = i; } else if (e > v2) { v2 = e; i2 = i; } }
            const float ex = __expf(v2 - v1), wA = pg / (1.f + ex), wB = pg * ex / (1.f + ex);
            const int eA = gi * 8 + i1, eB = gi * 8 + i2;
            const int pA = __hip_atomic_fetch_add(&hist[eA], 1, __ATOMIC_RELAXED, __HIP_MEMORY_SCOPE_WORKGROUP), pB = __hip_atomic_fetch_add(&hist[eB], 1, __ATOMIC_RELAXED, __HIP_MEMORY_SCOPE_WORKGROUP);
            LAS unsigned* rc = rec + (((nloc + (lane >> 4)) * 8 + F.wave) * 16 + (lane & 15)) * 8;
            rc[0] = (unsigned)eA; rc[1] = (unsigned)pA; rc[2] = (unsigned)eB; rc[3] = (unsigned)pB; rc[4] = __float_as_uint(wA); rc[5] = __float_as_uint(wB); rc[6] = (unsigned)((lane < 16 ? rowA : rowB) + (lane & 15));
        }
        AMP_SPIN(81);
    }
    __syncthreads();
    if (tid < 64) base[tid] = (int)__hip_atomic_fetch_add(F.ctl + CW_CNT + 16 * tid, (unsigned)hist[tid], RLX_AGENT);
    __syncthreads();
    {
        int* TOKL = (int*)(F.ws + WS_TOKL); u32x4* ROUTE = (u32x4*)(F.ws + WS_ROUTE);
        const int ntile_max = (ML_ROWS / 16 + NGW - 1) / NGW;
        for (int i = tid; i < ntile_max * 128; i += 512) {
            const int nl = i >> 7, wv = (i >> 4) & 7;
            if ((long)(F.vcu * 8 + wv) + (long)nl * NGW >= ML_ROWS / 16) continue;
            const LAS unsigned* rc = rec + i * 8;
            const int eA = (int)rc[0], pA = (int)rc[1] + base[rc[0]], eB = (int)rc[2], pB = (int)rc[3] + base[rc[2]], tok = (int)rc[6];
            TOKL[(size_t)eA * 65536 + pA] = tok; TOKL[(size_t)eB * 65536 + pB] = tok;
            ROUTE[tok] = (u32x4){((unsigned)eA << 20) | (unsigned)pA, ((unsigned)eB << 20) | (unsigned)pB, rc[4], rc[5]};
        }
    }
}

__device__ __forceinline__ void moe_tables(Frame& F) {
    LAS int* cnt = (LAS int*)(F.lds + MISC_OFF + MS_CNT); LAS int* start = (LAS int*)(F.lds + MISC_OFF + MS_START); LAS int* tstart = (LAS int*)(F.lds + MISC_OFF + MS_TSTART);
    __syncthreads();
    if (FTID(F) < 64) cnt[FTID(F)] = (int)__hip_atomic_load(F.ctl + CW_CNT + 16 * FTID(F), RLX_AGENT);
    __syncthreads();
    if (FTID(F) == 0) { int s = 0, t = 0; for (int e = 0; e < 64; ++e) { start[e] = s; tstart[e] = t; s += cnt[e]; t += (cnt[e] + 255) >> 8; } start[64] = s; tstart[64] = t; }
    __syncthreads();
}
struct MoeOrder {
    const LAS int* cnt; const LAS int* start; const LAS int* tstart; int G, c;
    __device__ __forceinline__ bool next(int i, pg8::Unit& u) const {
        const int tile = i * (G >> 2) + (c & 7) + 8 * (c >> 5), pnn = (c >> 3) & 3;
        if (tile >= tstart[64]) return false;
        int e = 0;
        for (int s = 32; s >= 1; s >>= 1) if (tstart[e + s] <= tile) e += s;
        while (cnt[e] == 0) --e;
        u.e = e; u.pm = tile - tstart[e]; u.pn = pnn; const int rem = cnt[e] - u.pm * 256; u.cnt = rem < 256 ? rem : 256; return true;
    }
};
struct MoeSched1 {
    static constexpr bool GATHER = true;
    MoeOrder ord; const char* XM2; const char* W13; const int* TOKL;
    __device__ __forceinline__ bool next(int i, pg8::Unit& u) const { return ord.next(i, u); }
    __device__ __forceinline__ const char* a_ptr(const pg8::Unit&) const { return XM2; }
    __device__ __forceinline__ const char* b_ptr(const pg8::Unit& u) const { return W13 + ((size_t)u.e * 1024 + (size_t)u.pn * 256) * 2048; }
    __device__ __forceinline__ void a_voff(const pg8::Unit& u, unsigned (&v)[2][2], int tid) const {
        int R0, R1, C0, C1; pg8::stage_rc(tid * 16, R0, C0); pg8::stage_rc(tid * 16 + 8192, R1, C1);
        const int* tl = TOKL + (size_t)u.e * 65536 + u.pm * 256;
#pragma unroll
        for (int h = 0; h < 2; ++h) { const int r0 = h * 128 + R0, r1 = h * 128 + R1;
            const int t0 = r0 < u.cnt ? tl[r0] : 0, t1 = r1 < u.cnt ? tl[r1] : 0;
            v[h][0] = (unsigned)t0 * 2048u + (unsigned)C0 * 2u; v[h][1] = (unsigned)t1 * 2048u + (unsigned)C1 * 2u; }
    }
};
struct MoeSched2 {
    static constexpr bool GATHER = false;
    MoeOrder ord; const char* H; const char* W2;
    __device__ __forceinline__ bool next(int i, pg8::Unit& u) const { return ord.next(i, u); }
    __device__ __forceinline__ const char* a_ptr(const pg8::Unit& u) const { return H + (size_t)(ord.start[u.e] + u.pm * 256) * 1024; }
    __device__ __forceinline__ const char* b_ptr(const pg8::Unit& u) const { return W2 + ((size_t)u.e * 1024 + (size_t)u.pn * 256) * 1024; }
    __device__ __forceinline__ void a_voff(const pg8::Unit&, unsigned (&)[2][2], int) const {}
};
struct EpiH {
    static constexpr bool PERM = true;
    bf16* H; const LAS int* start;
    __device__ __forceinline__ void operator()(const f32x4 (&acc)[2][2][4][2], const pg8::Unit& u, int wr, int wc, int fr, int fq) const {
        const int r0 = wr * 64 + fr; const size_t slot0 = (size_t)start[u.e] + u.pm * 256;
        const int col0 = u.pn * 128 + wc * 32 + 8 * fq;
#pragma unroll
        for (int ai = 0; ai < 2; ++ai)
#pragma unroll
            for (int m = 0; m < 4; ++m) { const int r = r0 + ai * 128 + m * 16;
                if (r < u.cnt) { float o[8];
#pragma unroll
                    for (int n = 0; n < 2; ++n)
#pragma unroll
                        for (int j = 0; j < 4; ++j) { const float h1 = acc[ai][0][m][n][j], h3 = acc[ai][1][m][n][j]; o[4 * n + j] = h1 / (1.f + __expf(-h1)) * h3; }
                    *(u32x4*)(H + (slot0 + r) * 512 + col0) = (u32x4){cvt_pk_bf16(o[0], o[1]), cvt_pk_bf16(o[2], o[3]), cvt_pk_bf16(o[4], o[5]), cvt_pk_bf16(o[6], o[7])}; } }
    }
};
struct EpiY {
    static constexpr bool PERM = true;
    bf16* Y; const LAS int* start;
    __device__ __forceinline__ void operator()(const f32x4 (&acc)[2][2][4][2], const pg8::Unit& u, int wr, int wc, int fr, int fq) const {
        const int r0 = wr * 64 + fr; const size_t slot0 = (size_t)start[u.e] + u.pm * 256;
        const int col0 = u.pn * 256 + wc * 32 + 8 * fq;
#pragma unroll
        for (int ai = 0; ai < 2; ++ai)
#pragma unroll
            for (int m = 0; m < 4; ++m) { const int r = r0 + ai * 128 + m * 16;
                if (r < u.cnt) {
#pragma unroll
                    for (int bj = 0; bj < 2; ++bj) { const f32x4 v0 = acc[ai][bj][m][0], v1 = acc[ai][bj][m][1];
                        *(u32x4*)(Y + (slot0 + r) * 1024 + col0 + bj * 128) = (u32x4){cvt_pk_bf16(v0[0], v0[1]), cvt_pk_bf16(v0[2], v0[3]), cvt_pk_bf16(v1[0], v1[1]), cvt_pk_bf16(v1[2], v1[3])}; } } }
    }
};

__device__ __forceinline__ void p11_final(Frame& F, const Args& a) {
    const int gw = F.vcu * 8 + F.wave, NGW = F.G * 8, lane = opaque(cur_lane());
    const bf16* XMID = (const bf16*)(F.ws + WS_Y1); const bf16* Y = (const bf16*)(F.ws + WS_YMOE); const u32x4* ROUTE = (const u32x4*)(F.ws + WS_ROUTE);
    const float* ada = (const float*)(F.ws + WS_ADA);
    const LAS int* start = (const LAS int*)(F.lds + MISC_OFF + MS_START);
    for (int m0 = gw; m0 < ML_ROWS; m0 += 4 * NGW) {
        f32x4 v[4][4]; float sm[4]; bool ok[4]; int mm[4];
        u32x4 rt[4];
#pragma unroll
        for (int r = 0; r < 4; ++r) { const int m = m0 + r * NGW; ok[r] = m < ML_ROWS; mm[r] = ok[r] ? m : m0; rt[r] = ROUTE[mm[r]]; }
#pragma unroll
        for (int r = 0; r < 4; ++r) {
            const size_t sA = (size_t)start[rt[r].x >> 20] + (rt[r].x & 0xfffffu), sB = (size_t)start[rt[r].y >> 20] + (rt[r].y & 0xfffffu);
            const float wA = __uint_as_float(rt[r].z), wB = __uint_as_float(rt[r].w);
            const u32x2* xr = (const u32x2*)(XMID + (size_t)mm[r] * 1024) + lane; const u32x2* ya = (const u32x2*)(Y + sA * 1024) + lane; const u32x2* yb = (const u32x2*)(Y + sB * 1024) + lane;
            const f32x4* g2 = (const f32x4*)(ada + (size_t)(mm[r] >> 13) * 6144 + 5120) + lane;
            sm[r] = 0.f;
#pragma unroll
            for (int j = 0; j < 4; ++j) { const u32x2 xp = xr[64 * j], pa = ya[64 * j], pb = yb[64 * j]; const f32x4 gg = g2[64 * j];
                const f32x4 xv = (f32x4){bf_lo(xp.x), bf_hi(xp.x), bf_lo(xp.y), bf_hi(xp.y)};
                f32x4 mo; mo.x = wA * bf_lo(pa.x) + wB * bf_lo(pb.x); mo.y = wA * bf_hi(pa.x) + wB * bf_hi(pb.x); mo.z = wA * bf_lo(pa.y) + wB * bf_lo(pb.y); mo.w = wA * bf_hi(pa.y) + wB * bf_hi(pb.y);
                v[r][j] = xv * DN_ALPHA + gg * mo; sm[r] += (v[r][j].x + v[r][j].y) + (v[r][j].z + v[r][j].w); }
        }
        wave_sum4(sm);
#pragma unroll
        for (int r = 0; r < 4; ++r) { const float mean = sm[r] * (1.f / DM); sm[r] = 0.f;
#pragma unroll
            for (int j = 0; j < 4; ++j) { v[r][j] = v[r][j] - mean; sm[r] += (v[r][j].x * v[r][j].x + v[r][j].y * v[r][j].y) + (v[r][j].z * v[r][j].z + v[r][j].w * v[r][j].w); } }
        wave_sum4(sm);
#pragma unroll
        for (int r = 0; r < 4; ++r) { const float rstd = 1.f / sqrtf(sm[r] * (1.f / DM) + LN_EPS);
            f32x4* o = (f32x4*)(a.out + (size_t)mm[r] * 1024) + lane;
            if (ok[r]) {
#pragma unroll
                for (int j = 0; j < 4; ++j) { const f32x4 gg = ((const f32x4*)a.in[22])[lane + 64 * j], bb = ((const f32x4*)a.in[23])[lane + 64 * j]; o[64 * j] = (v[r][j] * rstd) * gg + bb; } }
        }
    }
}

__global__ void __launch_bounds__(512, 2) mk_fwd(Args args) {
    extern __shared__ __attribute__((aligned(16))) unsigned char lds_raw[];
    Frame F;
    F.lds = (LAS unsigned char*)lds_raw; F.ws = args.ws; F.ctl = (unsigned*)(args.ws + WS_CTL);
    F.wave = __builtin_amdgcn_readfirstlane((int)threadIdx.x >> 6);
    F.G = gridDim.x; { const int bx = blockIdx.x; F.vcu = (F.G % 8 == 0) ? (bx % 8) * (F.G / 8) + bx / 8 : bx; }
    for (int u = FTID(F); u < (LDS_BYTES - MISC_OFF) / 4; u += 512) ((LAS unsigned*)(F.lds + MISC_OFF))[u] = 0u;
    __syncthreads();
    XcdBarrier bar; bar.bar = F.ctl + CW_BAR; bar.x = 0; bar.st = nullptr;
    if (MK_N_LAUNCHES == 1) bar = xcd_barrier_post(F.ctl + CW_BAR, (volatile LAS unsigned*)(F.lds + MISC_OFF));
    const int lo = args.ph_lo, hi = args.ph_hi;
#define IN(k) (lo <= (k) && (k) < hi)
#define SEAM(k) do { if (IN(k) && IN((k) + 1)) xcd_barrier(bar); AMP_SPIN(k); } while (0)
    if (PROBE_AMP >= 0) { if (FTID(F) == 0) *(volatile LAS unsigned long long*)(F.lds + MISC_OFF + 32) = __builtin_amdgcn_s_memrealtime(); }

    if (IN(0)) { p0_prologue(F, args); } SEAM(0);
    if (IN(1)) { p1_ln_mod(F, args); } SEAM(1);
    if (IN(2)) {
        pg8::DenseSched S; S.A = (const char*)(F.ws + WS_XM); S.Bt = (const char*)(F.ws + WS_WIN); S.K = 1024; S.ord.init(MT, NZ, F.G, (int)blockIdx.x);
        EpiZ E{F.ws, args.in[9]};
        pg8::gemm_phase<EpiZ, pg8::DenseSched>(F.lds, 1024, S, E);
    } SEAM(2);
    if (IN(3)) { if (args.pad != 2) p3_qkprep(F, args); if (args.pad != 1) p3_na(F, args); } SEAM(3);
    if (IN(4)) {
        for (int u = blockIdx.x; u < 576; u += F.G) { if (u < 512) mlstm_unit<false>(F, args, u >> 3, u & 7, false); else mlstm_unit<false>(F, args, u - 512, -1, false); }
    } SEAM(4);
    if (IN(5)) {
        for (int u = blockIdx.x; u < 256; u += F.G) { const int bh = u >> 3, gt = u & 7; for (int ps = 0; ps < 2; ++ps) mlstm_unit<true>(F, args, bh * 2 + ps, ps ? 7 - gt : gt, ps != 0); }
    } SEAM(5);
    if (IN(7)) {
        pg8::DenseSched S; S.A = (const char*)(F.ws + WS_MIX); S.Bt = (const char*)(F.ws + WS_WOUT); S.K = 1024; S.ord.init(ML_ROWS, 1024, F.G, (int)blockIdx.x);
        EpiY1 E{args.in[0], (const float*)(F.ws + WS_ADA), (bf16*)(F.ws + WS_Y1)};
        pg8::gemm_phase<EpiY1, pg8::DenseSched>(F.lds, 1024, S, E);
    } SEAM(7);
    if (IN(8)) { p8_mid(F, args); } SEAM(8);
    if (IN(9)) {
        moe_tables(F);
        MoeSched1 S; S.ord = MoeOrder{(const LAS int*)(F.lds + MISC_OFF + MS_CNT), (const LAS int*)(F.lds + MISC_OFF + MS_START), (const LAS int*)(F.lds + MISC_OFF + MS_TSTART), F.G, (int)blockIdx.x};
        S.XM2 = (const char*)(F.ws + WS_XM2); S.W13 = (const char*)(F.ws + WS_W13); S.TOKL = (const int*)(F.ws + WS_TOKL);
        EpiH E{(bf16*)(F.ws + WS_HMOE), (const LAS int*)(F.lds + MISC_OFF + MS_START)};
        pg8::gemm_phase<EpiH, MoeSched1>(F.lds, 1024, S, E);
    } SEAM(9);
    if (IN(10)) {
        moe_tables(F);
        MoeSched2 S; S.ord = MoeOrder{(const LAS int*)(F.lds + MISC_OFF + MS_CNT), (const LAS int*)(F.lds + MISC_OFF + MS_START), (const LAS int*)(F.lds + MISC_OFF + MS_TSTART), F.G, (int)blockIdx.x};
        S.H = (const char*)(F.ws + WS_HMOE); S.W2 = (const char*)(F.ws + WS_W2);
        EpiY E{(bf16*)(F.ws + WS_YMOE), (const LAS int*)(F.lds + MISC_OFF + MS_START)};
        pg8::gemm_phase<EpiY, MoeSched2>(F.lds, 512, S, E);
    } SEAM(10);
    if (IN(11)) { moe_tables(F); p11_final(F, args); }
    if (PROBE_AMP == 11) { VM_WAIT(); AMP_SPIN(11); }
#undef IN
#undef SEAM
}

extern "C" void kernel_launch(void* const* d_in, const int* in_sizes, int n_in, void* d_out, int out_size, void* d_ws, size_t ws_size, hipStream_t stream) {
    static int grid = 0;
    if (grid == 0) {
        if (n_in != 24 || out_size != ML_ROWS * DM || ws_size < WS_END) { fprintf(stderr, "kernel_launch: unexpected shapes (n_in %d out %d ws %zu)\n", n_in, out_size, ws_size); grid = -1; return; }
        int dev = 0, cus = 0, per_cu = 0;
        if (hipGetDevice(&dev) != hipSuccess || hipDeviceGetAttribute(&cus, hipDeviceAttributeMultiprocessorCount, dev) != hipSuccess) { grid = -1; return; }
        if (hipFuncSetAttribute((const void*)mk_fwd, hipFuncAttributeMaxDynamicSharedMemorySize, LDS_BYTES) != hipSuccess) { fprintf(stderr, "kernel_launch: hipFuncSetAttribute failed\n"); grid = -1; return; }
        if (hipOccupancyMaxActiveBlocksPerMultiprocessor(&per_cu, (const void*)mk_fwd, 512, LDS_BYTES) != hipSuccess || per_cu < 1) fprintf(stderr, "kernel_launch: occupancy query says %d\n", per_cu);
        (void)hipGetLastError();
        grid = cus;
    }
    if (grid < 0) return;
    if (hipMemsetAsync((char*)d_ws + WS_CTL, 0, CTL_ZERO_BYTES, stream) != hipSuccess) return;
    Args a{};
    for (int i = 0; i < 24; ++i) a.in[i] = (const float*)d_in[i];
    a.out = (float*)d_out; a.ws = (unsigned char*)d_ws;
    if (MK_N_LAUNCHES == 1) { a.ph_lo = 0; a.ph_hi = NPHASE; a.li = 0; hipLaunchKernelGGL(mk_fwd, dim3(grid), dim3(512), LDS_BYTES, stream, a); }
    else for (int p = 0; p < NPHASE; ++p) { a.ph_lo = p; a.ph_hi = p + 1; a.li = p; a.pad = 0; hipLaunchKernelGGL(mk_fwd, dim3(grid), dim3(512), LDS_BYTES, stream, a);
        if (PROBE_DBL == p || (PROBE_DBL == 33 && p == 3)) { a.pad = (PROBE_DBL == 33) ? 2 : (p == 3 ? 1 : 0); hipLaunchKernelGGL(mk_fwd, dim3(grid), dim3(512), LDS_BYTES, stream, a); } }
}
```

```cpp
#include <hip/hip_runtime.h>
#include <cstdio>
#include <cstdint>

#ifndef MK_N_LAUNCHES
#define MK_N_LAUNCHES 1
#endif
#ifndef PROBE_DBL
#define PROBE_DBL -1
#endif
#ifndef PROBE_AMP
#define PROBE_AMP -1
#endif

#define GAS __attribute__((address_space(1)))
#define LAS __attribute__((address_space(3)))
typedef unsigned short bf16;
typedef short bf16x8 __attribute__((ext_vector_type(8)));
typedef short bf16x4 __attribute__((ext_vector_type(4)));
typedef float f32x4 __attribute__((ext_vector_type(4)));
typedef float f32x2 __attribute__((ext_vector_type(2)));
typedef unsigned u32x4 __attribute__((ext_vector_type(4)));
typedef unsigned u32x2 __attribute__((ext_vector_type(2)));

constexpr int NB = 8, SEQ = 8192, DM = 1024, CTXL = 256;
constexpr int ML_ROWS = NB * SEQ, MC_ROWS = NB * CTXL, MT = ML_ROWS + MC_ROWS;
constexpr int IN_COLS = 3600, NZ = 3840;
constexpr int NEXP = 64, EH = 512;
constexpr float LN_EPS = 1e-5f;
constexpr float DN_ALPHA = 1.189207115002721f;
constexpr int NPHASE = 12;

constexpr size_t MiB = 1u << 20;
constexpr size_t WS_CTL = 0, CTL_ZERO_BYTES = 1 * MiB;
constexpr size_t WS_WIN = 1 * MiB;
constexpr size_t WS_WOUT = 9 * MiB;
constexpr size_t WS_W13 = 11 * MiB;
constexpr size_t WS_W2 = 139 * MiB;
constexpr size_t WS_ADA = 203 * MiB;
constexpr size_t WS_ROPE = 204 * MiB;
constexpr size_t WS_WR = 204 * MiB + 512 * 1024;
constexpr size_t WS_GATES = 205 * MiB;
constexpr size_t WS_TOKL = 210 * MiB;
constexpr size_t WS_ROUTE = 226 * MiB;
constexpr size_t WS_MLST = 227 * MiB;
constexpr int REC_FLOATS = 18688;
constexpr size_t WS_ZA = 270 * MiB;
constexpr size_t WS_ZQK = 468 * MiB;
constexpr size_t WS_ZV = 600 * MiB;
constexpr size_t WS_ZO = 666 * MiB;
constexpr size_t WS_XM = 732 * MiB;
constexpr size_t WS_MIX = 864 * MiB;
constexpr size_t WS_HB = 270 * MiB;
constexpr size_t WS_Y1 = 270 * MiB;
constexpr size_t WS_HMOE = 526 * MiB;
constexpr size_t WS_XM2 = 655 * MiB;
constexpr size_t WS_YMOE = 655 * MiB;
constexpr size_t WS_END = 992 * MiB;
static_assert(WS_MLST + (size_t)64 * 9 * REC_FLOATS * 4 <= WS_ZA, "ws map");
static_assert(WS_YMOE + (size_t)(131072 + 256) * 1024 * 2 <= WS_END, "ws map");
constexpr int CW_TMO = 0;
constexpr int CW_BAR = 4096;
constexpr int CW_CNT = 16384;

constexpr int PH_BYTES = 159744;
constexpr int MISC_OFF = PH_BYTES;
constexpr int LDS_BYTES = PH_BYTES + 4096;
constexpr int MS_TSTART = 64;
constexpr int MS_CNT = 384;
constexpr int MS_START = 704;
constexpr int MS_HIST = 1024;
constexpr int MS_BASE = 1280;

#define LDS_WAIT() asm volatile("s_waitcnt lgkmcnt(0)" ::: "memory")
#define VM_WAIT() asm volatile("s_waitcnt vmcnt(0)" ::: "memory")
#define RLX_AGENT __ATOMIC_RELAXED, __HIP_MEMORY_SCOPE_AGENT

__device__ __forceinline__ unsigned cvt_pk_bf16(float lo, float hi) { unsigned r; asm volatile("v_cvt_pk_bf16_f32 %0, %1, %2" : "=v"(r) : "v"(lo), "v"(hi)); return r; }
__device__ __forceinline__ int opaque(int x) { asm volatile("" : "+v"(x)); return x; }
__device__ __forceinline__ float bf_lo(unsigned u) { return __builtin_bit_cast(float, u << 16); }
__device__ __forceinline__ float bf_hi(unsigned u) { return __builtin_bit_cast(float, u & 0xffff0000u); }
__device__ __forceinline__ float wave_sum(float v) {
#pragma unroll
    for (int o = 1; o < 64; o <<= 1) v += __shfl_xor(v, o);
    return v;
}
__device__ __forceinline__ void wave_sum4(float (&v)[4]) {
#pragma unroll
    for (int o = 1; o < 64; o <<= 1) {
#pragma unroll
        for (int r = 0; r < 4; ++r) v[r] += __shfl_xor(v[r], o);
    }
}
__device__ __forceinline__ bf16x4 tr_read(const LAS unsigned char* p) { return __builtin_amdgcn_ds_read_tr16_b64_v4i16((LAS bf16x4*)p); }
__device__ __forceinline__ bf16x8 cat4(bf16x4 a, bf16x4 b) { return (bf16x8){a[0], a[1], a[2], a[3], b[0], b[1], b[2], b[3]}; }
__device__ __forceinline__ bf16x8 as_bf16x8(u32x4 v) { return __builtin_bit_cast(bf16x8, v); }

#define XB_TMO      128
#define XB_XCNT(j)  (256  + 64 * (j))
#define XB_XSUB(j)  (1280 + 64 * (j))
#define XB_XGEN(j)  (2304 + 64 * (j))
#define XB_TOP      3328
#define XB_TOPGEN   3392
#define XCD_BAR_WORDS 3456
#define XB_SPIN_CAP (1u << 18)
__device__ __forceinline__ unsigned xb_ld(unsigned* p)              { return __hip_atomic_load(p, __ATOMIC_RELAXED, __HIP_MEMORY_SCOPE_AGENT); }
__device__ __forceinline__ unsigned xb_add(unsigned* p, unsigned v) { return __hip_atomic_fetch_add(p, v, __ATOMIC_RELAXED, __HIP_MEMORY_SCOPE_AGENT); }
__device__ __forceinline__ unsigned xb_xcc_id() { return (unsigned)__builtin_amdgcn_s_getreg((3 << 11) | 20) & 0xFu; }
#define XB_SPIN(cond, bar) do { unsigned _sp = 0; while (cond) { __builtin_amdgcn_s_sleep(1); \
    if ((++_sp & 255u) == 0u) { if (xb_ld(&(bar)[XB_TMO])) break; if (_sp > XB_SPIN_CAP) { atomicAdd(&(bar)[XB_TMO], 1u); break; } } } } while (0)
struct XcdBarrier { unsigned* bar; unsigned x; volatile LAS unsigned* st; };
__device__ __forceinline__ XcdBarrier xcd_barrier_post(unsigned* bar, volatile LAS unsigned* st) {
    XcdBarrier b; b.bar = bar; b.x = xb_xcc_id(); b.st = st;
    if (threadIdx.x == 0) (void)xb_add(&bar[XB_XCNT(b.x)], 1u);
    return b;
}
__device__ __forceinline__ void xcd_barrier_complete(unsigned* bar, unsigned x, unsigned& nloc, unsigned& nx) {
    const unsigned G = gridDim.x * gridDim.y * gridDim.z;
    unsigned sum, cnt, mine, sp = 0u;
    for (;;) {
        sum = 0u; cnt = 0u; mine = 0u;
#pragma unroll
        for (unsigned j = 0; j < 16; ++j) { const unsigned c = xb_ld(&bar[XB_XCNT(j)]); sum += c; cnt += (c > 0u) ? 1u : 0u; mine = (j == x) ? c : mine; }
        if (sum == G) break;
        __builtin_amdgcn_s_sleep(1);
        if ((++sp & 255u) == 0u) { if (xb_ld(&bar[XB_TMO])) break; if (sp > XB_SPIN_CAP) { atomicAdd(&bar[XB_TMO], 1u); break; } }
    }
    nloc = mine > 0u ? mine : 1u; nx = cnt > 0u ? cnt : 1u;
}
__device__ __forceinline__ void xcd_barrier(const XcdBarrier& b) {
    asm volatile("s_waitcnt vmcnt(0)" ::: "memory");
    __syncthreads();
    if (threadIdx.x == 0) {
        unsigned* bar = b.bar;
        __builtin_amdgcn_s_waitcnt(0);
        unsigned nloc = b.st[0], nx = b.st[1];
        if (nloc == 0u) { xcd_barrier_complete(bar, b.x, nloc, nx); b.st[0] = nloc; b.st[1] = nx; }
        const unsigned old = xb_add(&bar[XB_XSUB(b.x)], 1u);
        const unsigned gen = old / nloc;
        if (old + 1u == (gen + 1u) * nloc) {
            __builtin_amdgcn_fence(__ATOMIC_RELEASE, "agent");
            asm volatile("s_waitcnt vmcnt(0)" ::: "memory");
            const unsigned og = xb_add(&bar[XB_TOP], 1u);
            const unsigned tg = og / nx;
            if (og + 1u == (tg + 1u) * nx) xb_add(&bar[XB_TOPGEN], 1u);
            else XB_SPIN(xb_ld(&bar[XB_TOPGEN]) == tg, bar);
            __builtin_amdgcn_fence(__ATOMIC_ACQUIRE, "agent");
            xb_add(&bar[XB_XGEN(b.x)], 1u);
            asm volatile("s_waitcnt vmcnt(0)" ::: "memory");
        } else {
            XB_SPIN(xb_ld(&bar[XB_XGEN(b.x)]) == gen, bar);
            __builtin_amdgcn_fence(__ATOMIC_ACQUIRE, "agent");
            asm volatile("s_waitcnt vmcnt(0)" ::: "memory");
        }
    }
    __syncthreads();
}

namespace pg8 {
constexpr int BM = 256, BK = 64, HALF = 128, HTB = HALF * BK * 2, STAGE_BYTES = 8 * HTB, NXCD = 8, WGM = 8;
__host__ __device__ __forceinline__ int lds_byte(int r, int c) { const int st = (r >> 4) * 2 + (c >> 5), rr = r & 15, cc = c & 31, ob = rr * 64 + cc * 2; return st * 1024 + (ob ^ (((ob >> 9) & 1) << 5)); }
__host__ __device__ __forceinline__ void stage_rc(int b, int& R, int& C) { const int st = b / 1024, sb = b % 1024, swz = sb ^ (((sb >> 9) & 1) << 5); R = (st >> 1) * 16 + swz / 64; C = (st & 1) * 32 + (swz % 64) / 2; }
__host__ __device__ __forceinline__ int perm32(int rho) { const int n = rho >> 4, i = rho & 15; return 8 * (i >> 2) + 4 * n + (i & 3); }

struct Unit { int pm, pn, e, cnt; };

struct StaticOrder {
    int nM, nN, nwg, G, c;
    __device__ void init(int M, int N, int G_, int c_) { nM = M / BM; nN = N / BM; nwg = nM * nN; G = G_; c = c_; }
    __device__ bool next(int i, Unit& u) const {
        const long L = (long)i * G + c; if (L >= nwg) return false;
        int wgid = (int)L; { const int q = nwg / NXCD, r = nwg % NXCD, xcd = wgid % NXCD, off = wgid / NXCD; wgid = (xcd < r ? xcd * (q + 1) : r * (q + 1) + (xcd - r) * q) + off; }
        const int nig = WGM * nN, gid = wgid / nig, fm = gid * WGM, gsz = (nM - fm) < WGM ? (nM - fm) : WGM;
        u.pm = fm + ((wgid % nig) % gsz); u.pn = (wgid % nig) / gsz; u.e = 0; u.cnt = 256; return true;
    }
};
struct DenseSched {
    static constexpr bool GATHER = false;
    const char* A; const char* Bt; int K; StaticOrder ord;
    __device__ __forceinline__ bool next(int i, Unit& u) const { return ord.next(i, u); }
    __device__ __forceinline__ const char* a_ptr(const Unit& u) const { return A + (size_t)u.pm * BM * K * 2; }
    __device__ __forceinline__ const char* b_ptr(const Unit& u) const { return Bt + (size_t)u.pn * BM * K * 2; }
    __device__ __forceinline__ void a_voff(const Unit&, unsigned (&)[2][2], int) const {}
};

template <class Epi, class Sched, bool ALIGN_EPI = true>
__device__ __forceinline__ void gemm_phase(LAS unsigned char* lds, const int K, const Sched& S, const Epi& E) {
    const int tid = opaque((int)threadIdx.x), wid = __builtin_amdgcn_readfirstlane(tid >> 6), lane = tid & 63, wr = wid >> 2, wc = wid & 3, fr = lane & 15, fq = lane >> 4;
    const int nt = K / BK;
    unsigned voffA[2], voffB[2];
#pragma unroll
    for (int i = 0; i < 2; ++i) { int R, C; stage_rc(tid * 16 + i * 8192, R, C); const int Rb = Epi::PERM ? ((R & ~31) + perm32(R & 31)) : R;
        voffA[i] = (unsigned)(R * K + C) * 2u; voffB[i] = (unsigned)(Rb * K + C) * 2u; }
    const size_t kstep = (size_t)(BK * 2);
    const size_t hstep = (size_t)HALF * K * 2;
    const unsigned ldsw = (unsigned)wid * 1024u;
    const int aoff = lds_byte(wr * 64 + fr, fq * 8), boff = lds_byte(wc * 32 + fr, fq * 8);
#define PG8_SA(b, h) (((b) * 2 + (h)) * HTB)
#define PG8_SB(b, h) ((4 + (b) * 2 + (h)) * HTB)
#define PG8_STAGE(bufoff, gbase, voff) do { _Pragma("unroll") for (int _i = 0; _i < 2; ++_i) \
        __builtin_amdgcn_global_load_lds((const unsigned*)((const char*)(gbase) + (voff)[_i]), (LAS unsigned*)(lds + (bufoff) + ldsw + _i * 8192), 16, 0, 0); } while (0)
#define PG8_STAGE_A(b, h, ptr, gv) do { if constexpr (Sched::GATHER) { PG8_STAGE(PG8_SA(b, h), ptr, gv[h]); } else { PG8_STAGE(PG8_SA(b, h), (ptr) + ((h) ? hstep : 0), voffA); } } while (0)
#define PG8_LDA(dst, b, h) do { _Pragma("unroll") for (int m = 0; m < 4; ++m) _Pragma("unroll") for (int k = 0; k < 2; ++k) dst[m][k] = *(const LAS bf16x8*)(lds + PG8_SA(b, h) + aoff + m * 2048 + k * 1024); } while (0)
#define PG8_LDB(dst, b, h) do { _Pragma("unroll") for (int n = 0; n < 2; ++n) _Pragma("unroll") for (int k = 0; k < 2; ++k) dst[n][k] = *(const LAS bf16x8*)(lds + PG8_SB(b, h) + boff + n * 2048 + k * 1024); } while (0)
#define PG8_MMA(ai, bj, At, Bt) do { __builtin_amdgcn_s_setprio(1); _Pragma("unroll") for (int m = 0; m < 4; ++m) _Pragma("unroll") for (int n = 0; n < 2; ++n) _Pragma("unroll") for (int k = 0; k < 2; ++k) \
        acc[ai][bj][m][n] = __builtin_amdgcn_mfma_f32_16x16x32_bf16(Bt[n][k], At[m][k], acc[ai][bj][m][n], 0, 0, 0); __builtin_amdgcn_s_setprio(0); } while (0)
#define PG8_WAIT_V(n) asm volatile("s_waitcnt vmcnt(" #n ")" ::: "memory")
#define PG8_WAIT_L(n) asm volatile("s_waitcnt lgkmcnt(" #n ")" ::: "memory")
#define PG8_BAR __builtin_amdgcn_s_barrier()
#define PG8_SCHED __builtin_amdgcn_sched_barrier(0)
    Unit cur, nxt; int ui = 0;
    if (!S.next(0, cur)) return;
    f32x4 acc[2][2][4][2];
#pragma unroll
    for (int a = 0; a < 2; ++a)
#pragma unroll
        for (int b = 0; b < 2; ++b)
#pragma unroll
            for (int m = 0; m < 4; ++m)
#pragma unroll
                for (int n = 0; n < 2; ++n) acc[a][b][m][n] = (f32x4){0.f, 0.f, 0.f, 0.f};
    bf16x8 At[4][2], B0[2][2], B1[2][2];
    unsigned cv[2][2], nv[2][2];
    const char* cA = S.a_ptr(cur); const char* cB = S.b_ptr(cur);
    if constexpr (Sched::GATHER) { S.a_voff(cur, cv, tid);
#pragma unroll
        for (int h = 0; h < 2; ++h)
#pragma unroll
            for (int i = 0; i < 2; ++i) nv[h][i] = cv[h][i]; }
    PG8_STAGE(PG8_SB(0, 0), cB, voffB); PG8_STAGE(PG8_SB(0, 1), cB + hstep, voffB); PG8_STAGE_A(0, 0, cA, cv); PG8_STAGE_A(0, 1, cA, cv);
    if (wr == 1) PG8_BAR;
    PG8_WAIT_V(2); PG8_BAR;
    PG8_STAGE(PG8_SB(1, 0), cB + kstep, voffB); PG8_STAGE_A(1, 0, cA + kstep, cv); PG8_STAGE(PG8_SB(1, 1), cB + hstep + kstep, voffB);
    PG8_WAIT_V(6); PG8_BAR;
    for (;;) {
        const bool has_next = S.next(ui + 1, nxt);
        const char* nA = has_next ? S.a_ptr(nxt) : cA; const char* nB = has_next ? S.b_ptr(nxt) : cB;
        if constexpr (Sched::GATHER) { if (has_next) S.a_voff(nxt, nv, tid); }
        for (int t = 0; t < nt; t += 2) {
            const bool last = (t == nt - 2);
            const char* a1 = cA + (size_t)(t + 1) * kstep;
            const char* a2 = last ? nA : cA + (size_t)(t + 2) * kstep; const char* b2 = last ? nB : cB + (size_t)(t + 2) * kstep;
            const char* a3 = a2 + kstep; const char* b3 = b2 + kstep;
            unsigned v2[2][2];
            if constexpr (Sched::GATHER) {
#pragma unroll
                for (int h = 0; h < 2; ++h)
#pragma unroll
                    for (int i = 0; i < 2; ++i) v2[h][i] = last ? nv[h][i] : cv[h][i]; }
            PG8_LDB(B0, 0, 0); PG8_LDB(B1, 0, 1); PG8_SCHED; PG8_LDA(At, 0, 0); PG8_STAGE_A(1, 1, a1, cv);
            PG8_WAIT_V(8); PG8_WAIT_L(0); PG8_BAR; PG8_MMA(0, 0, At, B0); PG8_MMA(0, 1, At, B1); PG8_BAR; PG8_SCHED;
            PG8_LDA(At, 0, 1); PG8_STAGE(PG8_SB(0, 0), b2, voffB); PG8_STAGE(PG8_SB(0, 1), b2 + hstep, voffB); PG8_STAGE_A(0, 0, a2, v2);
            PG8_WAIT_V(8); PG8_WAIT_L(0); PG8_BAR; PG8_MMA(1, 0, At, B0); PG8_MMA(1, 1, At, B1); PG8_BAR; PG8_SCHED;
            PG8_LDB(B0, 1, 0); PG8_LDB(B1, 1, 1); PG8_SCHED; PG8_LDA(At, 1, 0); PG8_STAGE_A(0, 1, a2, v2);
            PG8_WAIT_V(8); PG8_WAIT_L(0); PG8_BAR; PG8_MMA(0, 0, At, B0); PG8_MMA(0, 1, At, B1); PG8_BAR; PG8_SCHED;
            PG8_LDA(At, 1, 1); PG8_STAGE(PG8_SB(1, 0), b3, voffB); PG8_STAGE(PG8_SB(1, 1), b3 + hstep, voffB); PG8_STAGE_A(1, 0, a3, v2);
            PG8_WAIT_V(8); PG8_WAIT_L(0); PG8_BAR; PG8_MMA(1, 0, At, B0); PG8_MMA(1, 1, At, B1); PG8_BAR; PG8_SCHED;
        }
        if constexpr (ALIGN_EPI) { if (wr == 0) PG8_BAR; }
        E(acc, cur, wr, wc, fr, fq);
        if (!has_next) break;
#pragma unroll
        for (int a = 0; a < 2; ++a)
#pragma unroll
            for (int b = 0; b < 2; ++b)
#pragma unroll
                for (int m = 0; m < 4; ++m)
#pragma unroll
                    for (int n = 0; n < 2; ++n) acc[a][b][m][n] = (f32x4){0.f, 0.f, 0.f, 0.f};
        cur = nxt; cA = nA; cB = nB; ++ui;
        if constexpr (Sched::GATHER) {
#pragma unroll
            for (int h = 0; h < 2; ++h)
#pragma unroll
                for (int i = 0; i < 2; ++i) cv[h][i] = nv[h][i]; }
        if constexpr (ALIGN_EPI) { if (wr == 1) PG8_BAR; }
    }
    PG8_WAIT_V(0);
    if constexpr (!ALIGN_EPI) { if (wr == 0) PG8_BAR; }
    PG8_BAR;
#undef PG8_SA
#undef PG8_SB
#undef PG8_STAGE
#undef PG8_STAGE_A
#undef PG8_LDA
#undef PG8_LDB
#undef PG8_MMA
#undef PG8_WAIT_V
#undef PG8_WAIT_L
#undef PG8_BAR
#undef PG8_SCHED
}
}

struct Args { const float* in[24]; float* out; unsigned char* ws; int ph_lo, ph_hi, li, pad; };
struct Frame {
    LAS unsigned char* lds;
    unsigned* ctl;
    int wave, vcu, G;
    unsigned char* ws;
};
__device__ __forceinline__ int cur_lane() { int l; asm volatile("v_mbcnt_lo_u32_b32 %0, -1, 0\n\tv_mbcnt_hi_u32_b32 %0, -1, %0" : "=v"(l)); return l; }
#define FTID(F) ((F).wave * 64 + cur_lane())

#define AMP_SPIN(k) do { if (PROBE_AMP == (k)) { __syncthreads(); const unsigned long long t0_ = *(volatile LAS unsigned long long*)(F.lds + MISC_OFF + 32), t1_ = __builtin_amdgcn_s_memrealtime(), tg_ = t1_ + 3ull * (t1_ - t0_); \
            while (__builtin_amdgcn_s_memrealtime() < tg_) __builtin_amdgcn_s_sleep(20); __syncthreads(); } \
        if (PROBE_AMP >= 0) { if (FTID(F) == 0) *(volatile LAS unsigned long long*)(F.lds + MISC_OFF + 32) = __builtin_amdgcn_s_memrealtime(); } } while (0)

__device__ __forceinline__ int rowmap(int mode, int n) { return mode == 0 ? n : ((n >> 7) * 256 + (n & 127) + (mode == 2 ? 128 : 0)); }
__device__ __forceinline__ void p0_transpose_item(const float* W, int K, int N, bf16* WT, int mode, LAS float* scr, int item, int lane) {
    const int nblk = (N + 63) / 64, kb = item / nblk, nb = item % nblk, k0 = 64 * kb, n0 = 64 * nb;
    const int nn = n0 + lane; const bool ok = nn < N;
    float tv[64];
#pragma unroll
    for (int i = 0; i < 64; ++i) tv[i] = ok ? W[(size_t)(k0 + i) * N + nn] : 0.f;
#pragma unroll
    for (int i = 0; i < 64; ++i) scr[i * 65 + lane] = tv[i];
    LDS_WAIT(); asm volatile("" ::: "memory");
    const int c = lane & 7;
#pragma unroll
    for (int j = 0; j < 8; ++j) { const int n = (lane >> 3) + 8 * j; const LAS float* s = scr + (8 * c) * 65 + n;
        u32x4 o; o.x = cvt_pk_bf16(s[0 * 65], s[1 * 65]); o.y = cvt_pk_bf16(s[2 * 65], s[3 * 65]); o.z = cvt_pk_bf16(s[4 * 65], s[5 * 65]); o.w = cvt_pk_bf16(s[6 * 65], s[7 * 65]);
        if (n0 + n < N) *(u32x4*)(WT + (size_t)rowmap(mode, n0 + n) * K + k0 + 8 * c) = o; }
    LDS_WAIT(); asm volatile("" ::: "memory");
}
__device__ __forceinline__ void p0_prologue(Frame& F, const Args& a) {
    const int gw = F.vcu * 8 + F.wave, NGW = F.G * 8, lane = cur_lane(), tid = FTID(F);
    float* ada = (float*)(F.ws + WS_ADA);
    {
        LAS float* sS = (LAS float*)F.lds;
        LAS float* sP = (LAS float*)(F.lds + 36864);
        bool staged = false;
        for (int it = blockIdx.x; it < 192; it += F.G) {
            if (!staged) {
                for (int i = tid; i < 9 * 1024; i += 512) { const int r = i >> 10, k = i & 1023; const float v = r < 8 ? a.in[1][r * 1024 + k] : a.in[3][k]; sS[i] = v / (1.f + __expf(-v)); }
                staged = true;
            }
            __syncthreads();
            const int n = it * 32 + (lane & 31), kh = lane >> 5, kb = F.wave * 128;
            float acc[9];
#pragma unroll
            for (int r = 0; r < 9; ++r) acc[r] = 0.f;
            const float* W = a.in[4];
            for (int jb = 0; jb < 64; jb += 16) {
                float wv[16];
#pragma unroll
                for (int j = 0; j < 16; ++j) wv[j] = W[(size_t)(kb + 2 * (jb + j) + kh) * 6144 + n];
#pragma unroll
                for (int j = 0; j < 16; ++j) { const int k = kb + 2 * (jb + j) + kh;
#pragma unroll
                    for (int r = 0; r < 9; ++r) acc[r] += sS[r * 1024 + k] * wv[j]; }
            }
#pragma unroll
            for (int r = 0; r < 9; ++r) { acc[r] += __shfl_xor(acc[r], 32); if (lane < 32) sP[(F.wave * 9 + r) * 32 + lane] = acc[r]; }
            __syncthreads();
            if (tid < 288) { const int r = tid >> 5, c = tid & 31; float s = a.in[5][it * 32 + c];
#pragma unroll
                for (int w = 0; w < 8; ++w) s += sP[(w * 9 + r) * 32 + c];
                ada[r * 6144 + it * 32 + c] = s; }
        }
        __syncthreads();
    }
    { float* rope = (float*)(F.ws + WS_ROPE);
      for (int i = blockIdx.x * 512 + tid; i < 128 * 32; i += F.G * 512) { const int pos = i >> 5, j = i & 31; const double ang = (double)pos * pow(10000.0, -(double)j / 32.0);
          rope[2 * i] = (float)cos(ang); rope[2 * i + 1] = (float)sin(ang); } }
    { bf16* wr = (bf16*)(F.ws + WS_WR);
      for (int i = blockIdx.x * 512 + tid; i < 80 * 1024; i += F.G * 512) { const int r = i >> 10, k = i & 1023; float v = 0.f;
          if (r < 8) v = a.in[15][k * 8 + r]; else if (r >= 16) v = a.in[17][k * 64 + (r - 16)];
          wr[i] = (bf16)(cvt_pk_bf16(v, 0.f) & 0xffffu); } }
    { u32x4* z = (u32x4*)((bf16*)(F.ws + WS_WIN) + (size_t)IN_COLS * 1024);
      for (int i = blockIdx.x * 512 + tid; i < (NZ - IN_COLS) * 1024 / 8; i += F.G * 512) z[i] = (u32x4){0u, 0u, 0u, 0u}; }
    LAS float* scr = (LAS float*)(F.lds + 16384 + F.wave * 16640);
    constexpr int B_IN = 4 * 29, B_OUT = 4 * 8, B_E = 16;
    constexpr int NBITEMS = B_IN + B_OUT + 3 * NEXP * B_E;
    const int wk = F.wave >> 1, wn = F.wave & 1;
    for (int bi = F.vcu; bi < NBITEMS; bi += F.G) {
        int r = bi;
        if (r < B_IN) { const int kb = 4 * (r / 29) + wk, nb = 2 * (r % 29) + wn; if (nb < 57) p0_transpose_item(a.in[6], 1024, IN_COLS, (bf16*)(F.ws + WS_WIN), 0, scr, kb * 57 + nb, lane); continue; } r -= B_IN;
        if (r < B_OUT) { const int kb = 4 * (r / 8) + wk, nb = 2 * (r % 8) + wn; p0_transpose_item(a.in[12], 1024, 1024, (bf16*)(F.ws + WS_WOUT), 0, scr, kb * 16 + nb, lane); continue; } r -= B_OUT;
        if (r < NEXP * B_E) { const int e = r >> 4, q = r & 15, kb = 4 * (q >> 2) + wk, nb = 2 * (q & 3) + wn; p0_transpose_item(a.in[19] + (size_t)e * 1024 * 512, 1024, 512, (bf16*)(F.ws + WS_W13) + (size_t)e * 1024 * 1024, 1, scr, kb * 8 + nb, lane); continue; } r -= NEXP * B_E;
        if (r < NEXP * B_E) { const int e = r >> 4, q = r & 15, kb = 4 * (q >> 2) + wk, nb = 2 * (q & 3) + wn; p0_transpose_item(a.in[20] + (size_t)e * 1024 * 512, 1024, 512, (bf16*)(F.ws + WS_W13) + (size_t)e * 1024 * 1024, 2, scr, kb * 8 + nb, lane); continue; } r -= NEXP * B_E;
        { const int e = r >> 4, q = r & 15, kb = 4 * (q >> 3) + wk, nb = 2 * (q & 7) + wn; p0_transpose_item(a.in[21] + (size_t)e * 512 * 1024, 512, 1024, (bf16*)(F.ws + WS_W2) + (size_t)e * 1024 * 512, 0, scr, kb * 16 + nb, lane); }
    }
}

__device__ __forceinline__ void p1_ln_mod(Frame& F, const Args& a) {
    const int gw = F.vcu * 8 + F.wave, NGW = F.G * 8, lane = opaque(cur_lane());
    const float* ada = (const float*)(F.ws + WS_ADA);
    bf16* XM = (bf16*)(F.ws + WS_XM);
    for (int m0 = gw; m0 < MT; m0 += 4 * NGW) {
        f32x4 v[4][4]; float s[4]; bool ok[4]; int mm[4];
#pragma unroll
        for (int r = 0; r < 4; ++r) { const int m = m0 + r * NGW; ok[r] = m < MT; mm[r] = ok[r] ? m : m0;
            const f32x4* xr = (const f32x4*)(mm[r] < ML_ROWS ? a.in[0] + (size_t)mm[r] * DM : a.in[2] + (size_t)(mm[r] - ML_ROWS) * DM) + lane;
#pragma unroll
            for (int j = 0; j < 4; ++j) v[r][j] = xr[64 * j]; }
#pragma unroll
        for (int r = 0; r < 4; ++r) { s[r] = 0.f;
#pragma unroll
            for (int j = 0; j < 4; ++j) s[r] += (v[r][j].x + v[r][j].y) + (v[r][j].z + v[r][j].w); }
        wave_sum4(s);
#pragma unroll
        for (int r = 0; r < 4; ++r) { const float mean = s[r] * (1.f / DM); s[r] = 0.f;
#pragma unroll
            for (int j = 0; j < 4; ++j) { v[r][j] = v[r][j] - mean; s[r] += (v[r][j].x * v[r][j].x + v[r][j].y * v[r][j].y) + (v[r][j].z * v[r][j].z + v[r][j].w * v[r][j].w); } }
        wave_sum4(s);
#pragma unroll
        for (int r = 0; r < 4; ++r) {
            const float rstd = 1.f / sqrtf(s[r] * (1.f / DM) + LN_EPS);
            const int ab = mm[r] < ML_ROWS ? (mm[r] >> 13) : 8;
            const f32x4* sh = (const f32x4*)(ada + ab * 6144) + lane; const f32x4* sc = sh + 256;
            u32x2* o8 = (u32x2*)(XM + (size_t)mm[r] * DM) + lane;
            if (ok[r]) {
#pragma unroll
                for (int j = 0; j < 4; ++j) { const f32x4 h = sh[64 * j], c = sc[64 * j]; const f32x4 y = (v[r][j] * rstd) * (c + 1.f) + h;
                    o8[64 * j] = (u32x2){cvt_pk_bf16(y.x, y.y), cvt_pk_bf16(y.z, y.w)}; } }
        }
    }
}

struct EpiZ {
    static constexpr bool PERM = true;
    unsigned char* ws; const float* gate_b;
    __device__ __forceinline__ void operator()(const f32x4 (&acc)[2][2][4][2], const pg8::Unit& u, int wr, int wc, int fr, int fq) const {
        const int row0 = u.pm * 256 + wr * 64 + fr;
        if (u.pn < 14) {
            bf16* base; int ldc, colt;
            if (u.pn < 6) { base = (bf16*)(ws + WS_ZA); ldc = 1536; colt = u.pn * 256; }
            else if (u.pn < 10) { base = (bf16*)(ws + WS_ZQK); ldc = 1024; colt = (u.pn - 6) * 256; }
            else if (u.pn < 12) { base = (bf16*)(ws + WS_ZV); ldc = 512; colt = (u.pn - 10) * 256; }
            else { base = (bf16*)(ws + WS_ZO); ldc = 512; colt = (u.pn - 12) * 256; }
            const int col0 = colt + wc * 32 + 8 * fq;
#pragma unroll
            for (int ai = 0; ai < 2; ++ai)
#pragma unroll
                for (int m = 0; m < 4; ++m) { bf16* rowp = base + (size_t)(row0 + ai * 128 + m * 16) * ldc + col0;
#pragma unroll
                    for (int bj = 0; bj < 2; ++bj) { const f32x4 v0 = acc[ai][bj][m][0], v1 = acc[ai][bj][m][1];
                        u32x4 w; w.x = cvt_pk_bf16(v0[0], v0[1]); w.y = cvt_pk_bf16(v0[2], v0[3]); w.z = cvt_pk_bf16(v1[0], v1[1]); w.w = cvt_pk_bf16(v1[2], v1[3]);
                        *(u32x4*)(rowp + bj * 128) = w; } }
        } else if (wc == 0 && fq < 2) {
            float* G = (float*)(ws + WS_GATES);
            const f32x4 b0 = *(const f32x4*)(gate_b + 8 * fq), b1 = *(const f32x4*)(gate_b + 8 * fq + 4);
#pragma unroll
            for (int ai = 0; ai < 2; ++ai)
#pragma unroll
                for (int m = 0; m < 4; ++m) { float* rowp = G + (size_t)(row0 + ai * 128 + m * 16) * 16 + 8 * fq;
                    *(f32x4*)rowp = acc[ai][0][m][0] + b0; *(f32x4*)(rowp + 4) = acc[ai][0][m][1] + b1; }
        }
    }
};

__device__ __forceinline__ void p3_qkprep(Frame& F, const Args& a) {
    const int lane = cur_lane(), half = F.wave & 1;
    const int gwh = (F.vcu * 8 + F.wave) >> 1, NGH = F.G * 4;
    const bf16* ZQK = (const bf16*)(F.ws + WS_ZQK); bf16* QKP = (bf16*)(F.ws + WS_XM);
    const float* rope = (const float*)(F.ws + WS_ROPE);
    const int ch0 = half * 512 + 8 * lane, i0 = 8 * (lane & 3);
    const bool col_rot = ((lane >> 3) & 1) != 0, second = ((lane >> 2) & 1) != 0;
    float w[5][8], bia[8];
#pragma unroll
    for (int j = 0; j < 5; ++j) { const f32x4 w0 = *(const f32x4*)(a.in[7] + j * 1024 + ch0), w1 = *(const f32x4*)(a.in[7] + j * 1024 + ch0 + 4);
#pragma unroll
        for (int e = 0; e < 4; ++e) { w[j][e] = w0[e]; w[j][4 + e] = w1[e]; } }
    { const f32x4 b0 = *(const f32x4*)(a.in[8] + ch0), b1 = *(const f32x4*)(a.in[8] + ch0 + 4);
#pragma unroll
      for (int e = 0; e < 4; ++e) { bia[e] = b0[e]; bia[4 + e] = b1[e]; } }
    float cst[8], sst[8];
#pragma unroll
    for (int q = 0; q < 4; ++q) { const f32x4 t = *(const f32x4*)(rope + (size_t)(32 + i0 + 2 * q) * 2);
        cst[2 * q] = col_rot ? t.x : 1.f; sst[2 * q] = col_rot ? t.y : 0.f; cst[2 * q + 1] = col_rot ? t.z : 1.f; sst[2 * q + 1] = col_rot ? t.w : 0.f; }
    const float ksc = half ? 0.08838834764831845f : 1.f;
    constexpr int RUN = 8, NITEM = MT / RUN;
    for (int it = gwh; it < NITEM; it += NGH) {
        const int row0 = it * RUN;
        const bool lat = row0 < ML_ROWS;
        const int T = lat ? SEQ : CTXL, s0 = lat ? (row0 & (SEQ - 1)) : ((row0 - ML_ROWS) & (CTXL - 1));
        u32x4 win[12];
#pragma unroll
        for (int j = 0; j < 12; ++j) { const int s = s0 + j - 2; const bool ok = s >= 0 && s < T;
            win[j] = ok ? *(const u32x4*)(ZQK + (size_t)(row0 + j - 2) * 1024 + ch0) : (u32x4){0u, 0u, 0u, 0u}; }
        float cc[8], ss[8];
        if (lat) { const int pos = col_rot ? (s0 & 63) : (s0 >> 6);
#pragma unroll
            for (int q = 0; q < 4; ++q) { const f32x4 t = *(const f32x4*)(rope + (size_t)(pos * 32 + i0 + 2 * q) * 2); cc[2 * q] = t.x; ss[2 * q] = t.y; cc[2 * q + 1] = t.z; ss[2 * q + 1] = t.w; }
        } else {
#pragma unroll
            for (int e = 0; e < 8; ++e) { cc[e] = 1.f; ss[e] = 0.f; }
        }
#pragma unroll
        for (int r = 0; r < RUN; ++r) {
            float u[8];
#pragma unroll
            for (int e = 0; e < 8; ++e) u[e] = bia[e];
#pragma unroll
            for (int j = 0; j < 5; ++j)
#pragma unroll
                for (int q = 0; q < 4; ++q) { const unsigned x = win[r + j][q]; u[2 * q] += w[j][2 * q] * bf_lo(x); u[2 * q + 1] += w[j][2 * q + 1] * bf_hi(x); }
            u32x4 o;
            float v[8];
#pragma unroll
            for (int e = 0; e < 8; ++e) { const float sv = u[e] * __builtin_amdgcn_rcpf(1.f + __expf(-u[e])); const float ot = __shfl_xor(sv, 4);
                v[e] = (sv * cc[e] + ot * (second ? ss[e] : -ss[e])) * ksc; }
#pragma unroll
            for (int q = 0; q < 4; ++q) o[q] = cvt_pk_bf16(v[2 * q], v[2 * q + 1]);
            *(u32x4*)(QKP + (size_t)(row0 + r) * 1024 + ch0) = o;
            if (lat && r + 1 < RUN) {
#pragma unroll
                for (int e = 0; e < 8; ++e) { const float c2 = cc[e] * cst[e] - ss[e] * sst[e], s2 = ss[e] * cst[e] + cc[e] * sst[e]; cc[e] = c2; ss[e] = s2; }
            }
        }
    }
}

constexpr int NA_SLOTS = 11;
constexpr int NA_VR = 0, NA_VC = 90112, NA_KC = 122880, NA_RPB = 155648;
static_assert(NA_RPB + 2048 <= PH_BYTES, "NA LDS");
__device__ __forceinline__ int na_r0(int r) { return r - 4 < 0 ? 0 : (r - 4 > 120 ? 120 : r - 4); }
__device__ __forceinline__ void p3_na(Frame& F, const Args& a) {
    const int w = F.wave, lane = cur_lane(), tid = FTID(F), cg = w & 3, rsel = w >> 2, g = lane >> 4, lq = lane & 15, qp = lq >> 2, pp = lane & 3;
    const bf16* ZA = (const bf16*)(F.ws + WS_ZA); bf16* MIX = (bf16*)(F.ws + WS_MIX);
    LAS unsigned char* VR = F.lds + NA_VR; LAS unsigned char* VC = F.lds + NA_VC; LAS unsigned char* KC = F.lds + NA_KC; LAS float* RPB = (LAS float*)(F.lds + NA_RPB);
    const int cs = cg == 0 ? 0 : (cg == 1 ? 8 : (cg == 2 ? 24 : 32));
    const int qc = 16 * cg + lq, c0q = qc - 8 < 0 ? 0 : (qc - 8 > 48 ? 48 : qc - 8);
    const int sw = (4 * g + qp) & 7;
    unsigned voff[4], koff[2];
#pragma unroll
    for (int dt = 0; dt < 4; ++dt) voff[dt] = (unsigned)((((2 * dt + (pp >> 1)) ^ sw) * 16) + 8 * (pp & 1) + (4 * g + qp) * 128);
#pragma unroll
    for (int kk = 0; kk < 2; ++kk) koff[kk] = (unsigned)(lq * 128 + (((4 * kk + g) ^ ((lq >> 1) & 7)) * 16));
    unsigned cooff[2][4];
#pragma unroll
    for (int tt = 0; tt < 2; ++tt)
#pragma unroll
        for (int j = 0; j < 4; ++j) { const int kc = cs + 16 * tt + 4 * g + j; const bool valid = kc >= c0q && kc < c0q + 16; cooff[tt][j] = (unsigned)((valid ? kc - qc + 15 : 31) * 4); }
    const float CE = 0.125f * 1.4426950408889634f;
    const int sc = tid >> 3, sch = tid & 7;
    for (int su = blockIdx.x; su < 256; su += F.G) {
        const int bh = su >> 2, head = bh & 7, b = bh >> 3, R0 = (su & 3) * 32;
        __syncthreads();
#pragma unroll
        for (int i = 0; i < 4; ++i) { const int idx = tid + 512 * i, key = idx >> 3, ch = idx & 7; const bf16* src = ZA + ((size_t)(ML_ROWS + b * CTXL + key)) * 1536 + head * 64 + ch * 8;
            *(LAS u32x4*)(KC + key * 128 + ((ch ^ ((key >> 1) & 7)) * 16)) = *(const u32x4*)(src + 512);
            *(LAS u32x4*)(VC + key * 128 + ((ch ^ (key & 7)) * 16)) = *(const u32x4*)(src + 1024); }
        if (tid < 480) { const int rw = tid >> 5, co = tid & 31; RPB[tid] = co < 31 ? 8.f * a.in[10][head * 465 + rw * 31 + co] : -1e30f; }
        int hw = na_r0(R0); const int hi0 = na_r0(R0 + 1) + 8;
        for (int rho = hw; rho < hi0; ++rho) *(LAS u32x4*)(VR + ((rho % NA_SLOTS) * 64 + sc) * 128 + ((sch ^ (sc & 7)) * 16)) = *(const u32x4*)(ZA + ((size_t)(b * SEQ + rho * 64 + sc)) * 1536 + 1024 + head * 64 + sch * 8);
        hw = hi0;
        __syncthreads();
        for (int p = 0; p < 16; ++p) {
            const int ra = R0 + 2 * p, r = ra + rsel, r0 = na_r0(r);
            const int nhi = p < 15 ? na_r0(ra + 3) + 8 : hw, nnew = nhi - hw;
            u32x4 pre0 = (u32x4){0u, 0u, 0u, 0u}, pre1 = pre0;
            if (nnew > 0) pre0 = *(const u32x4*)(ZA + ((size_t)(b * SEQ + hw * 64 + sc)) * 1536 + 1024 + head * 64 + sch * 8);
            if (nnew > 1) pre1 = *(const u32x4*)(ZA + ((size_t)(b * SEQ + (hw + 1) * 64 + sc)) * 1536 + 1024 + head * 64 + sch * 8);
            const size_t qtok = (size_t)b * SEQ + r * 64 + qc;
            bf16x8 qf[2];
#pragma unroll
            for (int kk = 0; kk < 2; ++kk) qf[kk] = *(const bf16x8*)(ZA + qtok * 1536 + head * 64 + 32 * kk + 8 * g);
            f32x4 o[4];
#pragma unroll
            for (int dt = 0; dt < 4; ++dt) o[dt] = (f32x4){0.f, 0.f, 0.f, 0.f};
            float nm;
            {
                f32x4 t4[4];
#pragma unroll
                for (int t = 0; t < 4; ++t) { f32x4 acc = (f32x4){0.f, 0.f, 0.f, 0.f};
                    acc = __builtin_amdgcn_mfma_f32_16x16x32_bf16(*(const LAS bf16x8*)(KC + t * 2048 + koff[0]), qf[0], acc, 0, 0, 0);
                    acc = __builtin_amdgcn_mfma_f32_16x16x32_bf16(*(const LAS bf16x8*)(KC + t * 2048 + koff[1]), qf[1], acc, 0, 0, 0); t4[t] = acc; }
                float mx = fmaxf(fmaxf(fmaxf(t4[0][0], t4[0][1]), fmaxf(t4[0][2], t4[0][3])), fmaxf(fmaxf(t4[1][0], t4[1][1]), fmaxf(t4[1][2], t4[1][3])));
                mx = fmaxf(mx, fmaxf(fmaxf(fmaxf(t4[2][0], t4[2][1]), fmaxf(t4[2][2], t4[2][3])), fmaxf(fmaxf(t4[3][0], t4[3][1]), fmaxf(t4[3][2], t4[3][3]))));
                mx = fmaxf(mx, __shfl_xor(mx, 16)); mx = fmaxf(mx, __shfl_xor(mx, 32));
                nm = -mx * CE;
            }
            float sum = 0.f;
#define NA_EXP(x) __builtin_amdgcn_exp2f(fminf(__builtin_fmaf((x), CE, nm), 126.f))
            {
                bf16x8 kf[2][2];
#pragma unroll
                for (int u2 = 0; u2 < 2; ++u2) { kf[u2][0] = *(const LAS bf16x8*)(KC + u2 * 2048 + koff[0]); kf[u2][1] = *(const LAS bf16x8*)(KC + u2 * 2048 + koff[1]); }
                f32x4 scn[2];
#pragma unroll
                for (int u2 = 0; u2 < 2; ++u2) { f32x4 acc = (f32x4){0.f, 0.f, 0.f, 0.f}; acc = __builtin_amdgcn_mfma_f32_16x16x32_bf16(kf[u2][0], qf[0], acc, 0, 0, 0); scn[u2] = __builtin_amdgcn_mfma_f32_16x16x32_bf16(kf[u2][1], qf[1], acc, 0, 0, 0); }
#pragma unroll
                for (int u2 = 0; u2 < 2; ++u2) { kf[u2][0] = *(const LAS bf16x8*)(KC + (2 + u2) * 2048 + koff[0]); kf[u2][1] = *(const LAS bf16x8*)(KC + (2 + u2) * 2048 + koff[1]); }
                bf16x4 va[4][2];
#pragma unroll
                for (int dt = 0; dt < 4; ++dt) { va[dt][0] = tr_read(VC + voff[dt]); va[dt][1] = tr_read(VC + 2048 + voff[dt]); }
#pragma unroll
                for (int kp = 0; kp < 8; ++kp) {
                    const f32x4 sc0 = scn[0], sc1 = scn[1];
                    __builtin_amdgcn_sched_barrier(0);
                    if (kp < 7) {
#pragma unroll
                        for (int u2 = 0; u2 < 2; ++u2) { f32x4 acc = (f32x4){0.f, 0.f, 0.f, 0.f}; acc = __builtin_amdgcn_mfma_f32_16x16x32_bf16(kf[u2][0], qf[0], acc, 0, 0, 0); scn[u2] = __builtin_amdgcn_mfma_f32_16x16x32_bf16(kf[u2][1], qf[1], acc, 0, 0, 0); } }
                    __builtin_amdgcn_sched_barrier(0);
                    bf16x4 vn[4][2];
#pragma unroll
                    for (int dt = 0; dt < 4; ++dt) { vn[dt][0] = va[dt][0]; vn[dt][1] = va[dt][1]; }
                    if (kp < 6) {
#pragma unroll
                        for (int u2 = 0; u2 < 2; ++u2) { kf[u2][0] = *(const LAS bf16x8*)(KC + (2 * kp + 4 + u2) * 2048 + koff[0]); kf[u2][1] = *(const LAS bf16x8*)(KC + (2 * kp + 4 + u2) * 2048 + koff[1]); } }
                    if (kp < 7) {
#pragma unroll
                        for (int dt = 0; dt < 4; ++dt) { vn[dt][0] = tr_read(VC + (kp + 1) * 4096 + voff[dt]); vn[dt][1] = tr_read(VC + (kp + 1) * 4096 + 2048 + voff[dt]); } }
                    __builtin_amdgcn_sched_barrier(0);
                    float p[8];
#pragma unroll
                    for (int j = 0; j < 4; ++j) { p[j] = NA_EXP(sc0[j]); p[4 + j] = NA_EXP(sc1[j]); }
                    sum += ((p[0] + p[1]) + (p[2] + p[3])) + ((p[4] + p[5]) + (p[6] + p[7]));
                    const bf16x8 pf = as_bf16x8((u32x4){cvt_pk_bf16(p[0], p[1]), cvt_pk_bf16(p[2], p[3]), cvt_pk_bf16(p[4], p[5]), cvt_pk_bf16(p[6], p[7])});
#pragma unroll
                    for (int dt = 0; dt < 4; ++dt) o[dt] = __builtin_amdgcn_mfma_f32_16x16x32_bf16(cat4(va[dt][0], va[dt][1]), pf, o[dt], 0, 0, 0);
                    __builtin_amdgcn_sched_barrier(0);
#pragma unroll
                    for (int dt = 0; dt < 4; ++dt) { va[dt][0] = vn[dt][0]; va[dt][1] = vn[dt][1]; }
                }
            }
            {
                const bf16* kbase = ZA + ((size_t)b * SEQ + r0 * 64 + cs + lq) * 1536 + 512 + head * 64 + 8 * g;
                bf16x8 k0[2][2], kc[2][2], kn[2][2];
#pragma unroll
                for (int tt = 0; tt < 2; ++tt) { k0[tt][0] = *(const bf16x8*)(kbase + (size_t)tt * 16 * 1536); k0[tt][1] = *(const bf16x8*)(kbase + (size_t)tt * 16 * 1536 + 32); }
#pragma unroll
                for (int tt = 0; tt < 2; ++tt) { kc[tt][0] = *(const bf16x8*)(kbase + (size_t)(64 + tt * 16) * 1536); kc[tt][1] = *(const bf16x8*)(kbase + (size_t)(64 + tt * 16) * 1536 + 32); }
#pragma unroll
                for (int tt = 0; tt < 2; ++tt) { kn[tt][0] = *(const bf16x8*)(kbase + (size_t)(128 + tt * 16) * 1536); kn[tt][1] = *(const bf16x8*)(kbase + (size_t)(128 + tt * 16) * 1536 + 32); }
                f32x4 scn[2];
                { const LAS unsigned char* rb = (const LAS unsigned char*)RPB + (r0 - r + 7) * 128;
#pragma unroll
                  for (int tt = 0; tt < 2; ++tt) { f32x4 acc;
#pragma unroll
                      for (int j = 0; j < 4; ++j) acc[j] = *(const LAS float*)(rb + cooff[tt][j]);
                      acc = __builtin_amdgcn_mfma_f32_16x16x32_bf16(k0[tt][0], qf[0], acc, 0, 0, 0); scn[tt] = __builtin_amdgcn_mfma_f32_16x16x32_bf16(k0[tt][1], qf[1], acc, 0, 0, 0); } }
                int slot = r0 % NA_SLOTS;
                bf16x4 va[4][2];
                { const LAS unsigned char* vr = VR + (slot * 64 + cs) * 128;
#pragma unroll
                  for (int dt = 0; dt < 4; ++dt) { va[dt][0] = tr_read(vr + voff[dt]); va[dt][1] = tr_read(vr + 2048 + voff[dt]); } }
#pragma unroll
                for (int rr = 0; rr < 8; ++rr) {
                    const f32x4 sc0 = scn[0], sc1 = scn[1];
                    bf16x8 kx[2][2];
#pragma unroll
                    for (int tt = 0; tt < 2; ++tt) { kx[tt][0] = kn[tt][0]; kx[tt][1] = kn[tt][1]; }
                    if (rr < 5) {
#pragma unroll
                        for (int tt = 0; tt < 2; ++tt) { kx[tt][0] = *(const bf16x8*)(kbase + (size_t)((rr + 3) * 64 + tt * 16) * 1536); kx[tt][1] = *(const bf16x8*)(kbase + (size_t)((rr + 3) * 64 + tt * 16) * 1536 + 32); } }
                    f32x4 ini[2];
                    if (rr < 7) { const LAS unsigned char* rb = (const LAS unsigned char*)RPB + (r0 + rr + 1 - r + 7) * 128;
#pragma unroll
                        for (int tt = 0; tt < 2; ++tt)
#pragma unroll
                            for (int j = 0; j < 4; ++j) ini[tt][j] = *(const LAS float*)(rb + cooff[tt][j]); }
                    slot = slot == NA_SLOTS - 1 ? 0 : slot + 1;
                    bf16x4 vn[4][2];
#pragma unroll
                    for (int dt = 0; dt < 4; ++dt) { vn[dt][0] = va[dt][0]; vn[dt][1] = va[dt][1]; }
                    if (rr < 7) { const LAS unsigned char* vx = VR + (slot * 64 + cs) * 128;
#pragma unroll
                        for (int dt = 0; dt < 4; ++dt) { vn[dt][0] = tr_read(vx + voff[dt]); vn[dt][1] = tr_read(vx + 2048 + voff[dt]); } }
                    __builtin_amdgcn_sched_barrier(0);
                    if (rr < 7) {
#pragma unroll
                        for (int tt = 0; tt < 2; ++tt) { f32x4 acc = ini[tt]; acc = __builtin_amdgcn_mfma_f32_16x16x32_bf16(kc[tt][0], qf[0], acc, 0, 0, 0); scn[tt] = __builtin_amdgcn_mfma_f32_16x16x32_bf16(kc[tt][1], qf[1], acc, 0, 0, 0); } }
                    __builtin_amdgcn_sched_barrier(0);
                    float p[8];
#pragma unroll
                    for (int j = 0; j < 4; ++j) { p[j] = NA_EXP(sc0[j]); p[4 + j] = NA_EXP(sc1[j]); }
                    sum += ((p[0] + p[1]) + (p[2] + p[3])) + ((p[4] + p[5]) + (p[6] + p[7]));
                    const bf16x8 pf = as_bf16x8((u32x4){cvt_pk_bf16(p[0], p[1]), cvt_pk_bf16(p[2], p[3]), cvt_pk_bf16(p[4], p[5]), cvt_pk_bf16(p[6], p[7])});
#pragma unroll
                    for (int dt = 0; dt < 4; ++dt) o[dt] = __builtin_amdgcn_mfma_f32_16x16x32_bf16(cat4(va[dt][0], va[dt][1]), pf, o[dt], 0, 0, 0);
                    __builtin_amdgcn_sched_barrier(0);
#pragma unroll
                    for (int dt = 0; dt < 4; ++dt) { va[dt][0] = vn[dt][0]; va[dt][1] = vn[dt][1]; }
#pragma unroll
                    for (int tt = 0; tt < 2; ++tt) { kc[tt][0] = kn[tt][0]; kc[tt][1] = kn[tt][1]; kn[tt][0] = kx[tt][0]; kn[tt][1] = kx[tt][1]; }
                }
            }
#undef NA_EXP
            sum += __shfl_xor(sum, 16); sum += __shfl_xor(sum, 32);
            { const float inv = 1.f / sum; bf16* op = MIX + qtok * 1024 + head * 64 + 4 * g;
#pragma unroll
              for (int dt = 0; dt < 4; ++dt) *(u32x2*)(op + 16 * dt) = (u32x2){cvt_pk_bf16(o[dt][0] * inv, o[dt][1] * inv), cvt_pk_bf16(o[dt][2] * inv, o[dt][3] * inv)}; }
            if (nnew > 0) *(LAS u32x4*)(VR + ((hw % NA_SLOTS) * 64 + sc) * 128 + ((sch ^ (sc & 7)) * 16)) = pre0;
            if (nnew > 1) *(LAS u32x4*)(VR + (((hw + 1) % NA_SLOTS) * 64 + sc) * 128 + ((sch ^ (sc & 7)) * 16)) = pre1;
            hw = nhi;
            __syncthreads();
        }
    }
    __syncthreads();
}

typedef float f32x16 __attribute__((ext_vector_type(16)));
constexpr int M2_QS = 0, M2_KS = 34816, M2_CT = 69632, M2_VS = 104448, M2_VEC = 145408;
constexpr int M2_RS = 272, M2_VR = 320;
static_assert(M2_VEC + 1040 * 4 <= PH_BYTES, "mLSTM LDS");
constexpr int REC_N = 16384, REC_S = 16512;
template <bool OUT>
__device__ __forceinline__ void mlstm_unit(Frame& F, const Args& a, const int sc, const int grp  , const bool FINAL) {
    const int w = F.wave, tid0 = opaque(FTID(F));
    int tid = tid0, lane = tid & 63, ln = lane & 31, h = lane >> 5, q4 = (lane & 15) >> 2, p4 = lane & 3, blk = (lane >> 4) & 1;
    const int dir = sc & 1, head = (sc >> 1) & 3, b = sc >> 3;
    const bf16* QKP = (const bf16*)(F.ws + WS_XM); const bf16* ZV = (const bf16*)(F.ws + WS_ZV); const float* GT = (const float*)(F.ws + WS_GATES);
    bf16* HB = (bf16*)(F.ws + WS_HB);
    float* REC = (float*)(F.ws + WS_MLST) + (size_t)sc * 9 * REC_FLOATS;
    LAS unsigned char* QS = F.lds + M2_QS; LAS unsigned char* KS = F.lds + M2_KS; LAS unsigned char* CT = F.lds + M2_CT; LAS unsigned char* VS = F.lds + M2_VS;
    LAS float* Va = (LAS float*)(F.lds + M2_VEC); LAS float* VA = Va + 128; LAS float* Vem = Va + 256; LAS float* Vin = Va + 384; LAS float* Vw = Va + 512; LAS float* Vn = Va + 640; LAS float* Vx = Va + 768; LAS float* Vs = Va + 1024;
    const int nch = grp < 0 ? 2 : 8;
    const int T = grp < 0 ? CTXL : SEQ;
    const size_t rowbase = grp < 0 ? (size_t)ML_ROWS + b * CTXL : (size_t)b * SEQ;
    const int sig0 = grp < 0 ? 0 : grp * 1024;
    const int tb = (int)((0x12032130u >> (4 * w)) & 3u), vh = w >> 2, db = w & 3;
    int trn = (8 * h + q4) * M2_VR + (16 * blk + 4 * p4) * 2;
    int trp = (4 * h + q4) * M2_VR + (16 * blk + 4 * p4) * 2;
    int trk = (8 * h + q4) * M2_RS + (16 * blk + 4 * p4) * 2;
    const bool nown = (vh == 0) && ((tid0 & 32) == 0);
    f32x16 Cacc[2]; float nreg = 0.f;
#pragma unroll
    for (int i = 0; i < 2; ++i)
#pragma unroll
        for (int r = 0; r < 16; ++r) Cacc[i][r] = 0.f;
    float m_prev = (grp < 0) ? 0.f : -1e30f, bsum = 0.f;
    if constexpr (OUT) {
        const float* R0 = REC;
        m_prev = R0[REC_S];
#pragma unroll
        for (int i = 0; i < 2; ++i)
#pragma unroll
            for (int qd = 0; qd < 4; ++qd) { const f32x4 t4 = *(const f32x4*)(R0 + (32 * (2 * vh + i) + ln) * 128 + 32 * db + 8 * qd + 4 * h);
                Cacc[i][4 * qd] = t4.x; Cacc[i][4 * qd + 1] = t4.y; Cacc[i][4 * qd + 2] = t4.z; Cacc[i][4 * qd + 3] = t4.w; }
        nreg = R0[REC_N + 32 * db + ln];
        for (int j = 0; j < grp; ++j) { const float* R = REC + (size_t)(1 + j) * REC_FLOATS; const float mj = R[REC_S], Bj = R[REC_S + 1];
            const float mn = fmaxf(Bj + m_prev, mj), f = __expf(Bj + m_prev - mn), gc = __expf(mj - mn);
#pragma unroll
            for (int i = 0; i < 2; ++i)
#pragma unroll
                for (int qd = 0; qd < 4; ++qd) { const f32x4 t4 = *(const f32x4*)(R + (32 * (2 * vh + i) + ln) * 128 + 32 * db + 8 * qd + 4 * h);
                    Cacc[i][4 * qd] = Cacc[i][4 * qd] * f + t4.x * gc; Cacc[i][4 * qd + 1] = Cacc[i][4 * qd + 1] * f + t4.y * gc; Cacc[i][4 * qd + 2] = Cacc[i][4 * qd + 2] * f + t4.z * gc; Cacc[i][4 * qd + 3] = Cacc[i][4 * qd + 3] * f + t4.w * gc; }
            nreg = nreg * f + R[REC_N + 32 * db + ln] * gc;
            m_prev = mn; }
    }
    __syncthreads();
    if constexpr (OUT) {
#pragma unroll
        for (int i = 0; i < 2; ++i)
#pragma unroll
            for (int qd = 0; qd < 4; ++qd) *(LAS u32x2*)(CT + (32 * (2 * vh + i) + ln) * M2_RS + (32 * db + 8 * qd + 4 * h) * 2) = (u32x2){cvt_pk_bf16(Cacc[i][4 * qd], Cacc[i][4 * qd + 1]), cvt_pk_bf16(Cacc[i][4 * qd + 2], Cacc[i][4 * qd + 3])};
        if (nown) Vn[32 * db + ln] = nreg;
    }
    u32x4 pq[4], pk[4], pv[4]; float gi0 = 0.f, gi1 = 0.f, gf0 = 0.f, gf1 = 0.f;
    const int gcol_i = (2 * dir) * 4 + head, gcol_f = (2 * dir + 1) * 4 + head;
#define ML_TOK(sig) (dir ? (T - 1 - (sig)) : (sig))
#define ML_LOAD(k) do { _Pragma("unroll") for (int j = 0; j < 4; ++j) { const int id = tid + 512 * j, row = id >> 4, ch = id & 15; const size_t gr = rowbase + ML_TOK(sig0 + (k) * 128 + row); \
            if (OUT) pq[j] = *(const u32x4*)(QKP + gr * 1024 + head * 128 + ch * 8); \
            pk[j] = *(const u32x4*)(QKP + gr * 1024 + 512 + head * 128 + ch * 8); pv[j] = *(const u32x4*)(ZV + gr * 512 + head * 128 + ch * 8); } \
        if (w == 0) { const size_t g0 = rowbase + ML_TOK(sig0 + (k) * 128 + 2 * lane), g1 = rowbase + ML_TOK(sig0 + (k) * 128 + 2 * lane + 1); \
            gi0 = GT[g0 * 16 + gcol_i]; gf0 = GT[g0 * 16 + gcol_f]; gi1 = GT[g1 * 16 + gcol_i]; gf1 = GT[g1 * 16 + gcol_f]; } } while (0)
    ML_LOAD(0);
    for (int k = 0; k < nch; ++k) {
        { const int z = *(volatile LAS int*)(F.lds + MISC_OFF + 48);
          tid = tid0 + z; lane = tid & 63; ln = lane & 31; h = lane >> 5; q4 = (lane & 15) >> 2; p4 = lane & 3; blk = (lane >> 4) & 1;
          trn = (8 * h + q4) * M2_VR + (16 * blk + 4 * p4) * 2; trp = (4 * h + q4) * M2_VR + (16 * blk + 4 * p4) * 2; trk = (8 * h + q4) * M2_RS + (16 * blk + 4 * p4) * 2; }
#pragma unroll
        for (int j = 0; j < 4; ++j) { const int id = tid + 512 * j, row = id >> 4, ch = id & 15;
            if (OUT) *(LAS u32x4*)(QS + row * M2_RS + ch * 16) = pq[j];
            *(LAS u32x4*)(KS + row * M2_RS + ch * 16) = pk[j]; *(LAS u32x4*)(VS + row * M2_VR + ch * 16) = pv[j]; }
        if (w == 0) {
            const float lf0 = fminf(gf0, 0.f) - log1pf(__expf(-fabsf(gf0))), lf1 = fminf(gf1, 0.f) - log1pf(__expf(-fabsf(gf1)));
            float P = lf0 + lf1;
#pragma unroll
            for (int o = 1; o < 64; o <<= 1) { const float t = __shfl_up(P, o); if (lane >= o) P += t; }
            const float b1 = P, b0 = P - lf1, a0 = gi0 - b0, a1 = gi1 - b1;
            float M = fmaxf(a0, a1);
#pragma unroll
            for (int o = 1; o < 64; o <<= 1) { const float t = __shfl_up(M, o); if (lane >= o) M = fmaxf(M, t); }
            float Mex = __shfl_up(M, 1); if (lane == 0) Mex = -1e30f;
            const float A0 = fmaxf(m_prev, fmaxf(Mex, a0)), A1 = fmaxf(m_prev, M);
            const float Aend = __shfl(A1, 63), bend = __shfl(b1, 63);
            *(LAS f32x2*)(Va + 2 * lane) = (f32x2){a0, a1}; *(LAS f32x2*)(VA + 2 * lane) = (f32x2){A0, A1};
            *(LAS f32x2*)(Vem + 2 * lane) = (f32x2){__expf(-(b0 + A0)), __expf(-(b1 + A1))};
            *(LAS f32x2*)(Vin + 2 * lane) = (f32x2){__expf(m_prev - A0), __expf(m_prev - A1)};
            *(LAS f32x2*)(Vw + 2 * lane) = (f32x2){__expf(a0 - Aend), __expf(a1 - Aend)};
            if (lane == 0) { Vs[0] = __expf(m_prev - Aend); Vs[1] = bend + Aend; Vs[2] = bend; }
        }
        const int knext = k + 1 < nch ? k + 1 : k;
        if constexpr (!OUT) { ML_LOAD(knext); }
        __syncthreads();
        const float decay = __builtin_bit_cast(float, __builtin_amdgcn_readfirstlane(__builtin_bit_cast(int, Vs[0]))), m_new = __builtin_bit_cast(float, __builtin_amdgcn_readfirstlane(__builtin_bit_cast(int, Vs[1])));
        if constexpr (!OUT) bsum += Vs[2];
        if constexpr (OUT) {
            const int t = 32 * tb + ln;
            const LAS unsigned char* qrow = QS + t * M2_RS + 16 * h;
            f32x16 acc[2];
#pragma unroll
            for (int i = 0; i < 2; ++i)
#pragma unroll
                for (int r = 0; r < 16; ++r) acc[i][r] = 0.f;
            const float it = Vin[t], At = VA[t];
            float qn = 0.f;
            {
                const LAS unsigned char* c0p = CT + (32 * (2 * vh) + ln) * M2_RS + 16 * h; const LAS unsigned char* c1p = c0p + 32 * M2_RS; const LAS float* np = Vn + 8 * h;
                bf16x8 qc = *(const LAS bf16x8*)(qrow), c0 = *(const LAS bf16x8*)(c0p), c1 = *(const LAS bf16x8*)(c1p);
#pragma unroll
                for (int ks = 0; ks < 8; ++ks) {
                    bf16x8 qx = qc, x0 = c0, x1 = c1;
                    const f32x4 n0 = *(const LAS f32x4*)(np + 16 * ks), n1 = *(const LAS f32x4*)(np + 16 * ks + 4);
                    if (ks < 7) { qx = *(const LAS bf16x8*)(qrow + 32 * (ks + 1)); x0 = *(const LAS bf16x8*)(c0p + 32 * (ks + 1)); x1 = *(const LAS bf16x8*)(c1p + 32 * (ks + 1)); }
                    __builtin_amdgcn_sched_barrier(0);
                    acc[0] = __builtin_amdgcn_mfma_f32_32x32x16_bf16(c0, qc, acc[0], 0, 0, 0);
                    acc[1] = __builtin_amdgcn_mfma_f32_32x32x16_bf16(c1, qc, acc[1], 0, 0, 0);
                    const u32x4 qu = __builtin_bit_cast(u32x4, qc);
                    qn += bf_lo(qu.x) * n0.x + bf_hi(qu.x) * n0.y + bf_lo(qu.y) * n0.z + bf_hi(qu.y) * n0.w + bf_lo(qu.z) * n1.x + bf_hi(qu.z) * n1.y + bf_lo(qu.w) * n1.z + bf_hi(qu.w) * n1.w;
                    __builtin_amdgcn_sched_barrier(0);
                    qc = qx; c0 = x0; c1 = x1;
                }
            }
#pragma unroll
            for (int i = 0; i < 2; ++i) acc[i] = acc[i] * it;
            float denp = 0.f;
#pragma unroll
            for (int sb = 0; sb < 4; ++sb) {
                if (sb <= tb) {
                    f32x16 sa;
#pragma unroll
                    for (int r = 0; r < 16; ++r) sa[r] = 0.f;
                    {
                        const LAS unsigned char* kp = KS + (32 * sb + ln) * M2_RS + 16 * h;
                        bf16x8 kc = *(const LAS bf16x8*)(kp), qc = *(const LAS bf16x8*)(qrow);
#pragma unroll
                        for (int ks = 0; ks < 8; ++ks) {
                            bf16x8 kx = kc, qx = qc;
                            if (ks < 7) { kx = *(const LAS bf16x8*)(kp + 32 * (ks + 1)); qx = *(const LAS bf16x8*)(qrow + 32 * (ks + 1)); }
                            __builtin_amdgcn_sched_barrier(0);
                            sa = __builtin_amdgcn_mfma_f32_32x32x16_bf16(kc, qc, sa, 0, 0, 0);
                            __builtin_amdgcn_sched_barrier(0);
                            kc = kx; qc = qx;
                        }
                    }
                    const LAS unsigned char* vr = VS + (32 * sb) * M2_VR + trp + 64 * (2 * vh);
                    const bf16x4 va00 = tr_read(vr), va01 = tr_read(vr + 8 * M2_VR), va10 = tr_read(vr + 64), va11 = tr_read(vr + 8 * M2_VR + 64);
                    u32x4 pw[2];
#pragma unroll
                    for (int qd = 0; qd < 4; ++qd) { const f32x4 av = *(const LAS f32x4*)(Va + 32 * sb + 8 * qd + 4 * h); float p[4];
#pragma unroll
                        for (int e = 0; e < 4; ++e) { const int s_ = 32 * sb + 8 * qd + 4 * h + e; p[e] = (s_ <= t) ? sa[4 * qd + e] * __expf(av[e] - At) : 0.f; denp += p[e]; }
                        pw[qd >> 1][2 * (qd & 1)] = cvt_pk_bf16(p[0], p[1]); pw[qd >> 1][2 * (qd & 1) + 1] = cvt_pk_bf16(p[2], p[3]); }
                    { const bf16x8 pf0 = as_bf16x8(pw[0]), pf1 = as_bf16x8(pw[1]);
                      const bf16x4 vb00 = tr_read(vr + 16 * M2_VR), vb01 = tr_read(vr + 24 * M2_VR), vb10 = tr_read(vr + 16 * M2_VR + 64), vb11 = tr_read(vr + 24 * M2_VR + 64);
                      __builtin_amdgcn_sched_barrier(0);
                      acc[0] = __builtin_amdgcn_mfma_f32_32x32x16_bf16(cat4(va00, va01), pf0, acc[0], 0, 0, 0);
                      acc[1] = __builtin_amdgcn_mfma_f32_32x32x16_bf16(cat4(va10, va11), pf0, acc[1], 0, 0, 0);
                      acc[0] = __builtin_amdgcn_mfma_f32_32x32x16_bf16(cat4(vb00, vb01), pf1, acc[0], 0, 0, 0);
                      acc[1] = __builtin_amdgcn_mfma_f32_32x32x16_bf16(cat4(vb10, vb11), pf1, acc[1], 0, 0, 0); }
                }
            }
            denp += __shfl_xor(denp, 32); qn += __shfl_xor(qn, 32);
            const float den = denp + it * qn;
            const float rd = 1.f / fmaxf(fabsf(den), Vem[t]);
            const size_t orow = rowbase + ML_TOK(sig0 + k * 128 + t);
            if (!FINAL) {
#pragma unroll
                for (int i = 0; i < 2; ++i) { bf16* hp = HB + orow * 512 + head * 128 + 32 * (2 * vh + i) + 4 * h;
#pragma unroll
                    for (int qd = 0; qd < 4; ++qd) *(u32x2*)(hp + 8 * qd) = (u32x2){cvt_pk_bf16(acc[i][4 * qd] * rd, acc[i][4 * qd + 1] * rd), cvt_pk_bf16(acc[i][4 * qd + 2] * rd, acc[i][4 * qd + 3] * rd)}; }
            } else {
                float ss = 0.f;
#pragma unroll
                for (int i = 0; i < 2; ++i) { const bf16* hp = HB + orow * 512 + head * 128 + 32 * (2 * vh + i) + 4 * h;
#pragma unroll
                    for (int qd = 0; qd < 4; ++qd) { const u32x2 hf = *(const u32x2*)(hp + 8 * qd);
                        acc[i][4 * qd] = acc[i][4 * qd] * rd + bf_lo(hf.x); acc[i][4 * qd + 1] = acc[i][4 * qd + 1] * rd + bf_hi(hf.x); acc[i][4 * qd + 2] = acc[i][4 * qd + 2] * rd + bf_lo(hf.y); acc[i][4 * qd + 3] = acc[i][4 * qd + 3] * rd + bf_hi(hf.y);
                        ss += (acc[i][4 * qd] * acc[i][4 * qd] + acc[i][4 * qd + 1] * acc[i][4 * qd + 1]) + (acc[i][4 * qd + 2] * acc[i][4 * qd + 2] + acc[i][4 * qd + 3] * acc[i][4 * qd + 3]); }
                    asm volatile("" ::: "memory"); }
                ss += __shfl_xor(ss, 32);
                if (h == 0) Vx[vh * 128 + t] = ss;
                __syncthreads();
                const float rs = 1.f / sqrtf((ss + Vx[(1 - vh) * 128 + t]) * (1.f / 128.f) + LN_EPS);
#pragma unroll
                for (int i = 0; i < 2; ++i) { const int c0 = head * 128 + 32 * (2 * vh + i) + 4 * h;
                    const bf16* zo = (const bf16*)(F.ws + WS_ZO) + orow * 512 + c0; const float* gn = a.in[11] + c0; bf16* mp = (bf16*)(F.ws + WS_MIX) + orow * 1024 + 512 + c0;
#pragma unroll
                    for (int qd = 0; qd < 4; ++qd) { const u32x2 zz = *(const u32x2*)(zo + 8 * qd); const f32x4 gg = *(const f32x4*)(gn + 8 * qd);
                        const float o0 = acc[i][4 * qd] * rs * gg[0] / (1.f + __expf(-bf_lo(zz.x))), o1 = acc[i][4 * qd + 1] * rs * gg[1] / (1.f + __expf(-bf_hi(zz.x)));
                        const float o2 = acc[i][4 * qd + 2] * rs * gg[2] / (1.f + __expf(-bf_lo(zz.y))), o3 = acc[i][4 * qd + 3] * rs * gg[3] / (1.f + __expf(-bf_hi(zz.y)));
                        *(u32x2*)(mp + 8 * qd) = (u32x2){cvt_pk_bf16(o0, o1), cvt_pk_bf16(o2, o3)};
                        if (qd & 1) asm volatile("" ::: "memory"); } }
            }
        }
        if constexpr (OUT) { ML_LOAD(knext); }
#pragma unroll
        for (int i = 0; i < 2; ++i) Cacc[i] = Cacc[i] * decay;
        float npart = 0.f;
        {
            const LAS unsigned char* kr = KS + trk + 64 * db; const LAS unsigned char* vr = VS + trn + 64 * (2 * vh); const LAS float* wp = Vw + 8 * h;
            bf16x4 k0 = tr_read(kr), k1 = tr_read(kr + 4 * M2_RS), v00 = tr_read(vr), v01 = tr_read(vr + 4 * M2_VR), v10 = tr_read(vr + 64), v11 = tr_read(vr + 4 * M2_VR + 64);
            f32x4 w0 = *(const LAS f32x4*)(wp), w1 = *(const LAS f32x4*)(wp + 4);
#pragma unroll
            for (int ks = 0; ks < 8; ++ks) {
                bf16x4 k0x = k0, k1x = k1, v00x = v00, v01x = v01, v10x = v10, v11x = v11; f32x4 w0x = w0, w1x = w1;
                if (ks < 7) { const LAS unsigned char* kn = kr + 16 * (ks + 1) * M2_RS; const LAS unsigned char* vn = vr + 16 * (ks + 1) * M2_VR;
                    k0x = tr_read(kn); k1x = tr_read(kn + 4 * M2_RS); v00x = tr_read(vn); v01x = tr_read(vn + 4 * M2_VR); v10x = tr_read(vn + 64); v11x = tr_read(vn + 4 * M2_VR + 64);
                    w0x = *(const LAS f32x4*)(wp + 16 * (ks + 1)); w1x = *(const LAS f32x4*)(wp + 16 * (ks + 1) + 4); }
                __builtin_amdgcn_sched_barrier(0);
                const u32x2 ku0 = __builtin_bit_cast(u32x2, k0), ku1 = __builtin_bit_cast(u32x2, k1);
                const float x0 = bf_lo(ku0.x) * w0[0], x1 = bf_hi(ku0.x) * w0[1], x2 = bf_lo(ku0.y) * w0[2], x3 = bf_hi(ku0.y) * w0[3];
                const float x4 = bf_lo(ku1.x) * w1[0], x5 = bf_hi(ku1.x) * w1[1], x6 = bf_lo(ku1.y) * w1[2], x7 = bf_hi(ku1.y) * w1[3];
                npart += ((x0 + x1) + (x2 + x3)) + ((x4 + x5) + (x6 + x7));
                const bf16x8 kf = as_bf16x8((u32x4){cvt_pk_bf16(x0, x1), cvt_pk_bf16(x2, x3), cvt_pk_bf16(x4, x5), cvt_pk_bf16(x6, x7)});
                Cacc[0] = __builtin_amdgcn_mfma_f32_32x32x16_bf16(kf, cat4(v00, v01), Cacc[0], 0, 0, 0);
                Cacc[1] = __builtin_amdgcn_mfma_f32_32x32x16_bf16(kf, cat4(v10, v11), Cacc[1], 0, 0, 0);
                __builtin_amdgcn_sched_barrier(0);
                k0 = k0x; k1 = k1x; v00 = v00x; v01 = v01x; v10 = v10x; v11 = v11x; w0 = w0x; w1 = w1x;
            }
        }
        npart += __shfl_xor(npart, 32);
        nreg = nreg * decay + npart;
        m_prev = m_new;
        __syncthreads();
        if constexpr (OUT) {
#pragma unroll
            for (int i = 0; i < 2; ++i)
#pragma unroll
                for (int qd = 0; qd < 4; ++qd) *(LAS u32x2*)(CT + (32 * (2 * vh + i) + ln) * M2_RS + (32 * db + 8 * qd + 4 * h) * 2) = (u32x2){cvt_pk_bf16(Cacc[i][4 * qd], Cacc[i][4 * qd + 1]), cvt_pk_bf16(Cacc[i][4 * qd + 2], Cacc[i][4 * qd + 3])};
            if (nown) Vn[32 * db + ln] = nreg;
        }
    }
#undef ML_LOAD
#undef ML_TOK
    if (OUT && !FINAL) { VM_WAIT(); __syncthreads(); }
    if constexpr (!OUT) {
        float* R = REC + (size_t)(grp < 0 ? 0 : 1 + grp) * REC_FLOATS;
#pragma unroll
        for (int i = 0; i < 2; ++i)
#pragma unroll
            for (int qd = 0; qd < 4; ++qd) *(f32x4*)(R + (32 * (2 * vh + i) + ln) * 128 + 32 * db + 8 * qd + 4 * h) = (f32x4){Cacc[i][4 * qd], Cacc[i][4 * qd + 1], Cacc[i][4 * qd + 2], Cacc[i][4 * qd + 3]};
        if (nown) R[REC_N + 32 * db + ln] = nreg;
        if (tid == 0) { R[REC_S] = m_prev; R[REC_S + 1] = bsum; }
    }
}

__device__ __forceinline__ void p6_readout(Frame& F, const Args& a) {
    const int gw = F.vcu * 8 + F.wave, NGW = F.G * 8, lane = cur_lane();
    const bf16* HB0 = (const bf16*)(F.ws + WS_HB); const bf16* HB1 = HB0 + (size_t)ML_ROWS * 512; const bf16* ZO = (const bf16*)(F.ws + WS_ZO);
    bf16* MIX = (bf16*)(F.ws + WS_MIX);
    const f32x4 g0 = *(const f32x4*)(a.in[11] + 8 * lane), g1 = *(const f32x4*)(a.in[11] + 8 * lane + 4);
    for (int m = gw; m < ML_ROWS; m += NGW) {
        const u32x4 hf = *(const u32x4*)(HB0 + (size_t)m * 512 + 8 * lane), hb = *(const u32x4*)(HB1 + (size_t)m * 512 + 8 * lane), zo = *(const u32x4*)(ZO + (size_t)m * 512 + 8 * lane);
        float h[8]; float ss = 0.f;
#pragma unroll
        for (int q = 0; q < 4; ++q) { h[2 * q] = bf_lo(hf[q]) + bf_lo(hb[q]); h[2 * q + 1] = bf_hi(hf[q]) + bf_hi(hb[q]); ss += h[2 * q] * h[2 * q] + h[2 * q + 1] * h[2 * q + 1]; }
        ss += __shfl_xor(ss, 1); ss += __shfl_xor(ss, 2); ss += __shfl_xor(ss, 4); ss += __shfl_xor(ss, 8);
        const float rs = 1.f / sqrtf(ss * (1.f / 128.f) + LN_EPS);
        float o[8];
#pragma unroll
        for (int q = 0; q < 4; ++q) { const float z0 = bf_lo(zo[q]), z1 = bf_hi(zo[q]);
            o[2 * q] = h[2 * q] * rs * (q < 2 ? g0[2 * q] : g1[2 * q - 4]) / (1.f + __expf(-z0));
            o[2 * q + 1] = h[2 * q + 1] * rs * (q < 2 ? g0[2 * q + 1] : g1[2 * q - 3]) / (1.f + __expf(-z1)); }
        *(u32x4*)(MIX + (size_t)m * 1024 + 512 + 8 * lane) = (u32x4){cvt_pk_bf16(o[0], o[1]), cvt_pk_bf16(o[2], o[3]), cvt_pk_bf16(o[4], o[5]), cvt_pk_bf16(o[6], o[7])};
    }
}

struct EpiY1 {
    static constexpr bool PERM = true;
    const float* x; const float* ada; bf16* y1;
    __device__ __forceinline__ void operator()(const f32x4 (&acc)[2][2][4][2], const pg8::Unit& u, int wr, int wc, int fr, int fq) const {
        const int row0 = u.pm * 256 + wr * 64 + fr, col0 = u.pn * 256 + wc * 32 + 8 * fq;
        const float* g1 = ada + (size_t)(u.pm >> 5) * 6144 + 2048;
        f32x4 gv[2][2];
#pragma unroll
        for (int bj = 0; bj < 2; ++bj)
#pragma unroll
            for (int n = 0; n < 2; ++n) gv[bj][n] = *(const f32x4*)(g1 + col0 + bj * 128 + 4 * n);
#pragma unroll
        for (int ai = 0; ai < 2; ++ai)
#pragma unroll
            for (int m = 0; m < 4; ++m) { const size_t off = (size_t)(row0 + ai * 128 + m * 16) * 1024 + col0;
#pragma unroll
                for (int bj = 0; bj < 2; ++bj) { const f32x4 x0 = *(const f32x4*)(x + off + bj * 128), x1 = *(const f32x4*)(x + off + bj * 128 + 4);
                    const f32x4 v0 = x0 * DN_ALPHA + gv[bj][0] * acc[ai][bj][m][0], v1 = x1 * DN_ALPHA + gv[bj][1] * acc[ai][bj][m][1];
                    *(u32x4*)(y1 + off + bj * 128) = (u32x4){cvt_pk_bf16(v0[0], v0[1]), cvt_pk_bf16(v0[2], v0[3]), cvt_pk_bf16(v1[0], v1[1]), cvt_pk_bf16(v1[2], v1[3])}; } }
    }
};

constexpr int P8_LG = 0;
constexpr int P8_REC = 81920;
__device__ __forceinline__ void p8_mid(Frame& F, const Args& a) {
    const int gw = F.vcu * 8 + F.wave, NGW = F.G * 8, lane = opaque(cur_lane()), tid = FTID(F), g = lane >> 4, lq = lane & 15;
    bf16* Y1 = (bf16*)(F.ws + WS_Y1); bf16* XM2 = (bf16*)(F.ws + WS_XM2);
    const float* ada = (const float*)(F.ws + WS_ADA); const bf16* WR = (const bf16*)(F.ws + WS_WR);
    LAS float* lg = (LAS float*)(F.lds + P8_LG) + F.wave * 2560;
    LAS unsigned* rec = (LAS unsigned*)(F.lds + P8_REC);
    LAS int* hist = (LAS int*)(F.lds + MISC_OFF + MS_HIST); LAS int* base = (LAS int*)(F.lds + MISC_OFF + MS_BASE);
    LAS float* rbias = (LAS float*)(F.lds + P8_REC + 16384);
    if (tid < 64) hist[tid] = 0;
    if (tid < 72) rbias[tid] = tid < 8 ? a.in[16][tid] : a.in[18][tid - 8];
    __syncthreads();
    const f32x4 l1g[4] = {((const f32x4*)a.in[13])[lane], ((const f32x4*)a.in[13])[lane + 64], ((const f32x4*)a.in[13])[lane + 128], ((const f32x4*)a.in[13])[lane + 192]};
    const f32x4 l1b[4] = {((const f32x4*)a.in[14])[lane], ((const f32x4*)a.in[14])[lane + 64], ((const f32x4*)a.in[14])[lane + 128], ((const f32x4*)a.in[14])[lane + 192]};
    const int NT16 = ML_ROWS / 16;
    int nloc = 0;
    for (int wt = gw; wt < NT16; wt += 2 * NGW, nloc += 2) {
        const bool two = wt + NGW < NT16;
        const int rowA = wt * 16, rowB = two ? (wt + NGW) * 16 : rowA;
        for (int rr = 0; rr < (two ? 32 : 16); rr += 4) {
            const int rowbase = (rr < 16 ? rowA : rowB) + (rr & 15);
            const float* sh2 = ada + (size_t)(rowbase >> 13) * 6144 + 3072; const float* sc2 = sh2 + 1024;
            f32x4 v[4][4]; float sm[4];
#pragma unroll
            for (int r = 0; r < 4; ++r) { const u32x2* yr = (const u32x2*)(Y1 + (size_t)(rowbase + r) * 1024) + lane;
#pragma unroll
                for (int j = 0; j < 4; ++j) { const u32x2 pk = yr[64 * j]; v[r][j] = (f32x4){bf_lo(pk.x), bf_hi(pk.x), bf_lo(pk.y), bf_hi(pk.y)}; } }
#pragma unroll
            for (int r = 0; r < 4; ++r) { sm[r] = 0.f;
#pragma unroll
                for (int j = 0; j < 4; ++j) sm[r] += (v[r][j].x + v[r][j].y) + (v[r][j].z + v[r][j].w); }
            wave_sum4(sm);
#pragma unroll
            for (int r = 0; r < 4; ++r) { const float mean = sm[r] * (1.f / DM); sm[r] = 0.f;
#pragma unroll
                for (int j = 0; j < 4; ++j) { v[r][j] = v[r][j] - mean; sm[r] += (v[r][j].x * v[r][j].x + v[r][j].y * v[r][j].y) + (v[r][j].z * v[r][j].z + v[r][j].w * v[r][j].w); } }
            wave_sum4(sm);
#pragma unroll
            for (int r = 0; r < 4; ++r) { const float rstd = 1.f / sqrtf(sm[r] * (1.f / DM) + LN_EPS); sm[r] = 0.f;
#pragma unroll
                for (int j = 0; j < 4; ++j) { v[r][j] = (v[r][j] * rstd) * l1g[j] + l1b[j]; sm[r] += (v[r][j].x + v[r][j].y) + (v[r][j].z + v[r][j].w); } }
            wave_sum4(sm);
#pragma unroll
            for (int r = 0; r < 4; ++r) { const float mean = sm[r] * (1.f / DM); sm[r] = 0.f;
#pragma unroll
                for (int j = 0; j < 4; ++j) { v[r][j] = v[r][j] - mean; sm[r] += (v[r][j].x * v[r][j].x + v[r][j].y * v[r][j].y) + (v[r][j].z * v[r][j].z + v[r][j].w * v[r][j].w); } }
            wave_sum4(sm);
#pragma unroll
            for (int r = 0; r < 4; ++r) { const float rstd = 1.f / sqrtf(sm[r] * (1.f / DM) + LN_EPS);
                u32x2* o8 = (u32x2*)(XM2 + (size_t)(rowbase + r) * 1024) + lane;
#pragma unroll
                for (int j = 0; j < 4; ++j) { const f32x4 h = ((const f32x4*)sh2)[lane + 64 * j], c = ((const f32x4*)sc2)[lane + 64 * j]; const f32x4 y = (v[r][j] * rstd) * (c + 1.f) + h;
                    o8[64 * j] = (u32x2){cvt_pk_bf16(y.x, y.y), cvt_pk_bf16(y.z, y.w)}; } }
        }
        VM_WAIT();
        AMP_SPIN(80);
        f32x4 la[2][5];
#pragma unroll
        for (int t2 = 0; t2 < 2; ++t2)
#pragma unroll
            for (int nt = 0; nt < 5; ++nt) la[t2][nt] = (f32x4){0.f, 0.f, 0.f, 0.f};
        const bf16* xpA = XM2 + (size_t)(rowA + lq) * 1024 + 8 * g; const bf16* xpB = XM2 + (size_t)(rowB + lq) * 1024 + 8 * g;
        const bf16* wp = WR + (size_t)lq * 1024 + 8 * g;
#pragma unroll 4
        for (int kk = 0; kk < 32; ++kk) {
            const bf16x8 xfA = __builtin_nontemporal_load((const bf16x8*)(xpA + 32 * kk)), xfB = __builtin_nontemporal_load((const bf16x8*)(xpB + 32 * kk));
#pragma unroll
            for (int nt = 0; nt < 5; ++nt) { const bf16x8 wf = *(const bf16x8*)(wp + (size_t)nt * 16 * 1024 + 32 * kk);
                la[0][nt] = __builtin_amdgcn_mfma_f32_16x16x32_bf16(wf, xfA, la[0][nt], 0, 0, 0);
                la[1][nt] = __builtin_amdgcn_mfma_f32_16x16x32_bf16(wf, xfB, la[1][nt], 0, 0, 0); }
        }
#pragma unroll
        for (int t2 = 0; t2 < 2; ++t2)
#pragma unroll
            for (int nt = 0; nt < 5; ++nt) *(LAS f32x4*)(lg + (16 * t2 + lq) * 80 + 16 * nt + 4 * g) = la[t2][nt];
        LDS_WAIT();
        if (lane < 16 || (lane < 32 && two)) {
            const LAS float* L = lg + lane * 80;
            float gl[8]; float gm = -1e30f; int gi = 0;
#pragma unroll
            for (int i = 0; i < 8; ++i) { gl[i] = L[i] + rbias[i]; if (gl[i] > gm) { gm = gl[i]; gi = i; } }
            float gs = 0.f;
#pragma unroll
            for (int i = 0; i < 8; ++i) gs += __expf(gl[i] - gm);
            const float pg = 1.f / gs;
            float v1 = -1e30f, v2 = -1e30f; int i1 = 0, i2 = 0;
#pragma unroll
            for (int i = 0; i < 8; ++i) { const float e = L[16 + gi * 8 + i] + rbias[8 + gi * 8 + i];
                if (e > v1) { v2 = v1; i2 = i1; v1 = e; i1 = i; } else if (e > v2) { v2 = e; i2 = i; } }
            const float ex = __expf(v2 - v1), wA = pg / (1.f + ex), wB = pg * ex / (1.f + ex);
            const int eA = gi * 8 + i1, eB = gi * 8 + i2;
            const int pA = __hip_atomic_fetch_add(&hist[eA], 1, __ATOMIC_RELAXED, __HIP_MEMORY_SCOPE_WORKGROUP), pB = __hip_atomic_fetch_add(&hist[eB], 1, __ATOMIC_RELAXED, __HIP_MEMORY_SCOPE_WORKGROUP);
            LAS unsigned* rc = rec + (((nloc + (lane >> 4)) * 8 + F.wave) * 16 + (lane & 15)) * 8;
            rc[0] = (unsigned)eA; rc[1] = (unsigned)pA; rc[2] = (unsigned)eB; rc[3] = (unsigned)pB; rc[4] = __float_as_uint(wA); rc[5] = __float_as_uint(wB); rc[6] = (unsigned)((lane < 16 ? rowA : rowB) + (lane & 15));
        }
        AMP_SPIN(81);
    }
    __syncthreads();
    if (tid < 64) base[tid] = (int)__hip_atomic_fetch_add(F.ctl + CW_CNT + 16 * tid, (unsigned)hist[tid], RLX_AGENT);
    __syncthreads();
    {
        int* TOKL = (int*)(F.ws + WS_TOKL); u32x4* ROUTE = (u32x4*)(F.ws + WS_ROUTE);
        const int ntile_max = (ML_ROWS / 16 + NGW - 1) / NGW;
        for (int i = tid; i < ntile_max * 128; i += 512) {
            const int nl = i >> 7, wv = (i >> 4) & 7;
            if ((long)(F.vcu * 8 + wv) + (long)nl * NGW >= ML_ROWS / 16) continue;
            const LAS unsigned* rc = rec + i * 8;
            const int eA = (int)rc[0], pA = (int)rc[1] + base[rc[0]], eB = (int)rc[2], pB = (int)rc[3] + base[rc[2]], tok = (int)rc[6];
            TOKL[(size_t)eA * 65536 + pA] = tok; TOKL[(size_t)eB * 65536 + pB] = tok;
            ROUTE[tok] = (u32x4){((unsigned)eA << 20) | (unsigned)pA, ((unsigned)eB << 20) | (unsigned)pB, rc[4], rc[5]};
        }
    }
}

__device__ __forceinline__ void moe_tables(Frame& F) {
    LAS int* cnt = (LAS int*)(F.lds + MISC_OFF + MS_CNT); LAS int* start = (LAS int*)(F.lds + MISC_OFF + MS_START); LAS int* tstart = (LAS int*)(F.lds + MISC_OFF + MS_TSTART);
    __syncthreads();
    if (FTID(F) < 64) cnt[FTID(F)] = (int)__hip_atomic_load(F.ctl + CW_CNT + 16 * FTID(F), RLX_AGENT);
    __syncthreads();
    if (FTID(F) == 0) { int s = 0, t = 0; for (int e = 0; e < 64; ++e) { start[e] = s; tstart[e] = t; s += cnt[e]; t += (cnt[e] + 255) >> 8; } start[64] = s; tstart[64] = t; }
    __syncthreads();
}
struct MoeOrder {
    const LAS int* cnt; const LAS int* start; const LAS int* tstart; int G, c;
    __device__ __forceinline__ bool next(int i, pg8::Unit& u) const {
        const int tile = i * (G >> 2) + (c & 7) + 8 * (c >> 5), pnn = (c >> 3) & 3;
        if (tile >= tstart[64]) return false;
        int e = 0;
        for (int s = 32; s >= 1; s >>= 1) if (tstart[e + s] <= tile) e += s;
        while (cnt[e] == 0) --e;
        u.e = e; u.pm = tile - tstart[e]; u.pn = pnn; const int rem = cnt[e] - u.pm * 256; u.cnt = rem < 256 ? rem : 256; return true;
    }
};
struct MoeSched1 {
    static constexpr bool GATHER = true;
    MoeOrder ord; const char* XM2; const char* W13; const int* TOKL;
    __device__ __forceinline__ bool next(int i, pg8::Unit& u) const { return ord.next(i, u); }
    __device__ __forceinline__ const char* a_ptr(const pg8::Unit&) const { return XM2; }
    __device__ __forceinline__ const char* b_ptr(const pg8::Unit& u) const { return W13 + ((size_t)u.e * 1024 + (size_t)u.pn * 256) * 2048; }
    __device__ __forceinline__ void a_voff(const pg8::Unit& u, unsigned (&v)[2][2], int tid) const {
        int R0, R1, C0, C1; pg8::stage_rc(tid * 16, R0, C0); pg8::stage_rc(tid * 16 + 8192, R1, C1);
        const int* tl = TOKL + (size_t)u.e * 65536 + u.pm * 256;
#pragma unroll
        for (int h = 0; h < 2; ++h) { const int r0 = h * 128 + R0, r1 = h * 128 + R1;
            const int t0 = r0 < u.cnt ? tl[r0] : 0, t1 = r1 < u.cnt ? tl[r1] : 0;
            v[h][0] = (unsigned)t0 * 2048u + (unsigned)C0 * 2u; v[h][1] = (unsigned)t1 * 2048u + (unsigned)C1 * 2u; }
    }
};
struct MoeSched2 {
    static constexpr bool GATHER = false;
    MoeOrder ord; const char* H; const char* W2;
    __device__ __forceinline__ bool next(int i, pg8::Unit& u) const { return ord.next(i, u); }
    __device__ __forceinline__ const char* a_ptr(const pg8::Unit& u) const { return H + (size_t)(ord.start[u.e] + u.pm * 256) * 1024; }
    __device__ __forceinline__ const char* b_ptr(const pg8::Unit& u) const { return W2 + ((size_t)u.e * 1024 + (size_t)u.pn * 256) * 1024; }
    __device__ __forceinline__ void a_voff(const pg8::Unit&, unsigned (&)[2][2], int) const {}
};
struct EpiH {
    static constexpr bool PERM = true;
    bf16* H; const LAS int* start;
    __device__ __forceinline__ void operator()(const f32x4 (&acc)[2][2][4][2], const pg8::Unit& u, int wr, int wc, int fr, int fq) const {
        const int r0 = wr * 64 + fr; const size_t slot0 = (size_t)start[u.e] + u.pm * 256;
        const int col0 = u.pn * 128 + wc * 32 + 8 * fq;
#pragma unroll
        for (int ai = 0; ai < 2; ++ai)
#pragma unroll
            for (int m = 0; m < 4; ++m) { const int r = r0 + ai * 128 + m * 16;
                if (r < u.cnt) { float o[8];
#pragma unroll
                    for (int n = 0; n < 2; ++n)
#pragma unroll
                        for (int j = 0; j < 4; ++j) { const float h1 = acc[ai][0][m][n][j], h3 = acc[ai][1][m][n][j]; o[4 * n + j] = h1 / (1.f + __expf(-h1)) * h3; }
                    *(u32x4*)(H + (slot0 + r) * 512 + col0) = (u32x4){cvt_pk_bf16(o[0], o[1]), cvt_pk_bf16(o[2], o[3]), cvt_pk_bf16(o[4], o[5]), cvt_pk_bf16(o[6], o[7])}; } }
    }
};
struct EpiY {
    static constexpr bool PERM = true;
    bf16* Y; const LAS int* start;
    __device__ __forceinline__ void operator()(const f32x4 (&acc)[2][2][4][2], const pg8::Unit& u, int wr, int wc, int fr, int fq) const {
        const int r0 = wr * 64 + fr; const size_t slot0 = (size_t)start[u.e] + u.pm * 256;
        const int col0 = u.pn * 256 + wc * 32 + 8 * fq;
#pragma unroll
        for (int ai = 0; ai < 2; ++ai)
#pragma unroll
            for (int m = 0; m < 4; ++m) { const int r = r0 + ai * 128 + m * 16;
                if (r < u.cnt) {
#pragma unroll
                    for (int bj = 0; bj < 2; ++bj) { const f32x4 v0 = acc[ai][bj][m][0], v1 = acc[ai][bj][m][1];
                        *(u32x4*)(Y + (slot0 + r) * 1024 + col0 + bj * 128) = (u32x4){cvt_pk_bf16(v0[0], v0[1]), cvt_pk_bf16(v0[2], v0[3]), cvt_pk_bf16(v1[0], v1[1]), cvt_pk_bf16(v1[2], v1[3])}; } } }
    }
};

__device__ __forceinline__ void p11_final(Frame& F, const Args& a) {
    const int gw = F.vcu * 8 + F.wave, NGW = F.G * 8, lane = opaque(cur_lane());
    const bf16* XMID = (const bf16*)(F.ws + WS_Y1); const bf16* Y = (const bf16*)(F.ws + WS_YMOE); const u32x4* ROUTE = (const u32x4*)(F.ws + WS_ROUTE);
    const float* ada = (const float*)(F.ws + WS_ADA);
    const LAS int* start = (const LAS int*)(F.lds + MISC_OFF + MS_START);
    for (int m0 = gw; m0 < ML_ROWS; m0 += 4 * NGW) {
        f32x4 v[4][4], mo[4][4]; float sm[4]; bool ok[4]; int mm[4];
        u32x4 rt[4];
#pragma unroll
        for (int r = 0; r < 4; ++r) { const int m = m0 + r * NGW; ok[r] = m < ML_ROWS; mm[r] = ok[r] ? m : m0; rt[r] = ROUTE[mm[r]]; }
#pragma unroll
        for (int r = 0; r < 4; ++r) {
            const size_t sA = (size_t)start[rt[r].x >> 20] + (rt[r].x & 0xfffffu), sB = (size_t)start[rt[r].y >> 20] + (rt[r].y & 0xfffffu);
            const float wA = __uint_as_float(rt[r].z), wB = __uint_as_float(rt[r].w);
            const u32x2* xr = (const u32x2*)(XMID + (size_t)mm[r] * 1024) + lane; const u32x2* ya = (const u32x2*)(Y + sA * 1024) + lane; const u32x2* yb = (const u32x2*)(Y + sB * 1024) + lane;
            const f32x4* g2 = (const f32x4*)(ada + (size_t)(mm[r] >> 13) * 6144 + 5120) + lane;
            sm[r] = 0.f;
#pragma unroll
            for (int j = 0; j < 4; ++j) { const u32x2 xp = xr[64 * j], pa = ya[64 * j], pb = yb[64 * j]; const f32x4 gg = g2[64 * j];
                v[r][j] = (f32x4){bf_lo(xp.x), bf_hi(xp.x), bf_lo(xp.y), bf_hi(xp.y)};
                mo[r][j].x = (wA * bf_lo(pa.x) + wB * bf_lo(pb.x)) * gg.x; mo[r][j].y = (wA * bf_hi(pa.x) + wB * bf_hi(pb.x)) * gg.y;
                mo[r][j].z = (wA * bf_lo(pa.y) + wB * bf_lo(pb.y)) * gg.z; mo[r][j].w = (wA * bf_hi(pa.y) + wB * bf_hi(pb.y)) * gg.w;
                sm[r] += (v[r][j].x + v[r][j].y) + (v[r][j].z + v[r][j].w); }
        }
        wave_sum4(sm);
#pragma unroll
        for (int r = 0; r < 4; ++r) { const float mean = sm[r] * (1.f / DM); sm[r] = 0.f;
#pragma unroll
            for (int j = 0; j < 4; ++j) { v[r][j] = v[r][j] - mean; sm[r] += (v[r][j].x * v[r][j].x + v[r][j].y * v[r][j].y) + (v[r][j].z * v[r][j].z + v[r][j].w * v[r][j].w); } }
        wave_sum4(sm);
#pragma unroll
        for (int r = 0; r < 4; ++r) { const float rstd = 1.f / sqrtf(sm[r] * (1.f / DM) + LN_EPS); sm[r] = 0.f;
#pragma unroll
            for (int j = 0; j < 4; ++j) { const f32x4 gg = ((const f32x4*)a.in[13])[lane + 64 * j], bb = ((const f32x4*)a.in[14])[lane + 64 * j];
                v[r][j] = ((v[r][j] * rstd) * gg + bb) * DN_ALPHA + mo[r][j]; sm[r] += (v[r][j].x + v[r][j].y) + (v[r][j].z + v[r][j].w); } }
        wave_sum4(sm);
#pragma unroll
        for (int r = 0; r < 4; ++r) { const float mean = sm[r] * (1.f / DM); sm[r] = 0.f;
#pragma unroll
            for (int j = 0; j < 4; ++j) { v[r][j] = v[r][j] - mean; sm[r] += (v[r][j].x * v[r][j].x + v[r][j].y * v[r][j].y) + (v[r][j].z * v[r][j].z + v[r][j].w * v[r][j].w); } }
        wave_sum4(sm);
#pragma unroll
        for (int r = 0; r < 4; ++r) { const float rstd = 1.f / sqrtf(sm[r] * (1.f / DM) + LN_EPS);
            f32x4* o = (f32x4*)(a.out + (size_t)mm[r] * 1024) + lane;
            if (ok[r]) {
#pragma unroll
                for (int j = 0; j < 4; ++j) { const f32x4 gg = ((const f32x4*)a.in[22])[lane + 64 * j], bb = ((const f32x4*)a.in[23])[lane + 64 * j]; o[64 * j] = (v[r][j] * rstd) * gg + bb; } }
        }
    }
}

__global__ void __launch_bounds__(512, 2) mk_fwd(Args args) {
    extern __shared__ __attribute__((aligned(16))) unsigned char lds_raw[];
    Frame F;
    F.lds = (LAS unsigned char*)lds_raw; F.ws = args.ws; F.ctl = (unsigned*)(args.ws + WS_CTL);
    F.wave = __builtin_amdgcn_readfirstlane((int)threadIdx.x >> 6);
    F.G = gridDim.x; { const int bx = blockIdx.x; F.vcu = (F.G % 8 == 0) ? (bx % 8) * (F.G / 8) + bx / 8 : bx; }
    for (int u = FTID(F); u < (LDS_BYTES - MISC_OFF) / 4; u += 512) ((LAS unsigned*)(F.lds + MISC_OFF))[u] = 0u;
    __syncthreads();
    XcdBarrier bar; bar.bar = F.ctl + CW_BAR; bar.x = 0; bar.st = nullptr;
    if (MK_N_LAUNCHES == 1) bar = xcd_barrier_post(F.ctl + CW_BAR, (volatile LAS unsigned*)(F.lds + MISC_OFF));
    const int lo = args.ph_lo, hi = args.ph_hi;
#define IN(k) (lo <= (k) && (k) < hi)
#define SEAM(k) do { if (IN(k) && IN((k) + 1)) xcd_barrier(bar); AMP_SPIN(k); } while (0)
    if (PROBE_AMP >= 0) { if (FTID(F) == 0) *(volatile LAS unsigned long long*)(F.lds + MISC_OFF + 32) = __builtin_amdgcn_s_memrealtime(); }

    if (IN(0)) { p0_prologue(F, args); } SEAM(0);
    if (IN(1)) { p1_ln_mod(F, args); } SEAM(1);
    if (IN(2)) {
        pg8::DenseSched S; S.A = (const char*)(F.ws + WS_XM); S.Bt = (const char*)(F.ws + WS_WIN); S.K = 1024; S.ord.init(MT, NZ, F.G, (int)blockIdx.x);
        EpiZ E{F.ws, args.in[9]};
        pg8::gemm_phase<EpiZ, pg8::DenseSched>(F.lds, 1024, S, E);
    } SEAM(2);
    if (IN(3)) { if (args.pad != 2) p3_qkprep(F, args); if (args.pad != 1) p3_na(F, args); } SEAM(3);
    if (IN(4)) {
        for (int u = blockIdx.x; u < 576; u += F.G) { if (u < 512) mlstm_unit<false>(F, args, u >> 3, u & 7, false); else mlstm_unit<false>(F, args, u - 512, -1, false); }
    } SEAM(4);
    if (IN(5)) {
        for (int u = blockIdx.x; u < 256; u += F.G) { const int bh = u >> 3, gt = u & 7; for (int ps = 0; ps < 2; ++ps) mlstm_unit<true>(F, args, bh * 2 + ps, ps ? 7 - gt : gt, ps != 0); }
    } SEAM(5);
    if (IN(7)) {
        pg8::DenseSched S; S.A = (const char*)(F.ws + WS_MIX); S.Bt = (const char*)(F.ws + WS_WOUT); S.K = 1024; S.ord.init(ML_ROWS, 1024, F.G, (int)blockIdx.x);
        EpiY1 E{args.in[0], (const float*)(F.ws + WS_ADA), (bf16*)(F.ws + WS_Y1)};
        pg8::gemm_phase<EpiY1, pg8::DenseSched>(F.lds, 1024, S, E);
    } SEAM(7);
    if (IN(8)) { p8_mid(F, args); } SEAM(8);
    if (IN(9)) {
        moe_tables(F);
        MoeSched1 S; S.ord = MoeOrder{(const LAS int*)(F.lds + MISC_OFF + MS_CNT), (const LAS int*)(F.lds + MISC_OFF + MS_START), (const LAS int*)(F.lds + MISC_OFF + MS_TSTART), F.G, (int)blockIdx.x};
        S.XM2 = (const char*)(F.ws + WS_XM2); S.W13 = (const char*)(F.ws + WS_W13); S.TOKL = (const int*)(F.ws + WS_TOKL);
        EpiH E{(bf16*)(F.ws + WS_HMOE), (const LAS int*)(F.lds + MISC_OFF + MS_START)};
        pg8::gemm_phase<EpiH, MoeSched1>(F.lds, 1024, S, E);
    } SEAM(9);
    if (IN(10)) {
        moe_tables(F);
        MoeSched2 S; S.ord = MoeOrder{(const LAS int*)(F.lds + MISC_OFF + MS_CNT), (const LAS int*)(F.lds + MISC_OFF + MS_START), (const LAS int*)(F.lds + MISC_OFF + MS_TSTART), F.G, (int)blockIdx.x};
        S.H = (const char*)(F.ws + WS_HMOE); S.W2 = (const char*)(F.ws + WS_W2);
        EpiY E{(bf16*)(F.ws + WS_YMOE), (const LAS int*)(F.lds + MISC_OFF + MS_START)};
        pg8::gemm_phase<EpiY, MoeSched2>(F.lds, 512, S, E);
    } SEAM(10);
    if (IN(11)) { moe_tables(F); p11_final(F, args); }
    if (PROBE_AMP == 11) { VM_WAIT(); AMP_SPIN(11); }
#undef IN
#undef SEAM
}

extern "C" void kernel_launch(void* const* d_in, const int* in_sizes, int n_in, void* d_out, int out_size, void* d_ws, size_t ws_size, hipStream_t stream) {
    static int grid = 0;
    if (grid == 0) {
        if (n_in != 24 || out_size != ML_ROWS * DM || ws_size < WS_END) { fprintf(stderr, "kernel_launch: unexpected shapes (n_in %d out %d ws %zu)\n", n_in, out_size, ws_size); grid = -1; return; }
        int dev = 0, cus = 0, per_cu = 0;
        if (hipGetDevice(&dev) != hipSuccess || hipDeviceGetAttribute(&cus, hipDeviceAttributeMultiprocessorCount, dev) != hipSuccess) { grid = -1; return; }
        if (hipFuncSetAttribute((const void*)mk_fwd, hipFuncAttributeMaxDynamicSharedMemorySize, LDS_BYTES) != hipSuccess) { fprintf(stderr, "kernel_launch: hipFuncSetAttribute failed\n"); grid = -1; return; }
        if (hipOccupancyMaxActiveBlocksPerMultiprocessor(&per_cu, (const void*)mk_fwd, 512, LDS_BYTES) != hipSuccess || per_cu < 1) fprintf(stderr, "kernel_launch: occupancy query says %d\n", per_cu);
        (void)hipGetLastError();
        grid = cus;
    }
    if (grid < 0) return;
    if (hipMemsetAsync((char*)d_ws + WS_CTL, 0, CTL_ZERO_BYTES, stream) != hipSuccess) return;
    Args a{};
    for (int i = 0; i < 24; ++i) a.in[i] = (const float*)d_in[i];
    a.out = (float*)d_out; a.ws = (unsigned char*)d_ws;
    if (MK_N_LAUNCHES == 1) { a.ph_lo = 0; a.ph_hi = NPHASE; a.li = 0; hipLaunchKernelGGL(mk_fwd, dim3(grid), dim3(512), LDS_BYTES, stream, a); }
    else for (int p = 0; p < NPHASE; ++p) { a.ph_lo = p; a.ph_hi = p + 1; a.li = p; a.pad = 0; hipLaunchKernelGGL(mk_fwd, dim3(grid), dim3(512), LDS_BYTES, stream, a);
        if (PROBE_DBL == p || (PROBE_DBL == 33 && p == 3)) { a.pad = (PROBE_DBL == 33) ? 2 : (p == 3 ? 1 : 0); hipLaunchKernelGGL(mk_fwd, dim3(grid), dim3(512), LDS_BYTES, stream, a); } }
}
```

```cpp
#include <hip/hip_runtime.h>
#include <cstdio>
#include <cstdint>

#ifndef MK_N_LAUNCHES
#define MK_N_LAUNCHES 1
#endif
#ifndef PROBE_DBL
#define PROBE_DBL -1
#endif
#ifndef PROBE_AMP
#define PROBE_AMP -1
#endif

#define GAS __attribute__((address_space(1)))
#define LAS __attribute__((address_space(3)))
typedef unsigned short bf16;
typedef short bf16x8 __attribute__((ext_vector_type(8)));
typedef short bf16x4 __attribute__((ext_vector_type(4)));
typedef float f32x4 __attribute__((ext_vector_type(4)));
typedef float f32x2 __attribute__((ext_vector_type(2)));
typedef unsigned u32x4 __attribute__((ext_vector_type(4)));
typedef unsigned u32x2 __attribute__((ext_vector_type(2)));

constexpr int NB = 8, SEQ = 8192, DM = 1024, CTXL = 256;
constexpr int ML_ROWS = NB * SEQ, MC_ROWS = NB * CTXL, MT = ML_ROWS + MC_ROWS;
constexpr int IN_COLS = 3600, NZ = 3840;
constexpr int NEXP = 64, EH = 512;
constexpr float LN_EPS = 1e-5f;
constexpr float DN_ALPHA = 1.189207115002721f;
constexpr int NPHASE = 12;

constexpr size_t MiB = 1u << 20;
constexpr size_t WS_CTL = 0, CTL_ZERO_BYTES = 1 * MiB;
constexpr size_t WS_WIN = 1 * MiB;
constexpr size_t WS_WOUT = 9 * MiB;
constexpr size_t WS_W13 = 11 * MiB;
constexpr size_t WS_W2 = 139 * MiB;
constexpr size_t WS_ADA = 203 * MiB;
constexpr size_t WS_ROPE = 204 * MiB;
constexpr size_t WS_WR = 204 * MiB + 512 * 1024;
constexpr size_t WS_GATES = 205 * MiB;
constexpr size_t WS_TOKL = 210 * MiB;
constexpr size_t WS_ROUTE = 226 * MiB;
constexpr size_t WS_MLST = 227 * MiB;
constexpr int REC_FLOATS = 18688;
constexpr size_t WS_ZA = 270 * MiB;
constexpr size_t WS_ZQK = 468 * MiB;
constexpr size_t WS_ZV = 600 * MiB;
constexpr size_t WS_ZO = 666 * MiB;
constexpr size_t WS_XM = 732 * MiB;
constexpr size_t WS_MIX = 864 * MiB;
constexpr size_t WS_HB = 270 * MiB;
constexpr size_t WS_Y1 = 270 * MiB;
constexpr size_t WS_HMOE = 526 * MiB;
constexpr size_t WS_XM2 = 655 * MiB;
constexpr size_t WS_YMOE = 655 * MiB;
constexpr size_t WS_END = 992 * MiB;
static_assert(WS_MLST + (size_t)64 * 9 * REC_FLOATS * 4 <= WS_ZA, "ws map");
static_assert(WS_YMOE + (size_t)(131072 + 256) * 1024 * 2 <= WS_END, "ws map");
constexpr int CW_TMO = 0;
constexpr int CW_BAR = 4096;
constexpr int CW_CNT = 16384;

constexpr int PH_BYTES = 159744;
constexpr int MISC_OFF = PH_BYTES;
constexpr int LDS_BYTES = PH_BYTES + 4096;
constexpr int MS_TSTART = 64;
constexpr int MS_CNT = 384;
constexpr int MS_START = 704;
constexpr int MS_HIST = 1024;
constexpr int MS_BASE = 1280;

#define LDS_WAIT() asm volatile("s_waitcnt lgkmcnt(0)" ::: "memory")
#define VM_WAIT() asm volatile("s_waitcnt vmcnt(0)" ::: "memory")
#define RLX_AGENT __ATOMIC_RELAXED, __HIP_MEMORY_SCOPE_AGENT

__device__ __forceinline__ unsigned cvt_pk_bf16(float lo, float hi) { unsigned r; asm volatile("v_cvt_pk_bf16_f32 %0, %1, %2" : "=v"(r) : "v"(lo), "v"(hi)); return r; }
__device__ __forceinline__ int opaque(int x) { asm volatile("" : "+v"(x)); return x; }
__device__ __forceinline__ float frcp(float x) { return __builtin_amdgcn_rcpf(x); }
__device__ __forceinline__ float frsq(float x) { return __builtin_amdgcn_rsqf(x); }
__device__ __forceinline__ float bf_lo(unsigned u) { return __builtin_bit_cast(float, u << 16); }
__device__ __forceinline__ float bf_hi(unsigned u) { return __builtin_bit_cast(float, u & 0xffff0000u); }
__device__ __forceinline__ float wave_sum(float v) {
#pragma unroll
    for (int o = 1; o < 64; o <<= 1) v += __shfl_xor(v, o);
    return v;
}
template <int N> __device__ __forceinline__ void wave_sumN(float (&v)[N]) {
#pragma unroll
    for (int o = 1; o < 64; o <<= 1) {
#pragma unroll
        for (int r = 0; r < N; ++r) v[r] += __shfl_xor(v[r], o);
    }
}
__device__ __forceinline__ void wave_sum4(float (&v)[4]) {
#pragma unroll
    for (int o = 1; o < 64; o <<= 1) {
#pragma unroll
        for (int r = 0; r < 4; ++r) v[r] += __shfl_xor(v[r], o);
    }
}
__device__ __forceinline__ bf16x4 tr_read(const LAS unsigned char* p) { return __builtin_amdgcn_ds_read_tr16_b64_v4i16((LAS bf16x4*)p); }
__device__ __forceinline__ bf16x8 cat4(bf16x4 a, bf16x4 b) { return (bf16x8){a[0], a[1], a[2], a[3], b[0], b[1], b[2], b[3]}; }
__device__ __forceinline__ bf16x8 as_bf16x8(u32x4 v) { return __builtin_bit_cast(bf16x8, v); }

#define XB_TMO      128
#define XB_XCNT(j)  (256  + 64 * (j))
#define XB_XSUB(j)  (1280 + 64 * (j))
#define XB_XGEN(j)  (2304 + 64 * (j))
#define XB_TOP      3328
#define XB_TOPGEN   3392
#define XCD_BAR_WORDS 3456
#define XB_SPIN_CAP (1u << 18)
__device__ __forceinline__ unsigned xb_ld(unsigned* p)              { return __hip_atomic_load(p, __ATOMIC_RELAXED, __HIP_MEMORY_SCOPE_AGENT); }
__device__ __forceinline__ unsigned xb_add(unsigned* p, unsigned v) { return __hip_atomic_fetch_add(p, v, __ATOMIC_RELAXED, __HIP_MEMORY_SCOPE_AGENT); }
__device__ __forceinline__ unsigned xb_xcc_id() { return (unsigned)__builtin_amdgcn_s_getreg((3 << 11) | 20) & 0xFu; }
#define XB_SPIN(cond, bar) do { unsigned _sp = 0; while (cond) { __builtin_amdgcn_s_sleep(1); \
    if ((++_sp & 255u) == 0u) { if (xb_ld(&(bar)[XB_TMO])) break; if (_sp > XB_SPIN_CAP) { atomicAdd(&(bar)[XB_TMO], 1u); break; } } } } while (0)
struct XcdBarrier { unsigned* bar; unsigned x; volatile LAS unsigned* st; };
__device__ __forceinline__ XcdBarrier xcd_barrier_post(unsigned* bar, volatile LAS unsigned* st) {
    XcdBarrier b; b.bar = bar; b.x = xb_xcc_id(); b.st = st;
    if (threadIdx.x == 0) (void)xb_add(&bar[XB_XCNT(b.x)], 1u);
    return b;
}
__device__ __forceinline__ void xcd_barrier_complete(unsigned* bar, unsigned x, unsigned& nloc, unsigned& nx) {
    const unsigned G = gridDim.x * gridDim.y * gridDim.z;
    unsigned sum, cnt, mine, sp = 0u;
    for (;;) {
        sum = 0u; cnt = 0u; mine = 0u;
#pragma unroll
        for (unsigned j = 0; j < 16; ++j) { const unsigned c = xb_ld(&bar[XB_XCNT(j)]); sum += c; cnt += (c > 0u) ? 1u : 0u; mine = (j == x) ? c : mine; }
        if (sum == G) break;
        __builtin_amdgcn_s_sleep(1);
        if ((++sp & 255u) == 0u) { if (xb_ld(&bar[XB_TMO])) break; if (sp > XB_SPIN_CAP) { atomicAdd(&bar[XB_TMO], 1u); break; } }
    }
    nloc = mine > 0u ? mine : 1u; nx = cnt > 0u ? cnt : 1u;
}
__device__ __forceinline__ void xcd_barrier(const XcdBarrier& b) {
    asm volatile("s_waitcnt vmcnt(0)" ::: "memory");
    __syncthreads();
    if (threadIdx.x == 0) {
        unsigned* bar = b.bar;
        __builtin_amdgcn_s_waitcnt(0);
        unsigned nloc = b.st[0], nx = b.st[1];
        if (nloc == 0u) { xcd_barrier_complete(bar, b.x, nloc, nx); b.st[0] = nloc; b.st[1] = nx; }
        const unsigned old = xb_add(&bar[XB_XSUB(b.x)], 1u);
        const unsigned gen = old / nloc;
        if (old + 1u == (gen + 1u) * nloc) {
            __builtin_amdgcn_fence(__ATOMIC_RELEASE, "agent");
            asm volatile("s_waitcnt vmcnt(0)" ::: "memory");
            const unsigned og = xb_add(&bar[XB_TOP], 1u);
            const unsigned tg = og / nx;
            if (og + 1u == (tg + 1u) * nx) xb_add(&bar[XB_TOPGEN], 1u);
            else XB_SPIN(xb_ld(&bar[XB_TOPGEN]) == tg, bar);
            __builtin_amdgcn_fence(__ATOMIC_ACQUIRE, "agent");
            xb_add(&bar[XB_XGEN(b.x)], 1u);
            asm volatile("s_waitcnt vmcnt(0)" ::: "memory");
        } else {
            XB_SPIN(xb_ld(&bar[XB_XGEN(b.x)]) == gen, bar);
            __builtin_amdgcn_fence(__ATOMIC_ACQUIRE, "agent");
            asm volatile("s_waitcnt vmcnt(0)" ::: "memory");
        }
    }
    __syncthreads();
}

namespace pg8 {
constexpr int BM = 256, BK = 64, HALF = 128, HTB = HALF * BK * 2, STAGE_BYTES = 8 * HTB, NXCD = 8, WGM = 8;
__host__ __device__ __forceinline__ int lds_byte(int r, int c) { const int st = (r >> 4) * 2 + (c >> 5), rr = r & 15, cc = c & 31, ob = rr * 64 + cc * 2; return st * 1024 + (ob ^ (((ob >> 9) & 1) << 5)); }
__host__ __device__ __forceinline__ void stage_rc(int b, int& R, int& C) { const int st = b / 1024, sb = b % 1024, swz = sb ^ (((sb >> 9) & 1) << 5); R = (st >> 1) * 16 + swz / 64; C = (st & 1) * 32 + (swz % 64) / 2; }
__host__ __device__ __forceinline__ int perm32(int rho) { const int n = rho >> 4, i = rho & 15; return 8 * (i >> 2) + 4 * n + (i & 3); }

struct Unit { int pm, pn, e, cnt; };

struct StaticOrder {
    int nM, nN, nwg, G, c;
    __device__ void init(int M, int N, int G_, int c_) { nM = M / BM; nN = N / BM; nwg = nM * nN; G = G_; c = c_; }
    __device__ bool next(int i, Unit& u) const {
        const long L = (long)i * G + c; if (L >= nwg) return false;
        int wgid = (int)L; { const int q = nwg / NXCD, r = nwg % NXCD, xcd = wgid % NXCD, off = wgid / NXCD; wgid = (xcd < r ? xcd * (q + 1) : r * (q + 1) + (xcd - r) * q) + off; }
        const int nig = WGM * nN, gid = wgid / nig, fm = gid * WGM, gsz = (nM - fm) < WGM ? (nM - fm) : WGM;
        u.pm = fm + ((wgid % nig) % gsz); u.pn = (wgid % nig) / gsz; u.e = 0; u.cnt = 256; return true;
    }
};
struct DenseSched {
    static constexpr bool GATHER = false;
    const char* A; const char* Bt; int K; StaticOrder ord;
    __device__ __forceinline__ bool next(int i, Unit& u) const { return ord.next(i, u); }
    __device__ __forceinline__ const char* a_ptr(const Unit& u) const { return A + (size_t)u.pm * BM * K * 2; }
    __device__ __forceinline__ const char* b_ptr(const Unit& u) const { return Bt + (size_t)u.pn * BM * K * 2; }
    __device__ __forceinline__ void a_voff(const Unit&, unsigned (&)[2][2], int) const {}
};

template <class Epi, class Sched, bool ALIGN_EPI = true>
__device__ __forceinline__ void gemm_phase(LAS unsigned char* lds, const int K, const Sched& S, const Epi& E) {
    const int tid = opaque((int)threadIdx.x), wid = __builtin_amdgcn_readfirstlane(tid >> 6), lane = tid & 63, wr = wid >> 2, wc = wid & 3, fr = lane & 15, fq = lane >> 4;
    const int nt = K / BK;
    unsigned voffA[2], voffB[2];
#pragma unroll
    for (int i = 0; i < 2; ++i) { int R, C; stage_rc(tid * 16 + i * 8192, R, C); const int Rb = Epi::PERM ? ((R & ~31) + perm32(R & 31)) : R;
        voffA[i] = (unsigned)(R * K + C) * 2u; voffB[i] = (unsigned)(Rb * K + C) * 2u; }
    const size_t kstep = (size_t)(BK * 2);
    const size_t hstep = (size_t)HALF * K * 2;
    const unsigned ldsw = (unsigned)wid * 1024u;
    const int aoff = lds_byte(wr * 64 + fr, fq * 8), boff = lds_byte(wc * 32 + fr, fq * 8);
#define PG8_SA(b, h) (((b) * 2 + (h)) * HTB)
#define PG8_SB(b, h) ((4 + (b) * 2 + (h)) * HTB)
#define PG8_STAGE(bufoff, gbase, voff) do { _Pragma("unroll") for (int _i = 0; _i < 2; ++_i) \
        __builtin_amdgcn_global_load_lds((const unsigned*)((const char*)(gbase) + (voff)[_i]), (LAS unsigned*)(lds + (bufoff) + ldsw + _i * 8192), 16, 0, 0); } while (0)
#define PG8_STAGE_A(b, h, ptr, gv) do { if constexpr (Sched::GATHER) { PG8_STAGE(PG8_SA(b, h), ptr, gv[h]); } else { PG8_STAGE(PG8_SA(b, h), (ptr) + ((h) ? hstep : 0), voffA); } } while (0)
#define PG8_LDA(dst, b, h) do { _Pragma("unroll") for (int m = 0; m < 4; ++m) _Pragma("unroll") for (int k = 0; k < 2; ++k) dst[m][k] = *(const LAS bf16x8*)(lds + PG8_SA(b, h) + aoff + m * 2048 + k * 1024); } while (0)
#define PG8_LDB(dst, b, h) do { _Pragma("unroll") for (int n = 0; n < 2; ++n) _Pragma("unroll") for (int k = 0; k < 2; ++k) dst[n][k] = *(const LAS bf16x8*)(lds + PG8_SB(b, h) + boff + n * 2048 + k * 1024); } while (0)
#define PG8_MMA(ai, bj, At, Bt) do { __builtin_amdgcn_s_setprio(1); _Pragma("unroll") for (int m = 0; m < 4; ++m) _Pragma("unroll") for (int n = 0; n < 2; ++n) _Pragma("unroll") for (int k = 0; k < 2; ++k) \
        acc[ai][bj][m][n] = __builtin_amdgcn_mfma_f32_16x16x32_bf16(Bt[n][k], At[m][k], acc[ai][bj][m][n], 0, 0, 0); __builtin_amdgcn_s_setprio(0); } while (0)
#define PG8_WAIT_V(n) asm volatile("s_waitcnt vmcnt(" #n ")" ::: "memory")
#define PG8_WAIT_L(n) asm volatile("s_waitcnt lgkmcnt(" #n ")" ::: "memory")
#define PG8_BAR __builtin_amdgcn_s_barrier()
#define PG8_SCHED __builtin_amdgcn_sched_barrier(0)
    Unit cur, nxt; int ui = 0;
    if (!S.next(0, cur)) return;
    f32x4 acc[2][2][4][2];
#pragma unroll
    for (int a = 0; a < 2; ++a)
#pragma unroll
        for (int b = 0; b < 2; ++b)
#pragma unroll
            for (int m = 0; m < 4; ++m)
#pragma unroll
                for (int n = 0; n < 2; ++n) acc[a][b][m][n] = (f32x4){0.f, 0.f, 0.f, 0.f};
    bf16x8 At[4][2], B0[2][2], B1[2][2];
    unsigned cv[2][2], nv[2][2];
    const char* cA = S.a_ptr(cur); const char* cB = S.b_ptr(cur);
    if constexpr (Sched::GATHER) { S.a_voff(cur, cv, tid);
#pragma unroll
        for (int h = 0; h < 2; ++h)
#pragma unroll
            for (int i = 0; i < 2; ++i) nv[h][i] = cv[h][i]; }
    PG8_STAGE(PG8_SB(0, 0), cB, voffB); PG8_STAGE(PG8_SB(0, 1), cB + hstep, voffB); PG8_STAGE_A(0, 0, cA, cv); PG8_STAGE_A(0, 1, cA, cv);
    if (wr == 1) PG8_BAR;
    PG8_WAIT_V(2); PG8_BAR;
    PG8_STAGE(PG8_SB(1, 0), cB + kstep, voffB); PG8_STAGE_A(1, 0, cA + kstep, cv); PG8_STAGE(PG8_SB(1, 1), cB + hstep + kstep, voffB);
    PG8_WAIT_V(6); PG8_BAR;
    for (;;) {
        const bool has_next = S.next(ui + 1, nxt);
        const char* nA = has_next ? S.a_ptr(nxt) : cA; const char* nB = has_next ? S.b_ptr(nxt) : cB;
        if constexpr (Sched::GATHER) { if (has_next) S.a_voff(nxt, nv, tid); }
        for (int t = 0; t < nt; t += 2) {
            const bool last = (t == nt - 2);
            const char* a1 = cA + (size_t)(t + 1) * kstep;
            const char* a2 = last ? nA : cA + (size_t)(t + 2) * kstep; const char* b2 = last ? nB : cB + (size_t)(t + 2) * kstep;
            const char* a3 = a2 + kstep; const char* b3 = b2 + kstep;
            unsigned v2[2][2];
            if constexpr (Sched::GATHER) {
#pragma unroll
                for (int h = 0; h < 2; ++h)
#pragma unroll
                    for (int i = 0; i < 2; ++i) v2[h][i] = last ? nv[h][i] : cv[h][i]; }
            PG8_LDB(B0, 0, 0); PG8_LDB(B1, 0, 1); PG8_SCHED; PG8_LDA(At, 0, 0); PG8_STAGE_A(1, 1, a1, cv);
            PG8_WAIT_V(8); PG8_WAIT_L(0); PG8_BAR; PG8_MMA(0, 0, At, B0); PG8_MMA(0, 1, At, B1); PG8_BAR; PG8_SCHED;
            PG8_LDA(At, 0, 1); PG8_STAGE(PG8_SB(0, 0), b2, voffB); PG8_STAGE(PG8_SB(0, 1), b2 + hstep, voffB); PG8_STAGE_A(0, 0, a2, v2);
            PG8_WAIT_V(8); PG8_WAIT_L(0); PG8_BAR; PG8_MMA(1, 0, At, B0); PG8_MMA(1, 1, At, B1); PG8_BAR; PG8_SCHED;
            PG8_LDB(B0, 1, 0); PG8_LDB(B1, 1, 1); PG8_SCHED; PG8_LDA(At, 1, 0); PG8_STAGE_A(0, 1, a2, v2);
            PG8_WAIT_V(8); PG8_WAIT_L(0); PG8_BAR; PG8_MMA(0, 0, At, B0); PG8_MMA(0, 1, At, B1); PG8_BAR; PG8_SCHED;
            PG8_LDA(At, 1, 1); PG8_STAGE(PG8_SB(1, 0), b3, voffB); PG8_STAGE(PG8_SB(1, 1), b3 + hstep, voffB); PG8_STAGE_A(1, 0, a3, v2);
            PG8_WAIT_V(8); PG8_WAIT_L(0); PG8_BAR; PG8_MMA(1, 0, At, B0); PG8_MMA(1, 1, At, B1); PG8_BAR; PG8_SCHED;
        }
        if constexpr (ALIGN_EPI) { if (wr == 0) PG8_BAR; }
        E(acc, cur, wr, wc, fr, fq);
        if (!has_next) break;
#pragma unroll
        for (int a = 0; a < 2; ++a)
#pragma unroll
            for (int b = 0; b < 2; ++b)
#pragma unroll
                for (int m = 0; m < 4; ++m)
#pragma unroll
                    for (int n = 0; n < 2; ++n) acc[a][b][m][n] = (f32x4){0.f, 0.f, 0.f, 0.f};
        cur = nxt; cA = nA; cB = nB; ++ui;
        if constexpr (Sched::GATHER) {
#pragma unroll
            for (int h = 0; h < 2; ++h)
#pragma unroll
                for (int i = 0; i < 2; ++i) cv[h][i] = nv[h][i]; }
        if constexpr (ALIGN_EPI) { if (wr == 1) PG8_BAR; }
    }
    PG8_WAIT_V(0);
    if constexpr (!ALIGN_EPI) { if (wr == 0) PG8_BAR; }
    PG8_BAR;
#undef PG8_SA
#undef PG8_SB
#undef PG8_STAGE
#undef PG8_STAGE_A
#undef PG8_LDA
#undef PG8_LDB
#undef PG8_MMA
#undef PG8_WAIT_V
#undef PG8_WAIT_L
#undef PG8_BAR
#undef PG8_SCHED
}
}

struct Args { const float* in[24]; float* out; unsigned char* ws; int ph_lo, ph_hi, li, pad; };
struct Frame {
    LAS unsigned char* lds;
    unsigned* ctl;
    int wave, vcu, G;
    unsigned char* ws;
};
__device__ __forceinline__ int cur_lane() { int l; asm volatile("v_mbcnt_lo_u32_b32 %0, -1, 0\n\tv_mbcnt_hi_u32_b32 %0, -1, %0" : "=v"(l)); return l; }
#define FTID(F) ((F).wave * 64 + cur_lane())

#define AMP_SPIN(k) do { if (PROBE_AMP == (k)) { __syncthreads(); const unsigned long long t0_ = *(volatile LAS unsigned long long*)(F.lds + MISC_OFF + 32), t1_ = __builtin_amdgcn_s_memrealtime(), tg_ = t1_ + 3ull * (t1_ - t0_); \
            while (__builtin_amdgcn_s_memrealtime() < tg_) __builtin_amdgcn_s_sleep(20); __syncthreads(); } \
        if (PROBE_AMP >= 0) { if (FTID(F) == 0) *(volatile LAS unsigned long long*)(F.lds + MISC_OFF + 32) = __builtin_amdgcn_s_memrealtime(); } } while (0)

__device__ __forceinline__ int rowmap(int mode, int n) { return mode == 0 ? n : ((n >> 7) * 256 + (n & 127) + (mode == 2 ? 128 : 0)); }
__device__ __forceinline__ void p0_transpose_item(const float* W, int K, int N, bf16* WT, int mode, LAS float* scr, int item, int lane) {
    const int nblk = (N + 63) / 64, kb = item / nblk, nb = item % nblk, k0 = 64 * kb, n0 = 64 * nb;
    const int nn = n0 + lane; const bool ok = nn < N;
    float tv[64];
#pragma unroll
    for (int i = 0; i < 64; ++i) tv[i] = ok ? W[(size_t)(k0 + i) * N + nn] : 0.f;
#pragma unroll
    for (int i = 0; i < 64; ++i) scr[i * 65 + lane] = tv[i];
    LDS_WAIT(); asm volatile("" ::: "memory");
    const int c = lane & 7;
#pragma unroll
    for (int j = 0; j < 8; ++j) { const int n = (lane >> 3) + 8 * j; const LAS float* s = scr + (8 * c) * 65 + n;
        u32x4 o; o.x = cvt_pk_bf16(s[0 * 65], s[1 * 65]); o.y = cvt_pk_bf16(s[2 * 65], s[3 * 65]); o.z = cvt_pk_bf16(s[4 * 65], s[5 * 65]); o.w = cvt_pk_bf16(s[6 * 65], s[7 * 65]);
        if (n0 + n < N) *(u32x4*)(WT + (size_t)rowmap(mode, n0 + n) * K + k0 + 8 * c) = o; }
    LDS_WAIT(); asm volatile("" ::: "memory");
}
__device__ __forceinline__ void p0_prologue(Frame& F, const Args& a) {
    const int gw = F.vcu * 8 + F.wave, NGW = F.G * 8, lane = cur_lane(), tid = FTID(F);
    float* ada = (float*)(F.ws + WS_ADA);
    {
        LAS float* sS = (LAS float*)F.lds;
        LAS float* sP = (LAS float*)(F.lds + 36864);
        bool staged = false;
        for (int it = blockIdx.x; it < 192; it += F.G) {
            if (!staged) {
                for (int i = tid; i < 9 * 1024; i += 512) { const int r = i >> 10, k = i & 1023; const float v = r < 8 ? a.in[1][r * 1024 + k] : a.in[3][k]; sS[i] = v / (1.f + __expf(-v)); }
                staged = true;
            }
            __syncthreads();
            const int n = it * 32 + (lane & 31), kh = lane >> 5, kb = F.wave * 128;
            float acc[9];
#pragma unroll
            for (int r = 0; r < 9; ++r) acc[r] = 0.f;
            const float* W = a.in[4];
            for (int jb = 0; jb < 64; jb += 16) {
                float wv[16];
#pragma unroll
                for (int j = 0; j < 16; ++j) wv[j] = W[(size_t)(kb + 2 * (jb + j) + kh) * 6144 + n];
#pragma unroll
                for (int j = 0; j < 16; ++j) { const int k = kb + 2 * (jb + j) + kh;
#pragma unroll
                    for (int r = 0; r < 9; ++r) acc[r] += sS[r * 1024 + k] * wv[j]; }
            }
#pragma unroll
            for (int r = 0; r < 9; ++r) { acc[r] += __shfl_xor(acc[r], 32); if (lane < 32) sP[(F.wave * 9 + r) * 32 + lane] = acc[r]; }
            __syncthreads();
            if (tid < 288) { const int r = tid >> 5, c = tid & 31; float s = a.in[5][it * 32 + c];
#pragma unroll
                for (int w = 0; w < 8; ++w) s += sP[(w * 9 + r) * 32 + c];
                ada[r * 6144 + it * 32 + c] = s; }
        }
        __syncthreads();
    }
    { float* rope = (float*)(F.ws + WS_ROPE);
      for (int i = blockIdx.x * 512 + tid; i < 128 * 32; i += F.G * 512) { const int pos = i >> 5, j = i & 31; const double ang = (double)pos * pow(10000.0, -(double)j / 32.0);
          rope[2 * i] = (float)cos(ang); rope[2 * i + 1] = (float)sin(ang); } }
    { bf16* wr = (bf16*)(F.ws + WS_WR);
      for (int i = blockIdx.x * 512 + tid; i < 80 * 1024; i += F.G * 512) { const int r = i >> 10, k = i & 1023; float v = 0.f;
          if (r < 8) v = a.in[15][k * 8 + r]; else if (r >= 16) v = a.in[17][k * 64 + (r - 16)];
          wr[i] = (bf16)(cvt_pk_bf16(v, 0.f) & 0xffffu); } }
    { u32x4* z = (u32x4*)((bf16*)(F.ws + WS_WIN) + (size_t)IN_COLS * 1024);
      for (int i = blockIdx.x * 512 + tid; i < (NZ - IN_COLS) * 1024 / 8; i += F.G * 512) z[i] = (u32x4){0u, 0u, 0u, 0u}; }
    LAS float* scr = (LAS float*)(F.lds + 16384 + F.wave * 16640);
    constexpr int B_IN = 4 * 29, B_OUT = 4 * 8, B_E = 16;
    constexpr int NBITEMS = B_IN + B_OUT + 3 * NEXP * B_E;
    const int wk = F.wave >> 1, wn = F.wave & 1;
    for (int bi = F.vcu; bi < NBITEMS; bi += F.G) {
        int r = bi;
        if (r < B_IN) { const int kb = 4 * (r / 29) + wk, nb = 2 * (r % 29) + wn; if (nb < 57) p0_transpose_item(a.in[6], 1024, IN_COLS, (bf16*)(F.ws + WS_WIN), 0, scr, kb * 57 + nb, lane); continue; } r -= B_IN;
        if (r < B_OUT) { const int kb = 4 * (r / 8) + wk, nb = 2 * (r % 8) + wn; p0_transpose_item(a.in[12], 1024, 1024, (bf16*)(F.ws + WS_WOUT), 0, scr, kb * 16 + nb, lane); continue; } r -= B_OUT;
        if (r < NEXP * B_E) { const int e = r >> 4, q = r & 15, kb = 4 * (q >> 2) + wk, nb = 2 * (q & 3) + wn; p0_transpose_item(a.in[19] + (size_t)e * 1024 * 512, 1024, 512, (bf16*)(F.ws + WS_W13) + (size_t)e * 1024 * 1024, 1, scr, kb * 8 + nb, lane); continue; } r -= NEXP * B_E;
        if (r < NEXP * B_E) { const int e = r >> 4, q = r & 15, kb = 4 * (q >> 2) + wk, nb = 2 * (q & 3) + wn; p0_transpose_item(a.in[20] + (size_t)e * 1024 * 512, 1024, 512, (bf16*)(F.ws + WS_W13) + (size_t)e * 1024 * 1024, 2, scr, kb * 8 + nb, lane); continue; } r -= NEXP * B_E;
        { const int e = r >> 4, q = r & 15, kb = 4 * (q >> 3) + wk, nb = 2 * (q & 7) + wn; p0_transpose_item(a.in[21] + (size_t)e * 512 * 1024, 512, 1024, (bf16*)(F.ws + WS_W2) + (size_t)e * 1024 * 512, 0, scr, kb * 16 + nb, lane); }
    }
}

__device__ __forceinline__ void p1_ln_mod(Frame& F, const Args& a) {
    const int gw = F.vcu * 8 + F.wave, NGW = F.G * 8, lane = opaque(cur_lane());
    const float* ada = (const float*)(F.ws + WS_ADA);
    bf16* XM = (bf16*)(F.ws + WS_XM);
    f32x4 shr[4], scr_[4]; int shb = -1;
    for (int m0 = gw; m0 < MT; m0 += 4 * NGW) {
        f32x4 v[4][4]; float s[4]; bool ok[4]; int mm[4];
#pragma unroll
        for (int r = 0; r < 4; ++r) { const int m = m0 + r * NGW; ok[r] = m < MT; mm[r] = ok[r] ? m : m0;
            const f32x4* xr = (const f32x4*)(mm[r] < ML_ROWS ? a.in[0] + (size_t)mm[r] * DM : a.in[2] + (size_t)(mm[r] - ML_ROWS) * DM) + lane;
#pragma unroll
            for (int j = 0; j < 4; ++j) v[r][j] = xr[64 * j]; }
#pragma unroll
        for (int r = 0; r < 4; ++r) { s[r] = 0.f;
#pragma unroll
            for (int j = 0; j < 4; ++j) s[r] += (v[r][j].x + v[r][j].y) + (v[r][j].z + v[r][j].w); }
        wave_sum4(s);
#pragma unroll
        for (int r = 0; r < 4; ++r) { const float mean = s[r] * (1.f / DM); s[r] = 0.f;
#pragma unroll
            for (int j = 0; j < 4; ++j) { v[r][j] = v[r][j] - mean; s[r] += (v[r][j].x * v[r][j].x + v[r][j].y * v[r][j].y) + (v[r][j].z * v[r][j].z + v[r][j].w * v[r][j].w); } }
        wave_sum4(s);
#pragma unroll
        for (int r = 0; r < 4; ++r) {
            const float rstd = frsq(s[r] * (1.f / DM) + LN_EPS);
            const int ab = mm[r] < ML_ROWS ? (mm[r] >> 13) : 8;
            if (ab != shb) { shb = ab; const f32x4* sh = (const f32x4*)(ada + ab * 6144) + lane;
#pragma unroll
                for (int j = 0; j < 4; ++j) { shr[j] = sh[64 * j]; scr_[j] = sh[256 + 64 * j]; } }
            u32x2* o8 = (u32x2*)(XM + (size_t)mm[r] * DM) + lane;
            if (ok[r]) {
#pragma unroll
                for (int j = 0; j < 4; ++j) { const f32x4 y = (v[r][j] * rstd) * (scr_[j] + 1.f) + shr[j];
                    o8[64 * j] = (u32x2){cvt_pk_bf16(y.x, y.y), cvt_pk_bf16(y.z, y.w)}; } }
        }
    }
}

struct EpiZ {
    static constexpr bool PERM = true;
    unsigned char* ws; const float* gate_b;
    __device__ __forceinline__ void operator()(const f32x4 (&acc)[2][2][4][2], const pg8::Unit& u, int wr, int wc, int fr, int fq) const {
        const int row0 = u.pm * 256 + wr * 64 + fr;
        if (u.pn < 14) {
            bf16* base; int ldc, colt;
            if (u.pn < 6) { base = (bf16*)(ws + WS_ZA); ldc = 1536; colt = u.pn * 256; }
            else if (u.pn < 10) { base = (bf16*)(ws + WS_ZQK); ldc = 1024; colt = (u.pn - 6) * 256; }
            else if (u.pn < 12) { base = (bf16*)(ws + WS_ZV); ldc = 512; colt = (u.pn - 10) * 256; }
            else { base = (bf16*)(ws + WS_ZO); ldc = 512; colt = (u.pn - 12) * 256; }
            const int col0 = colt + wc * 32 + 8 * fq;
#pragma unroll
            for (int ai = 0; ai < 2; ++ai)
#pragma unroll
                for (int m = 0; m < 4; ++m) { bf16* rowp = base + (size_t)(row0 + ai * 128 + m * 16) * ldc + col0;
#pragma unroll
                    for (int bj = 0; bj < 2; ++bj) { const f32x4 v0 = acc[ai][bj][m][0], v1 = acc[ai][bj][m][1];
                        u32x4 w; w.x = cvt_pk_bf16(v0[0], v0[1]); w.y = cvt_pk_bf16(v0[2], v0[3]); w.z = cvt_pk_bf16(v1[0], v1[1]); w.w = cvt_pk_bf16(v1[2], v1[3]);
                        *(u32x4*)(rowp + bj * 128) = w; } }
        } else if (wc == 0 && fq < 2) {
            float* G = (float*)(ws + WS_GATES);
            const f32x4 b0 = *(const f32x4*)(gate_b + 8 * fq), b1 = *(const f32x4*)(gate_b + 8 * fq + 4);
#pragma unroll
            for (int ai = 0; ai < 2; ++ai)
#pragma unroll
                for (int m = 0; m < 4; ++m) { float* rowp = G + (size_t)(row0 + ai * 128 + m * 16) * 16 + 8 * fq;
                    *(f32x4*)rowp = acc[ai][0][m][0] + b0; *(f32x4*)(rowp + 4) = acc[ai][0][m][1] + b1; }
        }
    }
};

__device__ __forceinline__ void p3_qkprep(Frame& F, const Args& a) {
    const int lane = cur_lane(), half = F.wave & 1;
    const int gwh = (F.vcu * 8 + F.wave) >> 1, NGH = F.G * 4;
    const bf16* ZQK = (const bf16*)(F.ws + WS_ZQK); bf16* QKP = (bf16*)(F.ws + WS_XM);
    const float* rope = (const float*)(F.ws + WS_ROPE);
    const int ch0 = half * 512 + 8 * lane, i0 = 8 * (lane & 3);
    const bool col_rot = ((lane >> 3) & 1) != 0, second = ((lane >> 2) & 1) != 0;
    float w[5][8], bia[8];
#pragma unroll
    for (int j = 0; j < 5; ++j) { const f32x4 w0 = *(const f32x4*)(a.in[7] + j * 1024 + ch0), w1 = *(const f32x4*)(a.in[7] + j * 1024 + ch0 + 4);
#pragma unroll
        for (int e = 0; e < 4; ++e) { w[j][e] = w0[e]; w[j][4 + e] = w1[e]; } }
    { const f32x4 b0 = *(const f32x4*)(a.in[8] + ch0), b1 = *(const f32x4*)(a.in[8] + ch0 + 4);
#pragma unroll
      for (int e = 0; e < 4; ++e) { bia[e] = b0[e]; bia[4 + e] = b1[e]; } }
    float cst[8], sst[8];
#pragma unroll
    for (int q = 0; q < 4; ++q) { const f32x4 t = *(const f32x4*)(rope + (size_t)(32 + i0 + 2 * q) * 2);
        cst[2 * q] = col_rot ? t.x : 1.f; sst[2 * q] = col_rot ? t.y : 0.f; cst[2 * q + 1] = col_rot ? t.z : 1.f; sst[2 * q + 1] = col_rot ? t.w : 0.f; }
    const float ksc = half ? 0.08838834764831845f : 1.f;
    constexpr int RUN = 8, NITEM = MT / RUN;
    for (int it = gwh; it < NITEM; it += NGH) {
        const int row0 = it * RUN;
        const bool lat = row0 < ML_ROWS;
        const int T = lat ? SEQ : CTXL, s0 = lat ? (row0 & (SEQ - 1)) : ((row0 - ML_ROWS) & (CTXL - 1));
        u32x4 win[12];
#pragma unroll
        for (int j = 0; j < 12; ++j) { const int s = s0 + j - 2; const bool ok = s >= 0 && s < T;
            win[j] = ok ? *(const u32x4*)(ZQK + (size_t)(row0 + j - 2) * 1024 + ch0) : (u32x4){0u, 0u, 0u, 0u}; }
        float cc[8], ss[8];
        if (lat) { const int pos = col_rot ? (s0 & 63) : (s0 >> 6);
#pragma unroll
            for (int q = 0; q < 4; ++q) { const f32x4 t = *(const f32x4*)(rope + (size_t)(pos * 32 + i0 + 2 * q) * 2); cc[2 * q] = t.x; ss[2 * q] = t.y; cc[2 * q + 1] = t.z; ss[2 * q + 1] = t.w; }
        } else {
#pragma unroll
            for (int e = 0; e < 8; ++e) { cc[e] = 1.f; ss[e] = 0.f; }
        }
#pragma unroll
        for (int r = 0; r < RUN; ++r) {
            float u[8];
#pragma unroll
            for (int e = 0; e < 8; ++e) u[e] = bia[e];
#pragma unroll
            for (int j = 0; j < 5; ++j)
#pragma unroll
                for (int q = 0; q < 4; ++q) { const unsigned x = win[r + j][q]; u[2 * q] += w[j][2 * q] * bf_lo(x); u[2 * q + 1] += w[j][2 * q + 1] * bf_hi(x); }
            u32x4 o;
            float v[8];
#pragma unroll
            for (int e = 0; e < 8; ++e) { const float sv = u[e] * __builtin_amdgcn_rcpf(1.f + __expf(-u[e])); const float ot = __shfl_xor(sv, 4);
                v[e] = (sv * cc[e] + ot * (second ? ss[e] : -ss[e])) * ksc; }
#pragma unroll
            for (int q = 0; q < 4; ++q) o[q] = cvt_pk_bf16(v[2 * q], v[2 * q + 1]);
            *(u32x4*)(QKP + (size_t)(row0 + r) * 1024 + ch0) = o;
            if (lat && r + 1 < RUN) {
#pragma unroll
                for (int e = 0; e < 8; ++e) { const float c2 = cc[e] * cst[e] - ss[e] * sst[e], s2 = ss[e] * cst[e] + cc[e] * sst[e]; cc[e] = c2; ss[e] = s2; }
            }
        }
    }
}

constexpr int NA_SLOTS = 11;
constexpr int NA_VR = 0, NA_VC = 90112, NA_KC = 122880, NA_RPB = 155648;
static_assert(NA_RPB + 2048 <= PH_BYTES, "NA LDS");
__device__ __forceinline__ int na_r0(int r) { return r - 4 < 0 ? 0 : (r - 4 > 120 ? 120 : r - 4); }
__device__ __forceinline__ void p3_na(Frame& F, const Args& a) {
    const int w = F.wave, lane = cur_lane(), tid = FTID(F), cg = w & 3, pr = w >> 2, g = lane >> 4, lq = lane & 15, qp = lq >> 2, pp = lane & 3;
    const bf16* ZA = (const bf16*)(F.ws + WS_ZA); bf16* MIX = (bf16*)(F.ws + WS_MIX);
    LAS unsigned char* VR = F.lds + NA_VR; LAS unsigned char* VC = F.lds + NA_VC; LAS unsigned char* KC = F.lds + NA_KC; LAS float* RPB = (LAS float*)(F.lds + NA_RPB);
    const int cs = cg == 0 ? 0 : (cg == 1 ? 8 : (cg == 2 ? 24 : 32));
    const int qc = 16 * cg + lq, c0q = qc - 8 < 0 ? 0 : (qc - 8 > 48 ? 48 : qc - 8);
    const int sw = (4 * g + qp) & 7;
    unsigned voff[4];
#pragma unroll
    for (int dt = 0; dt < 4; ++dt) voff[dt] = (unsigned)((((2 * dt + (pp >> 1)) ^ sw) * 16) + 8 * (pp & 1) + (4 * g + qp) * 128);
    const LAS unsigned char* vcb[4]; const LAS unsigned char* kcb[2];
#pragma unroll
    for (int dt = 0; dt < 4; ++dt) vcb[dt] = VC + voff[dt];
#pragma unroll
    for (int kk = 0; kk < 2; ++kk) kcb[kk] = KC + lq * 128 + (((4 * kk + g) ^ ((lq >> 1) & 7)) * 16);
    unsigned cooff[2][4];
#pragma unroll
    for (int tt = 0; tt < 2; ++tt)
#pragma unroll
        for (int j = 0; j < 4; ++j) { const int kc = cs + 16 * tt + 4 * g + j; const bool valid = kc >= c0q && kc < c0q + 16; cooff[tt][j] = (unsigned)((valid ? kc - qc + 15 : 31) * 4); }
    const float CE = 0.125f * 1.4426950408889634f;
    const int sc = tid >> 3, sch = tid & 7;
#define NA_EXP(x, nm_) __builtin_amdgcn_exp2f(__builtin_amdgcn_fmed3f(__builtin_fmaf((x), CE, (nm_)), -3.0e38f, 126.f))
#define NA_MM(kf0, kf1, q_, init) __builtin_amdgcn_mfma_f32_16x16x32_bf16((kf1), (q_)[1], __builtin_amdgcn_mfma_f32_16x16x32_bf16((kf0), (q_)[0], (init), 0, 0, 0), 0, 0, 0)
    for (int su = blockIdx.x; su < 256; su += F.G) {
        const int bh = su >> 2, head = bh & 7, b = bh >> 3, R0 = (su & 3) * 32;
        __syncthreads();
#pragma unroll
        for (int i = 0; i < 4; ++i) { const int idx = tid + 512 * i, key = idx >> 3, ch = idx & 7; const bf16* src = ZA + ((size_t)(ML_ROWS + b * CTXL + key)) * 1536 + head * 64 + ch * 8;
            *(LAS u32x4*)(KC + key * 128 + ((ch ^ ((key >> 1) & 7)) * 16)) = *(const u32x4*)(src + 512);
            *(LAS u32x4*)(VC + key * 128 + ((ch ^ (key & 7)) * 16)) = *(const u32x4*)(src + 1024); }
        { const int rw = tid >> 5, co = tid & 31; RPB[tid] = (rw < 15 && co < 31) ? 8.f * a.in[10][head * 465 + rw * 31 + co] : -1e30f; }
        int hw = na_r0(R0); const int hi0 = na_r0(R0 + 3) + 8;
        for (int rho = hw; rho < hi0; ++rho) *(LAS u32x4*)(VR + ((rho % NA_SLOTS) * 64 + sc) * 128 + ((sch ^ (sc & 7)) * 16)) = *(const u32x4*)(ZA + ((size_t)(b * SEQ + rho * 64 + sc)) * 1536 + 1024 + head * 64 + sch * 8);
        hw = hi0;
        __syncthreads();
        for (int q4 = 0; q4 < 8; ++q4) {
            const int rq = R0 + 4 * q4, ra = rq + 2 * pr, rb = ra + 1, rho0 = na_r0(ra), r0b = na_r0(rb);
            const int nhi = q4 < 7 ? na_r0(rq + 7) + 8 : hw, nnew = nhi - hw;
            u32x4 pre[4];
#pragma unroll
            for (int i = 0; i < 4; ++i) { const int rw_ = i < nnew ? hw + i : hw - 1; pre[i] = *(const u32x4*)(ZA + ((size_t)(b * SEQ + rw_ * 64 + sc)) * 1536 + 1024 + head * 64 + sch * 8); }
            const size_t qtA = (size_t)b * SEQ + ra * 64 + qc, qtB = qtA + 64;
            bf16x8 qA[2], qB[2];
#pragma unroll
            for (int kk = 0; kk < 2; ++kk) { qA[kk] = *(const bf16x8*)(ZA + qtA * 1536 + head * 64 + 32 * kk + 8 * g); qB[kk] = *(const bf16x8*)(ZA + qtB * 1536 + head * 64 + 32 * kk + 8 * g); }
            f32x4 oA[4], oB[4];
#pragma unroll
            for (int dt = 0; dt < 4; ++dt) { oA[dt] = (f32x4){0.f, 0.f, 0.f, 0.f}; oB[dt] = oA[dt]; }
            const f32x4 zero4 = (f32x4){0.f, 0.f, 0.f, 0.f};
            float nmA, nmB;
            {
                float mA = -1e30f, mB = -1e30f;
#pragma unroll
                for (int t = 0; t < 4; ++t) { const bf16x8 k0 = *(const LAS bf16x8*)(kcb[0] + t * 2048), k1 = *(const LAS bf16x8*)(kcb[1] + t * 2048);
                    const f32x4 sA = NA_MM(k0, k1, qA, zero4), sB = NA_MM(k0, k1, qB, zero4);
                    mA = fmaxf(mA, fmaxf(fmaxf(sA[0], sA[1]), fmaxf(sA[2], sA[3]))); mB = fmaxf(mB, fmaxf(fmaxf(sB[0], sB[1]), fmaxf(sB[2], sB[3]))); }
                mA = fmaxf(mA, __shfl_xor(mA, 16)); mA = fmaxf(mA, __shfl_xor(mA, 32)); mB = fmaxf(mB, __shfl_xor(mB, 16)); mB = fmaxf(mB, __shfl_xor(mB, 32));
                nmA = -mA * CE; nmB = -mB * CE;
            }
            float sumA = 0.f, sumB = 0.f;
#define NA_STEP(scA0, scA1, scB0, scB1, VB) do { float pA[8], pB[8]; \
        _Pragma("unroll") for (int j = 0; j < 4; ++j) { pA[j] = NA_EXP((scA0)[j], nmA); pA[4 + j] = NA_EXP((scA1)[j], nmA); pB[j] = NA_EXP((scB0)[j], nmB); pB[4 + j] = NA_EXP((scB1)[j], nmB); } \
        sumA += ((pA[0] + pA[1]) + (pA[2] + pA[3])) + ((pA[4] + pA[5]) + (pA[6] + pA[7])); sumB += ((pB[0] + pB[1]) + (pB[2] + pB[3])) + ((pB[4] + pB[5]) + (pB[6] + pB[7])); \
        const bf16x8 pfA = as_bf16x8((u32x4){cvt_pk_bf16(pA[0], pA[1]), cvt_pk_bf16(pA[2], pA[3]), cvt_pk_bf16(pA[4], pA[5]), cvt_pk_bf16(pA[6], pA[7])}); \
        const bf16x8 pfB = as_bf16x8((u32x4){cvt_pk_bf16(pB[0], pB[1]), cvt_pk_bf16(pB[2], pB[3]), cvt_pk_bf16(pB[4], pB[5]), cvt_pk_bf16(pB[6], pB[7])}); \
        _Pragma("unroll") for (int dt = 0; dt < 4; ++dt) { const bf16x8 vf = cat4((VB)[dt][0], (VB)[dt][1]); oA[dt] = __builtin_amdgcn_mfma_f32_16x16x32_bf16(vf, pfA, oA[dt], 0, 0, 0); oB[dt] = __builtin_amdgcn_mfma_f32_16x16x32_bf16(vf, pfB, oB[dt], 0, 0, 0); } } while (0)
            {
                bf16x8 kb[2][2][2]; bf16x4 vb[2][4][2];
#define NA_LDK(buf, p_) do { _Pragma("unroll") for (int u2 = 0; u2 < 2; ++u2) { kb[buf][u2][0] = *(const LAS bf16x8*)(kcb[0] + (2 * (p_) + u2) * 2048); kb[buf][u2][1] = *(const LAS bf16x8*)(kcb[1] + (2 * (p_) + u2) * 2048); } } while (0)
#define NA_LDV(buf, p_) do { _Pragma("unroll") for (int dt = 0; dt < 4; ++dt) { vb[buf][dt][0] = tr_read(vcb[dt] + (p_) * 4096); vb[buf][dt][1] = tr_read(vcb[dt] + (p_) * 4096 + 2048); } } while (0)
                NA_LDK(0, 0); NA_LDK(1, 1); NA_LDV(0, 0);
                f32x4 snA[2], snB[2];
#pragma unroll
                for (int u2 = 0; u2 < 2; ++u2) { snA[u2] = NA_MM(kb[0][u2][0], kb[0][u2][1], qA, zero4); snB[u2] = NA_MM(kb[0][u2][0], kb[0][u2][1], qB, zero4); }
#pragma unroll
                for (int kp = 0; kp < 8; ++kp) {
                    const f32x4 a0 = snA[0], a1 = snA[1], b0 = snB[0], b1 = snB[1];
                    __builtin_amdgcn_sched_barrier(0);
                    if (kp < 7) {
#pragma unroll
                        for (int u2 = 0; u2 < 2; ++u2) { snA[u2] = NA_MM(kb[(kp + 1) & 1][u2][0], kb[(kp + 1) & 1][u2][1], qA, zero4); snB[u2] = NA_MM(kb[(kp + 1) & 1][u2][0], kb[(kp + 1) & 1][u2][1], qB, zero4); } }
                    __builtin_amdgcn_sched_barrier(0);
                    if (kp < 6) NA_LDK(kp & 1, kp + 2);
                    if (kp < 7) NA_LDV((kp + 1) & 1, kp + 1);
                    __builtin_amdgcn_sched_barrier(0);
                    NA_STEP(a0, a1, b0, b1, vb[kp & 1]);
                    __builtin_amdgcn_sched_barrier(0);
                }
#undef NA_LDK
#undef NA_LDV
            }
            {
                const bf16* kbase = ZA + ((size_t)b * SEQ + rho0 * 64 + cs + lq) * 1536 + 512 + head * 64 + 8 * g;
                const int slot0 = rho0 % NA_SLOTS;
                bf16x8 kw[3][2][2]; bf16x4 vb[2][4][2]; f32x4 inA[2], inB[2];
#define NA_BROW_A(i) (((i) < 8) ? (rho0 + (i) - ra + 7) : 15)
#define NA_BROW_B(i) ((rho0 + (i) >= r0b && rho0 + (i) < r0b + 8) ? (rho0 + (i) - rb + 7) : 15)
#define NA_LDKW(buf, i) do { _Pragma("unroll") for (int tt = 0; tt < 2; ++tt) { kw[buf][tt][0] = *(const bf16x8*)(kbase + (size_t)((i) * 64 + tt * 16) * 1536); kw[buf][tt][1] = *(const bf16x8*)(kbase + (size_t)((i) * 64 + tt * 16) * 1536 + 32); } } while (0)
#define NA_LDVW(buf, i) do { int sl_ = slot0 + (i); sl_ = sl_ >= NA_SLOTS ? sl_ - NA_SLOTS : sl_; const LAS unsigned char* vr_ = VR + (sl_ * 64 + cs) * 128; \
        _Pragma("unroll") for (int dt = 0; dt < 4; ++dt) { vb[buf][dt][0] = tr_read(vr_ + voff[dt]); vb[buf][dt][1] = tr_read(vr_ + 2048 + voff[dt]); } } while (0)
#define NA_LDINI(i) do { const LAS unsigned char* rA_ = (const LAS unsigned char*)RPB + NA_BROW_A(i) * 128; const LAS unsigned char* rB_ = (const LAS unsigned char*)RPB + NA_BROW_B(i) * 128; \
        _Pragma("unroll") for (int tt = 0; tt < 2; ++tt) _Pragma("unroll") for (int j = 0; j < 4; ++j) { inA[tt][j] = *(const LAS float*)(rA_ + cooff[tt][j]); inB[tt][j] = *(const LAS float*)(rB_ + cooff[tt][j]); } } while (0)
                const int i9 = (r0b > rho0) ? 8 : 0;
                NA_LDKW(0, 0); NA_LDKW(1, 1); NA_LDKW(2, 2); NA_LDVW(0, 0); NA_LDINI(0);
                f32x4 snA[2], snB[2];
#pragma unroll
                for (int tt = 0; tt < 2; ++tt) { snA[tt] = NA_MM(kw[0][tt][0], kw[0][tt][1], qA, inA[tt]); snB[tt] = NA_MM(kw[0][tt][0], kw[0][tt][1], qB, inB[tt]); }
#pragma unroll
                for (int i = 0; i < 9; ++i) {
                    const f32x4 a0 = snA[0], a1 = snA[1], b0 = snB[0], b1 = snB[1];
                    if (i < 8) NA_LDINI(i + 1);
                    __builtin_amdgcn_sched_barrier(0);
                    if (i < 8) {
#pragma unroll
                        for (int tt = 0; tt < 2; ++tt) { snA[tt] = NA_MM(kw[(i + 1) % 3][tt][0], kw[(i + 1) % 3][tt][1], qA, inA[tt]); snB[tt] = NA_MM(kw[(i + 1) % 3][tt][0], kw[(i + 1) % 3][tt][1], qB, inB[tt]); } }
                    __builtin_amdgcn_sched_barrier(0);
                    if (i < 5) NA_LDKW(i % 3, i + 3);
                    if (i == 5) NA_LDKW(i % 3, i9);
                    if (i < 7) NA_LDVW((i + 1) & 1, i + 1);
                    if (i == 7) NA_LDVW((i + 1) & 1, i9);
                    __builtin_amdgcn_sched_barrier(0);
                    NA_STEP(a0, a1, b0, b1, vb[i & 1]);
                    __builtin_amdgcn_sched_barrier(0);
                }
#undef NA_BROW_A
#undef NA_BROW_B
#undef NA_LDKW
#undef NA_LDVW
#undef NA_LDINI
            }
#undef NA_STEP
            sumA += __shfl_xor(sumA, 16); sumA += __shfl_xor(sumA, 32); sumB += __shfl_xor(sumB, 16); sumB += __shfl_xor(sumB, 32);
            { const float ivA = frcp(sumA), ivB = frcp(sumB); bf16* opA = MIX + qtA * 1024 + head * 64 + 4 * g; bf16* opB = MIX + qtB * 1024 + head * 64 + 4 * g;
#pragma unroll
              for (int dt = 0; dt < 4; ++dt) { *(u32x2*)(opA + 16 * dt) = (u32x2){cvt_pk_bf16(oA[dt][0] * ivA, oA[dt][1] * ivA), cvt_pk_bf16(oA[dt][2] * ivA, oA[dt][3] * ivA)};
                  *(u32x2*)(opB + 16 * dt) = (u32x2){cvt_pk_bf16(oB[dt][0] * ivB, oB[dt][1] * ivB), cvt_pk_bf16(oB[dt][2] * ivB, oB[dt][3] * ivB)}; } }
            __syncthreads();
#pragma unroll
            for (int i = 0; i < 4; ++i) if (i < nnew) *(LAS u32x4*)(VR + (((hw + i) % NA_SLOTS) * 64 + sc) * 128 + ((sch ^ (sc & 7)) * 16)) = pre[i];
            hw = nhi;
            __syncthreads();
        }
    }
#undef NA_EXP
#undef NA_MM
    __syncthreads();
}

typedef float f32x16 __attribute__((ext_vector_type(16)));
constexpr int M2_QS = 0, M2_KS = 34816, M2_CT = 69632, M2_VS = 104448, M2_VEC = 145408;
constexpr int M2_RS = 272, M2_VR = 320;
static_assert(M2_VEC + 1040 * 4 <= PH_BYTES, "mLSTM LDS");
constexpr int REC_N = 16384, REC_S = 16512;
template <bool OUT>
__device__ __forceinline__ void mlstm_unit(Frame& F, const Args& a, const int sc, const int grp  , const bool FINAL) {
    const int w = F.wave, tid0 = opaque(FTID(F));
    int tid = tid0, lane = tid & 63, ln = lane & 31, h = lane >> 5, q4 = (lane & 15) >> 2, p4 = lane & 3, blk = (lane >> 4) & 1;
    const int dir = sc & 1, head = (sc >> 1) & 3, b = sc >> 3;
    const bf16* QKP = (const bf16*)(F.ws + WS_XM); const bf16* ZV = (const bf16*)(F.ws + WS_ZV); const float* GT = (const float*)(F.ws + WS_GATES);
    bf16* HB = (bf16*)(F.ws + WS_HB);
    float* REC = (float*)(F.ws + WS_MLST) + (size_t)sc * 9 * REC_FLOATS;
    LAS unsigned char* QS = F.lds + M2_QS; LAS unsigned char* KS = F.lds + M2_KS; LAS unsigned char* CT = F.lds + M2_CT; LAS unsigned char* VS = F.lds + M2_VS;
    LAS float* Va = (LAS float*)(F.lds + M2_VEC); LAS float* VA = Va + 128; LAS float* Vem = Va + 256; LAS float* Vin = Va + 384; LAS float* Vw = Va + 512; LAS float* Vn = Va + 640; LAS float* Vx = Va + 768; LAS float* Vs = Va + 1024;
    const int nch = grp < 0 ? 2 : 8;
    const int T = grp < 0 ? CTXL : SEQ;
    const size_t rowbase = grp < 0 ? (size_t)ML_ROWS + b * CTXL : (size_t)b * SEQ;
    const int sig0 = grp < 0 ? 0 : grp * 1024;
    const int tb = (int)((0x12032130u >> (4 * w)) & 3u), vh = w >> 2, db = w & 3;
    int trn = (8 * h + q4) * M2_VR + (16 * blk + 4 * p4) * 2;
    int trp = (4 * h + q4) * M2_VR + (16 * blk + 4 * p4) * 2;
    int trk = (8 * h + q4) * M2_RS + (16 * blk + 4 * p4) * 2;
    const bool nown = (vh == 0) && ((tid0 & 32) == 0);
    f32x16 Cacc[2]; float nreg = 0.f;
#pragma unroll
    for (int i = 0; i < 2; ++i)
#pragma unroll
        for (int r = 0; r < 16; ++r) Cacc[i][r] = 0.f;
    float m_prev = (grp < 0) ? 0.f : -1e30f, bsum = 0.f;
    if constexpr (OUT) {
        const float* R0 = REC;
        m_prev = R0[REC_S];
#pragma unroll
        for (int i = 0; i < 2; ++i)
#pragma unroll
            for (int qd = 0; qd < 4; ++qd) { const f32x4 t4 = *(const f32x4*)(R0 + (32 * (2 * vh + i) + ln) * 128 + 32 * db + 8 * qd + 4 * h);
                Cacc[i][4 * qd] = t4.x; Cacc[i][4 * qd + 1] = t4.y; Cacc[i][4 * qd + 2] = t4.z; Cacc[i][4 * qd + 3] = t4.w; }
        nreg = R0[REC_N + 32 * db + ln];
        for (int j = 0; j < grp; ++j) { const float* R = REC + (size_t)(1 + j) * REC_FLOATS; const float mj = R[REC_S], Bj = R[REC_S + 1];
            const float mn = fmaxf(Bj + m_prev, mj), f = __expf(Bj + m_prev - mn), gc = __expf(mj - mn);
#pragma unroll
            for (int i = 0; i < 2; ++i)
#pragma unroll
                for (int qd = 0; qd < 4; ++qd) { const f32x4 t4 = *(const f32x4*)(R + (32 * (2 * vh + i) + ln) * 128 + 32 * db + 8 * qd + 4 * h);
                    Cacc[i][4 * qd] = Cacc[i][4 * qd] * f + t4.x * gc; Cacc[i][4 * qd + 1] = Cacc[i][4 * qd + 1] * f + t4.y * gc; Cacc[i][4 * qd + 2] = Cacc[i][4 * qd + 2] * f + t4.z * gc; Cacc[i][4 * qd + 3] = Cacc[i][4 * qd + 3] * f + t4.w * gc; }
            nreg = nreg * f + R[REC_N + 32 * db + ln] * gc;
            m_prev = mn; }
    }
    __syncthreads();
    if constexpr (OUT) {
#pragma unroll
        for (int i = 0; i < 2; ++i)
#pragma unroll
            for (int qd = 0; qd < 4; ++qd) *(LAS u32x2*)(CT + (32 * (2 * vh + i) + ln) * M2_RS + (32 * db + 8 * qd + 4 * h) * 2) = (u32x2){cvt_pk_bf16(Cacc[i][4 * qd], Cacc[i][4 * qd + 1]), cvt_pk_bf16(Cacc[i][4 * qd + 2], Cacc[i][4 * qd + 3])};
        if (nown) Vn[32 * db + ln] = nreg;
    }
    u32x4 pq[4], pk[4], pv[4]; float gi0 = 0.f, gi1 = 0.f, gf0 = 0.f, gf1 = 0.f;
    const int gcol_i = (2 * dir) * 4 + head, gcol_f = (2 * dir + 1) * 4 + head;
#define ML_TOK(sig) (dir ? (T - 1 - (sig)) : (sig))
#define ML_LOAD(k) do { _Pragma("unroll") for (int j = 0; j < 4; ++j) { const int id = tid + 512 * j, row = id >> 4, ch = id & 15; const size_t gr = rowbase + ML_TOK(sig0 + (k) * 128 + row); \
            if (OUT) pq[j] = *(const u32x4*)(QKP + gr * 1024 + head * 128 + ch * 8); \
            pk[j] = *(const u32x4*)(QKP + gr * 1024 + 512 + head * 128 + ch * 8); pv[j] = *(const u32x4*)(ZV + gr * 512 + head * 128 + ch * 8); } \
        if (w == 0) { const size_t g0 = rowbase + ML_TOK(sig0 + (k) * 128 + 2 * lane), g1 = rowbase + ML_TOK(sig0 + (k) * 128 + 2 * lane + 1); \
            gi0 = GT[g0 * 16 + gcol_i]; gf0 = GT[g0 * 16 + gcol_f]; gi1 = GT[g1 * 16 + gcol_i]; gf1 = GT[g1 * 16 + gcol_f]; } } while (0)
    ML_LOAD(0);
    for (int k = 0; k < nch; ++k) {
        { const int z = *(volatile LAS int*)(F.lds + MISC_OFF + 48);
          tid = tid0 + z; lane = tid & 63; ln = lane & 31; h = lane >> 5; q4 = (lane & 15) >> 2; p4 = lane & 3; blk = (lane >> 4) & 1;
          trn = (8 * h + q4) * M2_VR + (16 * blk + 4 * p4) * 2; trp = (4 * h + q4) * M2_VR + (16 * blk + 4 * p4) * 2; trk = (8 * h + q4) * M2_RS + (16 * blk + 4 * p4) * 2; }
#pragma unroll
        for (int j = 0; j < 4; ++j) { const int id = tid + 512 * j, row = id >> 4, ch = id & 15;
            if (OUT) *(LAS u32x4*)(QS + row * M2_RS + ch * 16) = pq[j];
            *(LAS u32x4*)(KS + row * M2_RS + ch * 16) = pk[j]; *(LAS u32x4*)(VS + row * M2_VR + ch * 16) = pv[j]; }
        if (w == 0) {
            const float lf0 = fminf(gf0, 0.f) - log1pf(__expf(-fabsf(gf0))), lf1 = fminf(gf1, 0.f) - log1pf(__expf(-fabsf(gf1)));
            float P = lf0 + lf1;
#pragma unroll
            for (int o = 1; o < 64; o <<= 1) { const float t = __shfl_up(P, o); if (lane >= o) P += t; }
            const float b1 = P, b0 = P - lf1, a0 = gi0 - b0, a1 = gi1 - b1;
            float M = fmaxf(a0, a1);
#pragma unroll
            for (int o = 1; o < 64; o <<= 1) { const float t = __shfl_up(M, o); if (lane >= o) M = fmaxf(M, t); }
            float Mex = __shfl_up(M, 1); if (lane == 0) Mex = -1e30f;
            const float A0 = fmaxf(m_prev, fmaxf(Mex, a0)), A1 = fmaxf(m_prev, M);
            const float Aend = __shfl(A1, 63), bend = __shfl(b1, 63);
            *(LAS f32x2*)(Va + 2 * lane) = (f32x2){a0 * 1.4426950408889634f, a1 * 1.4426950408889634f}; *(LAS f32x2*)(VA + 2 * lane) = (f32x2){A0 * 1.4426950408889634f, A1 * 1.4426950408889634f};
            *(LAS f32x2*)(Vem + 2 * lane) = (f32x2){__expf(-(b0 + A0)), __expf(-(b1 + A1))};
            *(LAS f32x2*)(Vin + 2 * lane) = (f32x2){__expf(m_prev - A0), __expf(m_prev - A1)};
            *(LAS f32x2*)(Vw + 2 * lane) = (f32x2){__expf(a0 - Aend), __expf(a1 - Aend)};
            if (lane == 0) { Vs[0] = __expf(m_prev - Aend); Vs[1] = bend + Aend; Vs[2] = bend; }
        }
        const int knext = k + 1 < nch ? k + 1 : k;
        if constexpr (!OUT) { ML_LOAD(knext); }
        __syncthreads();
        const float decay = __builtin_bit_cast(float, __builtin_amdgcn_readfirstlane(__builtin_bit_cast(int, Vs[0]))), m_new = __builtin_bit_cast(float, __builtin_amdgcn_readfirstlane(__builtin_bit_cast(int, Vs[1])));
        if constexpr (!OUT) bsum += Vs[2];
        if constexpr (OUT) {
            const int t = 32 * tb + ln;
            const LAS unsigned char* qrow = QS + t * M2_RS + 16 * h;
            f32x16 acc[2];
#pragma unroll
            for (int i = 0; i < 2; ++i)
#pragma unroll
                for (int r = 0; r < 16; ++r) acc[i][r] = 0.f;
            const float it = Vin[t], At = VA[t];
            float qn = 0.f;
            {
                const LAS unsigned char* c0p = CT + (32 * (2 * vh) + ln) * M2_RS + 16 * h; const LAS unsigned char* c1p = c0p + 32 * M2_RS; const LAS float* np = Vn + 8 * h;
                bf16x8 qc = *(const LAS bf16x8*)(qrow), c0 = *(const LAS bf16x8*)(c0p), c1 = *(const LAS bf16x8*)(c1p);
#pragma unroll
                for (int ks = 0; ks < 8; ++ks) {
                    bf16x8 qx = qc, x0 = c0, x1 = c1;
                    const f32x4 n0 = *(const LAS f32x4*)(np + 16 * ks), n1 = *(const LAS f32x4*)(np + 16 * ks + 4);
                    if (ks < 7) { qx = *(const LAS bf16x8*)(qrow + 32 * (ks + 1)); x0 = *(const LAS bf16x8*)(c0p + 32 * (ks + 1)); x1 = *(const LAS bf16x8*)(c1p + 32 * (ks + 1)); }
                    __builtin_amdgcn_sched_barrier(0);
                    acc[0] = __builtin_amdgcn_mfma_f32_32x32x16_bf16(c0, qc, acc[0], 0, 0, 0);
                    acc[1] = __builtin_amdgcn_mfma_f32_32x32x16_bf16(c1, qc, acc[1], 0, 0, 0);
                    const u32x4 qu = __builtin_bit_cast(u32x4, qc);
                    qn += bf_lo(qu.x) * n0.x + bf_hi(qu.x) * n0.y + bf_lo(qu.y) * n0.z + bf_hi(qu.y) * n0.w + bf_lo(qu.z) * n1.x + bf_hi(qu.z) * n1.y + bf_lo(qu.w) * n1.z + bf_hi(qu.w) * n1.w;
                    __builtin_amdgcn_sched_barrier(0);
                    qc = qx; c0 = x0; c1 = x1;
                }
            }
#pragma unroll
            for (int i = 0; i < 2; ++i) acc[i] = acc[i] * it;
            float denp = 0.f;
#pragma unroll
            for (int sb = 0; sb < 4; ++sb) {
                if (sb <= tb) {
                    f32x16 sa;
#pragma unroll
                    for (int r = 0; r < 16; ++r) sa[r] = 0.f;
                    {
                        const LAS unsigned char* kp = KS + (32 * sb + ln) * M2_RS + 16 * h;
                        bf16x8 kc = *(const LAS bf16x8*)(kp), qc = *(const LAS bf16x8*)(qrow);
#pragma unroll
                        for (int ks = 0; ks < 8; ++ks) {
                            bf16x8 kx = kc, qx = qc;
                            if (ks < 7) { kx = *(const LAS bf16x8*)(kp + 32 * (ks + 1)); qx = *(const LAS bf16x8*)(qrow + 32 * (ks + 1)); }
                            __builtin_amdgcn_sched_barrier(0);
                            sa = __builtin_amdgcn_mfma_f32_32x32x16_bf16(kc, qc, sa, 0, 0, 0);
                            __builtin_amdgcn_sched_barrier(0);
                            kc = kx; qc = qx;
                        }
                    }
                    const LAS unsigned char* vr = VS + (32 * sb) * M2_VR + trp + 64 * (2 * vh);
                    const bf16x4 va00 = tr_read(vr), va01 = tr_read(vr + 8 * M2_VR), va10 = tr_read(vr + 64), va11 = tr_read(vr + 8 * M2_VR + 64);
                    u32x4 pw[2];
#pragma unroll
                    for (int qd = 0; qd < 4; ++qd) { const f32x4 av = *(const LAS f32x4*)(Va + 32 * sb + 8 * qd + 4 * h); float p[4];
#pragma unroll
                        for (int e = 0; e < 4; ++e) { const int s_ = 32 * sb + 8 * qd + 4 * h + e; const float pe = sa[4 * qd + e] * __builtin_amdgcn_exp2f(av[e] - At); p[e] = (sb < tb || s_ <= t) ? pe : 0.f; denp += p[e]; }
                        pw[qd >> 1][2 * (qd & 1)] = cvt_pk_bf16(p[0], p[1]); pw[qd >> 1][2 * (qd & 1) + 1] = cvt_pk_bf16(p[2], p[3]); }
                    { const bf16x8 pf0 = as_bf16x8(pw[0]), pf1 = as_bf16x8(pw[1]);
                      const bf16x4 vb00 = tr_read(vr + 16 * M2_VR), vb01 = tr_read(vr + 24 * M2_VR), vb10 = tr_read(vr + 16 * M2_VR + 64), vb11 = tr_read(vr + 24 * M2_VR + 64);
                      __builtin_amdgcn_sched_barrier(0);
                      acc[0] = __builtin_amdgcn_mfma_f32_32x32x16_bf16(cat4(va00, va01), pf0, acc[0], 0, 0, 0);
                      acc[1] = __builtin_amdgcn_mfma_f32_32x32x16_bf16(cat4(va10, va11), pf0, acc[1], 0, 0, 0);
                      acc[0] = __builtin_amdgcn_mfma_f32_32x32x16_bf16(cat4(vb00, vb01), pf1, acc[0], 0, 0, 0);
                      acc[1] = __builtin_amdgcn_mfma_f32_32x32x16_bf16(cat4(vb10, vb11), pf1, acc[1], 0, 0, 0); }
                }
            }
            denp += __shfl_xor(denp, 32); qn += __shfl_xor(qn, 32);
            const float den = denp + it * qn;
            const float rd = frcp(fmaxf(fabsf(den), Vem[t]));
            __syncthreads();
#pragma unroll
            for (int i = 0; i < 2; ++i)
#pragma unroll
                for (int qd = 0; qd < 4; ++qd) *(LAS u32x2*)(QS + t * M2_RS + (32 * (2 * vh + i) + 8 * qd + 4 * h) * 2) = (u32x2){cvt_pk_bf16(acc[i][4 * qd] * rd, acc[i][4 * qd + 1] * rd), cvt_pk_bf16(acc[i][4 * qd + 2] * rd, acc[i][4 * qd + 3] * rd)};
            __syncthreads();
            {
                const int vch = tid & 15;
                f32x4 gn0 = (f32x4){0.f, 0.f, 0.f, 0.f}, gn1 = gn0;
                if (FINAL) { gn0 = *(const f32x4*)(a.in[11] + head * 128 + 8 * vch); gn1 = *(const f32x4*)(a.in[11] + head * 128 + 8 * vch + 4); }
#pragma unroll
                for (int ps = 0; ps < 4; ++ps) {
                    const int tok = (tid >> 4) + 32 * ps;
                    const u32x4 xb = *(const LAS u32x4*)(QS + tok * M2_RS + vch * 16);
                    const size_t orow = rowbase + ML_TOK(sig0 + k * 128 + tok);
                    if (!FINAL) {
                        *(u32x4*)(HB + orow * 512 + head * 128 + 8 * vch) = xb;
                    } else {
                        const u32x4 hf = *(const u32x4*)(HB + orow * 512 + head * 128 + 8 * vch), zz = *(const u32x4*)((const bf16*)(F.ws + WS_ZO) + orow * 512 + head * 128 + 8 * vch);
                        float hv[8]; float ss = 0.f;
#pragma unroll
                        for (int q = 0; q < 4; ++q) { hv[2 * q] = bf_lo(xb[q]) + bf_lo(hf[q]); hv[2 * q + 1] = bf_hi(xb[q]) + bf_hi(hf[q]); ss += hv[2 * q] * hv[2 * q] + hv[2 * q + 1] * hv[2 * q + 1]; }
                        ss += __shfl_xor(ss, 1); ss += __shfl_xor(ss, 2); ss += __shfl_xor(ss, 4); ss += __shfl_xor(ss, 8);
                        const float rs = frsq(ss * (1.f / 128.f) + LN_EPS);
                        float ov[8];
#pragma unroll
                        for (int q = 0; q < 4; ++q) { const float g0 = q < 2 ? gn0[2 * q] : gn1[2 * q - 4], g1 = q < 2 ? gn0[2 * q + 1] : gn1[2 * q - 3];
                            ov[2 * q] = hv[2 * q] * rs * g0 * frcp(1.f + __expf(-bf_lo(zz[q]))); ov[2 * q + 1] = hv[2 * q + 1] * rs * g1 * frcp(1.f + __expf(-bf_hi(zz[q]))); }
                        *(u32x4*)((bf16*)(F.ws + WS_MIX) + orow * 1024 + 512 + head * 128 + 8 * vch) = (u32x4){cvt_pk_bf16(ov[0], ov[1]), cvt_pk_bf16(ov[2], ov[3]), cvt_pk_bf16(ov[4], ov[5]), cvt_pk_bf16(ov[6], ov[7])};
                    }
                }
            }
        }
        if constexpr (OUT) { ML_LOAD(knext); }
#pragma unroll
        for (int i = 0; i < 2; ++i) Cacc[i] = Cacc[i] * decay;
        float npart = 0.f;
        {
            const LAS unsigned char* kr = KS + trk + 64 * db; const LAS unsigned char* vr = VS + trn + 64 * (2 * vh); const LAS float* wp = Vw + 8 * h;
            bf16x4 k0 = tr_read(kr), k1 = tr_read(kr + 4 * M2_RS), v00 = tr_read(vr), v01 = tr_read(vr + 4 * M2_VR), v10 = tr_read(vr + 64), v11 = tr_read(vr + 4 * M2_VR + 64);
            f32x4 w0 = *(const LAS f32x4*)(wp), w1 = *(const LAS f32x4*)(wp + 4);
#pragma unroll
            for (int ks = 0; ks < 8; ++ks) {
                bf16x4 k0x = k0, k1x = k1, v00x = v00, v01x = v01, v10x = v10, v11x = v11; f32x4 w0x = w0, w1x = w1;
                if (ks < 7) { const LAS unsigned char* kn = kr + 16 * (ks + 1) * M2_RS; const LAS unsigned char* vn = vr + 16 * (ks + 1) * M2_VR;
                    k0x = tr_read(kn); k1x = tr_read(kn + 4 * M2_RS); v00x = tr_read(vn); v01x = tr_read(vn + 4 * M2_VR); v10x = tr_read(vn + 64); v11x = tr_read(vn + 4 * M2_VR + 64);
                    w0x = *(const LAS f32x4*)(wp + 16 * (ks + 1)); w1x = *(const LAS f32x4*)(wp + 16 * (ks + 1) + 4); }
                __builtin_amdgcn_sched_barrier(0);
                const u32x2 ku0 = __builtin_bit_cast(u32x2, k0), ku1 = __builtin_bit_cast(u32x2, k1);
                const float x0 = bf_lo(ku0.x) * w0[0], x1 = bf_hi(ku0.x) * w0[1], x2 = bf_lo(ku0.y) * w0[2], x3 = bf_hi(ku0.y) * w0[3];
                const float x4 = bf_lo(ku1.x) * w1[0], x5 = bf_hi(ku1.x) * w1[1], x6 = bf_lo(ku1.y) * w1[2], x7 = bf_hi(ku1.y) * w1[3];
                npart += ((x0 + x1) + (x2 + x3)) + ((x4 + x5) + (x6 + x7));
                const bf16x8 kf = as_bf16x8((u32x4){cvt_pk_bf16(x0, x1), cvt_pk_bf16(x2, x3), cvt_pk_bf16(x4, x5), cvt_pk_bf16(x6, x7)});
                Cacc[0] = __builtin_amdgcn_mfma_f32_32x32x16_bf16(kf, cat4(v00, v01), Cacc[0], 0, 0, 0);
                Cacc[1] = __builtin_amdgcn_mfma_f32_32x32x16_bf16(kf, cat4(v10, v11), Cacc[1], 0, 0, 0);
                __builtin_amdgcn_sched_barrier(0);
                k0 = k0x; k1 = k1x; v00 = v00x; v01 = v01x; v10 = v10x; v11 = v11x; w0 = w0x; w1 = w1x;
            }
        }
        npart += __shfl_xor(npart, 32);
        nreg = nreg * decay + npart;
        m_prev = m_new;
        __syncthreads();
        if constexpr (OUT) {
#pragma unroll
            for (int i = 0; i < 2; ++i)
#pragma unroll
                for (int qd = 0; qd < 4; ++qd) *(LAS u32x2*)(CT + (32 * (2 * vh + i) + ln) * M2_RS + (32 * db + 8 * qd + 4 * h) * 2) = (u32x2){cvt_pk_bf16(Cacc[i][4 * qd], Cacc[i][4 * qd + 1]), cvt_pk_bf16(Cacc[i][4 * qd + 2], Cacc[i][4 * qd + 3])};
            if (nown) Vn[32 * db + ln] = nreg;
        }
    }
#undef ML_LOAD
#undef ML_TOK
    if (OUT && !FINAL) { VM_WAIT(); __syncthreads(); }
    if constexpr (!OUT) {
        float* R = REC + (size_t)(grp < 0 ? 0 : 1 + grp) * REC_FLOATS;
#pragma unroll
        for (int i = 0; i < 2; ++i)
#pragma unroll
            for (int qd = 0; qd < 4; ++qd) *(f32x4*)(R + (32 * (2 * vh + i) + ln) * 128 + 32 * db + 8 * qd + 4 * h) = (f32x4){Cacc[i][4 * qd], Cacc[i][4 * qd + 1], Cacc[i][4 * qd + 2], Cacc[i][4 * qd + 3]};
        if (nown) R[REC_N + 32 * db + ln] = nreg;
        if (tid == 0) { R[REC_S] = m_prev; R[REC_S + 1] = bsum; }
    }
}

__device__ __forceinline__ void p6_readout(Frame& F, const Args& a) {
    const int gw = F.vcu * 8 + F.wave, NGW = F.G * 8, lane = cur_lane();
    const bf16* HB0 = (const bf16*)(F.ws + WS_HB); const bf16* HB1 = HB0 + (size_t)ML_ROWS * 512; const bf16* ZO = (const bf16*)(F.ws + WS_ZO);
    bf16* MIX = (bf16*)(F.ws + WS_MIX);
    const f32x4 g0 = *(const f32x4*)(a.in[11] + 8 * lane), g1 = *(const f32x4*)(a.in[11] + 8 * lane + 4);
    for (int m = gw; m < ML_ROWS; m += NGW) {
        const u32x4 hf = *(const u32x4*)(HB0 + (size_t)m * 512 + 8 * lane), hb = *(const u32x4*)(HB1 + (size_t)m * 512 + 8 * lane), zo = *(const u32x4*)(ZO + (size_t)m * 512 + 8 * lane);
        float h[8]; float ss = 0.f;
#pragma unroll
        for (int q = 0; q < 4; ++q) { h[2 * q] = bf_lo(hf[q]) + bf_lo(hb[q]); h[2 * q + 1] = bf_hi(hf[q]) + bf_hi(hb[q]); ss += h[2 * q] * h[2 * q] + h[2 * q + 1] * h[2 * q + 1]; }
        ss += __shfl_xor(ss, 1); ss += __shfl_xor(ss, 2); ss += __shfl_xor(ss, 4); ss += __shfl_xor(ss, 8);
        const float rs = frsq(ss * (1.f / 128.f) + LN_EPS);
        float o[8];
#pragma unroll
        for (int q = 0; q < 4; ++q) { const float z0 = bf_lo(zo[q]), z1 = bf_hi(zo[q]);
            o[2 * q] = h[2 * q] * rs * (q < 2 ? g0[2 * q] : g1[2 * q - 4]) / (1.f + __expf(-z0));
            o[2 * q + 1] = h[2 * q + 1] * rs * (q < 2 ? g0[2 * q + 1] : g1[2 * q - 3]) / (1.f + __expf(-z1)); }
        *(u32x4*)(MIX + (size_t)m * 1024 + 512 + 8 * lane) = (u32x4){cvt_pk_bf16(o[0], o[1]), cvt_pk_bf16(o[2], o[3]), cvt_pk_bf16(o[4], o[5]), cvt_pk_bf16(o[6], o[7])};
    }
}

struct EpiY1 {
    static constexpr bool PERM = true;
    const float* x; const float* ada; bf16* y1;
    __device__ __forceinline__ void operator()(const f32x4 (&acc)[2][2][4][2], const pg8::Unit& u, int wr, int wc, int fr, int fq) const {
        const int row0 = u.pm * 256 + wr * 64 + fr, col0 = u.pn * 256 + wc * 32 + 8 * fq;
        const float* g1 = ada + (size_t)(u.pm >> 5) * 6144 + 2048;
        f32x4 gv[2][2];
#pragma unroll
        for (int bj = 0; bj < 2; ++bj)
#pragma unroll
            for (int n = 0; n < 2; ++n) gv[bj][n] = *(const f32x4*)(g1 + col0 + bj * 128 + 4 * n);
#pragma unroll
        for (int ai = 0; ai < 2; ++ai)
#pragma unroll
            for (int m = 0; m < 4; ++m) { const size_t off = (size_t)(row0 + ai * 128 + m * 16) * 1024 + col0;
#pragma unroll
                for (int bj = 0; bj < 2; ++bj) { const f32x4 x0 = *(const f32x4*)(x + off + bj * 128), x1 = *(const f32x4*)(x + off + bj * 128 + 4);
                    const f32x4 v0 = x0 * DN_ALPHA + gv[bj][0] * acc[ai][bj][m][0], v1 = x1 * DN_ALPHA + gv[bj][1] * acc[ai][bj][m][1];
                    *(u32x4*)(y1 + off + bj * 128) = (u32x4){cvt_pk_bf16(v0[0], v0[1]), cvt_pk_bf16(v0[2], v0[3]), cvt_pk_bf16(v1[0], v1[1]), cvt_pk_bf16(v1[2], v1[3])}; } }
    }
};

constexpr int P8_LG = 0;
constexpr int P8_WRS = 1088;
constexpr int P8_REC = 87040;
__device__ __forceinline__ void p8_mid(Frame& F, const Args& a) {
    const int gw = F.vcu * 8 + F.wave, NGW = F.G * 8, lane = opaque(cur_lane()), tid = FTID(F), g = lane >> 4, lq = lane & 15;
    bf16* Y1 = (bf16*)(F.ws + WS_Y1); bf16* XM2 = (bf16*)(F.ws + WS_XM2);
    const float* ada = (const float*)(F.ws + WS_ADA); const bf16* WR = (const bf16*)(F.ws + WS_WR);
    LAS float* lg = (LAS float*)(F.lds + P8_LG) + F.wave * 2560;
    LAS unsigned* rec = (LAS unsigned*)(F.lds + P8_REC);
    LAS int* hist = (LAS int*)(F.lds + MISC_OFF + MS_HIST); LAS int* base = (LAS int*)(F.lds + MISC_OFF + MS_BASE);
    LAS float* rbias = (LAS float*)(F.lds + P8_REC + 16384);
    if (tid < 64) hist[tid] = 0;
    if (tid < 72) rbias[tid] = tid < 8 ? a.in[16][tid] : a.in[18][tid - 8];
    __syncthreads();
    const f32x4 l1g[4] = {((const f32x4*)a.in[13])[lane], ((const f32x4*)a.in[13])[lane + 64], ((const f32x4*)a.in[13])[lane + 128], ((const f32x4*)a.in[13])[lane + 192]};
    const f32x4 l1b[4] = {((const f32x4*)a.in[14])[lane], ((const f32x4*)a.in[14])[lane + 64], ((const f32x4*)a.in[14])[lane + 128], ((const f32x4*)a.in[14])[lane + 192]};
    const int NT16 = ML_ROWS / 16;
    int nloc = 0;
    const int npass = (NT16 + 2 * NGW - 1) / (2 * NGW);
    for (int ps = 0; ps < npass; ++ps, nloc += 2) {
        const int wt = gw + ps * 2 * NGW;
        const bool one = wt < NT16, two = wt + NGW < NT16;
        const int rowA = one ? wt * 16 : 0, rowB = two ? (wt + NGW) * 16 : rowA;
        f32x4 shr[4], scr_[4]; int shb = -1;
        for (int rr = 0; rr < (two ? 32 : (one ? 16 : 0)); rr += 4) {
            const int rowbase = (rr < 16 ? rowA : rowB) + (rr & 15);
            if ((rowbase >> 13) != shb) { shb = rowbase >> 13; const f32x4* sh2 = (const f32x4*)(ada + (size_t)shb * 6144 + 3072) + lane;
#pragma unroll
                for (int j = 0; j < 4; ++j) { shr[j] = sh2[64 * j]; scr_[j] = sh2[256 + 64 * j]; } }
            f32x4 v[4][4]; float sm[4];
#pragma unroll
            for (int r = 0; r < 4; ++r) { const u32x2* yr = (const u32x2*)(Y1 + (size_t)(rowbase + r) * 1024) + lane;
#pragma unroll
                for (int j = 0; j < 4; ++j) { const u32x2 pk = yr[64 * j]; v[r][j] = (f32x4){bf_lo(pk.x), bf_hi(pk.x), bf_lo(pk.y), bf_hi(pk.y)}; } }
#pragma unroll
            for (int r = 0; r < 4; ++r) { sm[r] = 0.f;
#pragma unroll
                for (int j = 0; j < 4; ++j) sm[r] += (v[r][j].x + v[r][j].y) + (v[r][j].z + v[r][j].w); }
            wave_sum4(sm);
#pragma unroll
            for (int r = 0; r < 4; ++r) { const float mean = sm[r] * (1.f / DM); sm[r] = 0.f;
#pragma unroll
                for (int j = 0; j < 4; ++j) { v[r][j] = v[r][j] - mean; sm[r] += (v[r][j].x * v[r][j].x + v[r][j].y * v[r][j].y) + (v[r][j].z * v[r][j].z + v[r][j].w * v[r][j].w); } }
            wave_sum4(sm);
#pragma unroll
            for (int r = 0; r < 4; ++r) { const float rstd = frsq(sm[r] * (1.f / DM) + LN_EPS); sm[r] = 0.f;
#pragma unroll
                for (int j = 0; j < 4; ++j) { v[r][j] = (v[r][j] * rstd) * l1g[j] + l1b[j]; sm[r] += (v[r][j].x + v[r][j].y) + (v[r][j].z + v[r][j].w); } }
            wave_sum4(sm);
#pragma unroll
            for (int r = 0; r < 4; ++r) { const float mean = sm[r] * (1.f / DM); sm[r] = 0.f;
#pragma unroll
                for (int j = 0; j < 4; ++j) { v[r][j] = v[r][j] - mean; sm[r] += (v[r][j].x * v[r][j].x + v[r][j].y * v[r][j].y) + (v[r][j].z * v[r][j].z + v[r][j].w * v[r][j].w); } }
            wave_sum4(sm);
#pragma unroll
            for (int r = 0; r < 4; ++r) { const float rstd = frsq(sm[r] * (1.f / DM) + LN_EPS);
                u32x2* o8 = (u32x2*)(XM2 + (size_t)(rowbase + r) * 1024) + lane;
#pragma unroll
                for (int j = 0; j < 4; ++j) { const f32x4 y = (v[r][j] * rstd) * (scr_[j] + 1.f) + shr[j];
                    o8[64 * j] = (u32x2){cvt_pk_bf16(y.x, y.y), cvt_pk_bf16(y.z, y.w)}; } }
        }
        VM_WAIT();
        AMP_SPIN(80);
        f32x4 la[2][5];
#pragma unroll
        for (int t2 = 0; t2 < 2; ++t2)
#pragma unroll
            for (int nt = 0; nt < 5; ++nt) la[t2][nt] = (f32x4){0.f, 0.f, 0.f, 0.f};
        const bf16* xpA = XM2 + (size_t)(rowA + lq) * 1024 + 8 * g; const bf16* xpB = XM2 + (size_t)(rowB + lq) * 1024 + 8 * g;
        LAS unsigned char* WH = F.lds + P8_LG;
        for (int hf = 0; hf < 2; ++hf) {
            __syncthreads();
#pragma unroll
            for (int i = 0; i < 10; ++i) { const int idx = tid + 512 * i, row = idx >> 6, ch = idx & 63;
                *(LAS u32x4*)(WH + row * P8_WRS + ch * 16) = *(const u32x4*)(WR + (size_t)row * 1024 + hf * 512 + ch * 8); }
            __syncthreads();
            const LAS unsigned char* wl = WH + lq * P8_WRS + 16 * g;
#pragma unroll 4
            for (int kk = 0; kk < 16; ++kk) {
                const bf16x8 xfA = __builtin_nontemporal_load((const bf16x8*)(xpA + hf * 512 + 32 * kk)), xfB = __builtin_nontemporal_load((const bf16x8*)(xpB + hf * 512 + 32 * kk));
#pragma unroll
                for (int nt = 0; nt < 5; ++nt) { const bf16x8 wf = *(const LAS bf16x8*)(wl + nt * 16 * P8_WRS + 64 * kk);
                    la[0][nt] = __builtin_amdgcn_mfma_f32_16x16x32_bf16(wf, xfA, la[0][nt], 0, 0, 0);
                    la[1][nt] = __builtin_amdgcn_mfma_f32_16x16x32_bf16(wf, xfB, la[1][nt], 0, 0, 0); }
            }
        }
        __syncthreads();
#pragma unroll
        for (int t2 = 0; t2 < 2; ++t2)
#pragma unroll
            for (int nt = 0; nt < 5; ++nt) *(LAS f32x4*)(lg + (16 * t2 + lq) * 80 + 16 * nt + 4 * g) = la[t2][nt];
        LDS_WAIT();
        if ((lane < 16 && one) || (lane >= 16 && lane < 32 && two)) {
            const LAS float* L = lg + lane * 80;
            float gl[8]; float gm = -1e30f; int gi = 0;
#pragma unroll
            for (int i = 0; i < 8; ++i) { gl[i] = L[i] + rbias[i]; if (gl[i] > gm) { gm = gl[i]; gi = i; } }
            float gs = 0.f;
#pragma unroll
            for (int i = 0; i < 8; ++i) gs += __expf(gl[i] - gm);
            const float pg = 1.f / gs;
            float v1 = -1e30f, v2 = -1e30f; int i1 = 0, i2 = 0;
#pragma unroll
            for (int i = 0; i < 8; ++i) { const float e = L[16 + gi * 8 + i] + rbias[8 + gi * 8 + i];
                if (e > v1) { v2 = v1; i2 = i1; v1 = e; i1 = i; } else if (e > v2) { v2 = e; i2 = i; } }
            const float ex = __expf(v2 - v1), wA = pg / (1.f + ex), wB = pg * ex / (1.f + ex);
            const int eA = gi * 8 + i1, eB = gi * 8 + i2;
            const int pA = __hip_atomic_fetch_add(&hist[eA], 1, __ATOMIC_RELAXED, __HIP_MEMORY_SCOPE_WORKGROUP), pB = __hip_atomic_fetch_add(&hist[eB], 1, __ATOMIC_RELAXED, __HIP_MEMORY_SCOPE_WORKGROUP);
            LAS unsigned* rc = rec + (((nloc + (lane >> 4)) * 8 + F.wave) * 16 + (lane & 15)) * 8;
            rc[0] = (unsigned)eA; rc[1] = (unsigned)pA; rc[2] = (unsigned)eB; rc[3] = (unsigned)pB; rc[4] = __float_as_uint(wA); rc[5] = __float_as_uint(wB); rc[6] = (unsigned)((lane < 16 ? rowA : rowB) + (lane & 15));
        }
        AMP_SPIN(81);
    }
    __syncthreads();
    if (tid < 64) base[tid] = (int)__hip_atomic_fetch_add(F.ctl + CW_CNT + 16 * tid, (unsigned)hist[tid], RLX_AGENT);
    __syncthreads();
    {
        int* TOKL = (int*)(F.ws + WS_TOKL); u32x4* ROUTE = (u32x4*)(F.ws + WS_ROUTE);
        const int ntile_max = (ML_ROWS / 16 + NGW - 1) / NGW;
        for (int i = tid; i < ntile_max * 128; i += 512) {
            const int nl = i >> 7, wv = (i >> 4) & 7;
            if ((long)(F.vcu * 8 + wv) + (long)nl * NGW >= ML_ROWS / 16) continue;
            const LAS unsigned* rc = rec + i * 8;
            const int eA = (int)rc[0], pA = (int)rc[1] + base[rc[0]], eB = (int)rc[2], pB = (int)rc[3] + base[rc[2]], tok = (int)rc[6];
            TOKL[(size_t)eA * 65536 + pA] = tok; TOKL[(size_t)eB * 65536 + pB] = tok;
            ROUTE[tok] = (u32x4){((unsigned)eA << 20) | (unsigned)pA, ((unsigned)eB << 20) | (unsigned)pB, rc[4], rc[5]};
        }
    }
}

__device__ __forceinline__ void moe_tables(Frame& F) {
    LAS int* cnt = (LAS int*)(F.lds + MISC_OFF + MS_CNT); LAS int* start = (LAS int*)(F.lds + MISC_OFF + MS_START); LAS int* tstart = (LAS int*)(F.lds + MISC_OFF + MS_TSTART);
    __syncthreads();
    if (FTID(F) < 64) cnt[FTID(F)] = (int)__hip_atomic_load(F.ctl + CW_CNT + 16 * FTID(F), RLX_AGENT);
    __syncthreads();
    if (FTID(F) == 0) { int s = 0, t = 0; for (int e = 0; e < 64; ++e) { start[e] = s; tstart[e] = t; s += cnt[e]; t += (cnt[e] + 255) >> 8; } start[64] = s; tstart[64] = t; }
    __syncthreads();
}
struct MoeOrder {
    const LAS int* cnt; const LAS int* start; const LAS int* tstart; int G, c;
    __device__ __forceinline__ bool next(int i, pg8::Unit& u) const {
        const int tile = i * (G >> 2) + (c & 7) + 8 * (c >> 5), pnn = (c >> 3) & 3;
        if (tile >= tstart[64]) return false;
        int e = 0;
        for (int s = 32; s >= 1; s >>= 1) if (tstart[e + s] <= tile) e += s;
        while (cnt[e] == 0) --e;
        u.e = e; u.pm = tile - tstart[e]; u.pn = pnn; const int rem = cnt[e] - u.pm * 256; u.cnt = rem < 256 ? rem : 256; return true;
    }
};
struct MoeSched1 {
    static constexpr bool GATHER = true;
    MoeOrder ord; const char* XM2; const char* W13; const int* TOKL;
    __device__ __forceinline__ bool next(int i, pg8::Unit& u) const { return ord.next(i, u); }
    __device__ __forceinline__ const char* a_ptr(const pg8::Unit&) const { return XM2; }
    __device__ __forceinline__ const char* b_ptr(const pg8::Unit& u) const { return W13 + ((size_t)u.e * 1024 + (size_t)u.pn * 256) * 2048; }
    __device__ __forceinline__ void a_voff(const pg8::Unit& u, unsigned (&v)[2][2], int tid) const {
        int R0, R1, C0, C1; pg8::stage_rc(tid * 16, R0, C0); pg8::stage_rc(tid * 16 + 8192, R1, C1);
        const int* tl = TOKL + (size_t)u.e * 65536 + u.pm * 256;
#pragma unroll
        for (int h = 0; h < 2; ++h) { const int r0 = h * 128 + R0, r1 = h * 128 + R1;
            const int t0 = r0 < u.cnt ? tl[r0] : 0, t1 = r1 < u.cnt ? tl[r1] : 0;
            v[h][0] = (unsigned)t0 * 2048u + (unsigned)C0 * 2u; v[h][1] = (unsigned)t1 * 2048u + (unsigned)C1 * 2u; }
    }
};
struct MoeSched2 {
    static constexpr bool GATHER = false;
    MoeOrder ord; const char* H; const char* W2;
    __device__ __forceinline__ bool next(int i, pg8::Unit& u) const { return ord.next(i, u); }
    __device__ __forceinline__ const char* a_ptr(const pg8::Unit& u) const { return H + (size_t)(ord.start[u.e] + u.pm * 256) * 1024; }
    __device__ __forceinline__ const char* b_ptr(const pg8::Unit& u) const { return W2 + ((size_t)u.e * 1024 + (size_t)u.pn * 256) * 1024; }
    __device__ __forceinline__ void a_voff(const pg8::Unit&, unsigned (&)[2][2], int) const {}
};
struct EpiH {
    static constexpr bool PERM = true;
    bf16* H; const LAS int* start;
    __device__ __forceinline__ void operator()(const f32x4 (&acc)[2][2][4][2], const pg8::Unit& u, int wr, int wc, int fr, int fq) const {
        const int r0 = wr * 64 + fr; const size_t slot0 = (size_t)start[u.e] + u.pm * 256;
        const int col0 = u.pn * 128 + wc * 32 + 8 * fq;
#pragma unroll
        for (int ai = 0; ai < 2; ++ai)
#pragma unroll
            for (int m = 0; m < 4; ++m) { const int r = r0 + ai * 128 + m * 16;
                if (r < u.cnt) { float o[8];
#pragma unroll
                    for (int n = 0; n < 2; ++n)
#pragma unroll
                        for (int j = 0; j < 4; ++j) { const float h1 = acc[ai][0][m][n][j], h3 = acc[ai][1][m][n][j]; o[4 * n + j] = h1 * frcp(1.f + __expf(-h1)) * h3; }
                    *(u32x4*)(H + (slot0 + r) * 512 + col0) = (u32x4){cvt_pk_bf16(o[0], o[1]), cvt_pk_bf16(o[2], o[3]), cvt_pk_bf16(o[4], o[5]), cvt_pk_bf16(o[6], o[7])}; } }
    }
};
struct EpiY {
    static constexpr bool PERM = true;
    bf16* Y; const LAS int* start;
    __device__ __forceinline__ void operator()(const f32x4 (&acc)[2][2][4][2], const pg8::Unit& u, int wr, int wc, int fr, int fq) const {
        const int r0 = wr * 64 + fr; const size_t slot0 = (size_t)start[u.e] + u.pm * 256;
        const int col0 = u.pn * 256 + wc * 32 + 8 * fq;
#pragma unroll
        for (int ai = 0; ai < 2; ++ai)
#pragma unroll
            for (int m = 0; m < 4; ++m) { const int r = r0 + ai * 128 + m * 16;
                if (r < u.cnt) {
#pragma unroll
                    for (int bj = 0; bj < 2; ++bj) { const f32x4 v0 = acc[ai][bj][m][0], v1 = acc[ai][bj][m][1];
                        *(u32x4*)(Y + (slot0 + r) * 1024 + col0 + bj * 128) = (u32x4){cvt_pk_bf16(v0[0], v0[1]), cvt_pk_bf16(v0[2], v0[3]), cvt_pk_bf16(v1[0], v1[1]), cvt_pk_bf16(v1[2], v1[3])}; } } }
    }
};

__device__ __forceinline__ void p11_final(Frame& F, const Args& a) {
    const int gw = F.vcu * 8 + F.wave, NGW = F.G * 8, lane = opaque(cur_lane());
    const bf16* XMID = (const bf16*)(F.ws + WS_Y1); const bf16* Y = (const bf16*)(F.ws + WS_YMOE); const u32x4* ROUTE = (const u32x4*)(F.ws + WS_ROUTE);
    const float* ada = (const float*)(F.ws + WS_ADA);
    const LAS int* start = (const LAS int*)(F.lds + MISC_OFF + MS_START);
    f32x4 l1g[4], l1b[4], l2g[4], l2b[4], g2r[4]; int g2b = -1;
#pragma unroll
    for (int j = 0; j < 4; ++j) { l1g[j] = ((const f32x4*)a.in[13])[lane + 64 * j]; l1b[j] = ((const f32x4*)a.in[14])[lane + 64 * j]; l2g[j] = ((const f32x4*)a.in[22])[lane + 64 * j]; l2b[j] = ((const f32x4*)a.in[23])[lane + 64 * j]; }
    for (int m0 = gw; m0 < ML_ROWS; m0 += 2 * NGW) {
        f32x4 v[2][4], mo[2][4]; float sm[2]; bool ok[2]; int mm[2];
        u32x4 rt[2];
#pragma unroll
        for (int r = 0; r < 2; ++r) { const int m = m0 + r * NGW; ok[r] = m < ML_ROWS; mm[r] = ok[r] ? m : m0; rt[r] = ROUTE[mm[r]]; }
#pragma unroll
        for (int r = 0; r < 2; ++r) {
            const size_t sA = (size_t)start[rt[r].x >> 20] + (rt[r].x & 0xfffffu), sB = (size_t)start[rt[r].y >> 20] + (rt[r].y & 0xfffffu);
            const float wA = __uint_as_float(rt[r].z), wB = __uint_as_float(rt[r].w);
            const u32x2* xr = (const u32x2*)(XMID + (size_t)mm[r] * 1024) + lane; const u32x2* ya = (const u32x2*)(Y + sA * 1024) + lane; const u32x2* yb = (const u32x2*)(Y + sB * 1024) + lane;
            if ((mm[r] >> 13) != g2b) { g2b = mm[r] >> 13; const f32x4* g2 = (const f32x4*)(ada + (size_t)g2b * 6144 + 5120) + lane;
#pragma unroll
                for (int j = 0; j < 4; ++j) g2r[j] = g2[64 * j]; }
            sm[r] = 0.f;
#pragma unroll
            for (int j = 0; j < 4; ++j) { const u32x2 xp = xr[64 * j], pa = ya[64 * j], pb = yb[64 * j]; const f32x4 gg = g2r[j];
                v[r][j] = (f32x4){bf_lo(xp.x), bf_hi(xp.x), bf_lo(xp.y), bf_hi(xp.y)};
                mo[r][j].x = (wA * bf_lo(pa.x) + wB * bf_lo(pb.x)) * gg.x; mo[r][j].y = (wA * bf_hi(pa.x) + wB * bf_hi(pb.x)) * gg.y;
                mo[r][j].z = (wA * bf_lo(pa.y) + wB * bf_lo(pb.y)) * gg.z; mo[r][j].w = (wA * bf_hi(pa.y) + wB * bf_hi(pb.y)) * gg.w;
                sm[r] += (v[r][j].x + v[r][j].y) + (v[r][j].z + v[r][j].w); }
        }
        wave_sumN<2>(sm);
#pragma unroll
        for (int r = 0; r < 2; ++r) { const float mean = sm[r] * (1.f / DM); sm[r] = 0.f;
#pragma unroll
            for (int j = 0; j < 4; ++j) { v[r][j] = v[r][j] - mean; sm[r] += (v[r][j].x * v[r][j].x + v[r][j].y * v[r][j].y) + (v[r][j].z * v[r][j].z + v[r][j].w * v[r][j].w); } }
        wave_sumN<2>(sm);
#pragma unroll
        for (int r = 0; r < 2; ++r) { const float rstd = frsq(sm[r] * (1.f / DM) + LN_EPS); sm[r] = 0.f;
#pragma unroll
            for (int j = 0; j < 4; ++j) {
                v[r][j] = ((v[r][j] * rstd) * l1g[j] + l1b[j]) * DN_ALPHA + mo[r][j]; sm[r] += (v[r][j].x + v[r][j].y) + (v[r][j].z + v[r][j].w); } }
        wave_sumN<2>(sm);
#pragma unroll
        for (int r = 0; r < 2; ++r) { const float mean = sm[r] * (1.f / DM); sm[r] = 0.f;
#pragma unroll
            for (int j = 0; j < 4; ++j) { v[r][j] = v[r][j] - mean; sm[r] += (v[r][j].x * v[r][j].x + v[r][j].y * v[r][j].y) + (v[r][j].z * v[r][j].z + v[r][j].w * v[r][j].w); } }
        wave_sumN<2>(sm);
#pragma unroll
        for (int r = 0; r < 2; ++r) { const float rstd = frsq(sm[r] * (1.f / DM) + LN_EPS);
            f32x4* o = (f32x4*)(a.out + (size_t)mm[r] * 1024) + lane;
            if (ok[r]) {
#pragma unroll
                for (int j = 0; j < 4; ++j) o[64 * j] = (v[r][j] * rstd) * l2g[j] + l2b[j]; }
        }
    }
}

__global__ void __launch_bounds__(512, 2) mk_fwd(Args args) {
    extern __shared__ __attribute__((aligned(16))) unsigned char lds_raw[];
    Frame F;
    F.lds = (LAS unsigned char*)lds_raw; F.ws = args.ws; F.ctl = (unsigned*)(args.ws + WS_CTL);
    F.wave = __builtin_amdgcn_readfirstlane((int)threadIdx.x >> 6);
    F.G = gridDim.x; { const int bx = blockIdx.x; F.vcu = (F.G % 8 == 0) ? (bx % 8) * (F.G / 8) + bx / 8 : bx; }
    for (int u = FTID(F); u < (LDS_BYTES - MISC_OFF) / 4; u += 512) ((LAS unsigned*)(F.lds + MISC_OFF))[u] = 0u;
    __syncthreads();
    XcdBarrier bar; bar.bar = F.ctl + CW_BAR; bar.x = 0; bar.st = nullptr;
    if (MK_N_LAUNCHES == 1) bar = xcd_barrier_post(F.ctl + CW_BAR, (volatile LAS unsigned*)(F.lds + MISC_OFF));
    const int lo = args.ph_lo, hi = args.ph_hi;
#define IN(k) (lo <= (k) && (k) < hi)
#define SEAM(k) do { if (IN(k) && IN((k) + 1)) xcd_barrier(bar); AMP_SPIN(k); } while (0)
    if (PROBE_AMP >= 0) { if (FTID(F) == 0) *(volatile LAS unsigned long long*)(F.lds + MISC_OFF + 32) = __builtin_amdgcn_s_memrealtime(); }

    if (IN(0)) { p0_prologue(F, args); } SEAM(0);
    if (IN(1)) { p1_ln_mod(F, args); } SEAM(1);
    if (IN(2)) {
        pg8::DenseSched S; S.A = (const char*)(F.ws + WS_XM); S.Bt = (const char*)(F.ws + WS_WIN); S.K = 1024; S.ord.init(MT, NZ, F.G, (int)blockIdx.x);
        EpiZ E{F.ws, args.in[9]};
        pg8::gemm_phase<EpiZ, pg8::DenseSched>(F.lds, 1024, S, E);
    } SEAM(2);
    if (IN(3)) { if (args.pad != 2) p3_qkprep(F, args); if (args.pad != 1) p3_na(F, args); } SEAM(3);
    if (IN(4)) {
        for (int u = blockIdx.x; u < 576; u += F.G) { if (u < 512) mlstm_unit<false>(F, args, u >> 3, u & 7, false); else mlstm_unit<false>(F, args, u - 512, -1, false); }
    } SEAM(4);
    if (IN(5)) {
        for (int u = blockIdx.x; u < 256; u += F.G) { const int bh = u >> 3, gt = u & 7; for (int ps = 0; ps < 2; ++ps) mlstm_unit<true>(F, args, bh * 2 + ps, ps ? 7 - gt : gt, ps != 0); }
    } SEAM(5);
    if (IN(7)) {
        pg8::DenseSched S; S.A = (const char*)(F.ws + WS_MIX); S.Bt = (const char*)(F.ws + WS_WOUT); S.K = 1024; S.ord.init(ML_ROWS, 1024, F.G, (int)blockIdx.x);
        EpiY1 E{args.in[0], (const float*)(F.ws + WS_ADA), (bf16*)(F.ws + WS_Y1)};
        pg8::gemm_phase<EpiY1, pg8::DenseSched>(F.lds, 1024, S, E);
    } SEAM(7);
    if (IN(8)) { p8_mid(F, args); } SEAM(8);
    if (IN(9)) {
        moe_tables(F);
        MoeSched1 S; S.ord = MoeOrder{(const LAS int*)(F.lds + MISC_OFF + MS_CNT), (const LAS int*)(F.lds + MISC_OFF + MS_START), (const LAS int*)(F.lds + MISC_OFF + MS_TSTART), F.G, (int)blockIdx.x};
        S.XM2 = (const char*)(F.ws + WS_XM2); S.W13 = (const char*)(F.ws + WS_W13); S.TOKL = (const int*)(F.ws + WS_TOKL);
        EpiH E{(bf16*)(F.ws + WS_HMOE), (const LAS int*)(F.lds + MISC_OFF + MS_START)};
        pg8::gemm_phase<EpiH, MoeSched1>(F.lds, 1024, S, E);
    } SEAM(9);
    if (IN(10)) {
        moe_tables(F);
        MoeSched2 S; S.ord = MoeOrder{(const LAS int*)(F.lds + MISC_OFF + MS_CNT), (const LAS int*)(F.lds + MISC_OFF + MS_START), (const LAS int*)(F.lds + MISC_OFF + MS_TSTART), F.G, (int)blockIdx.x};
        S.H = (const char*)(F.ws + WS_HMOE); S.W2 = (const char*)(F.ws + WS_W2);
        EpiY E{(bf16*)(F.ws + WS_YMOE), (const LAS int*)(F.lds + MISC_OFF + MS_START)};
        pg8::gemm_phase<EpiY, MoeSched2>(F.lds, 512, S, E);
    } SEAM(10);
    if (IN(11)) { moe_tables(F); p11_final(F, args); }
    if (PROBE_AMP == 11) { VM_WAIT(); AMP_SPIN(11); }
#undef IN
#undef SEAM
}

extern "C" void kernel_launch(void* const* d_in, const int* in_sizes, int n_in, void* d_out, int out_size, void* d_ws, size_t ws_size, hipStream_t stream) {
    static int grid = 0;
    if (grid == 0) {
        if (n_in != 24 || out_size != ML_ROWS * DM || ws_size < WS_END) { fprintf(stderr, "kernel_launch: unexpected shapes (n_in %d out %d ws %zu)\n", n_in, out_size, ws_size); grid = -1; return; }
        int dev = 0, cus = 0, per_cu = 0;
        if (hipGetDevice(&dev) != hipSuccess || hipDeviceGetAttribute(&cus, hipDeviceAttributeMultiprocessorCount, dev) != hipSuccess) { grid = -1; return; }
        if (hipFuncSetAttribute((const void*)mk_fwd, hipFuncAttributeMaxDynamicSharedMemorySize, LDS_BYTES) != hipSuccess) { fprintf(stderr, "kernel_launch: hipFuncSetAttribute failed\n"); grid = -1; return; }
        if (hipOccupancyMaxActiveBlocksPerMultiprocessor(&per_cu, (const void*)mk_fwd, 512, LDS_BYTES) != hipSuccess || per_cu < 1) fprintf(stderr, "kernel_launch: occupancy query says %d\n", per_cu);
        (void)hipGetLastError();
        grid = cus;
    }
    if (grid < 0) return;
    if (hipMemsetAsync((char*)d_ws + WS_CTL, 0, CTL_ZERO_BYTES, stream) != hipSuccess) return;
    Args a{};
    for (int i = 0; i < 24; ++i) a.in[i] = (const float*)d_in[i];
    a.out = (float*)d_out; a.ws = (unsigned char*)d_ws;
    if (MK_N_LAUNCHES == 1) { a.ph_lo = 0; a.ph_hi = NPHASE; a.li = 0; hipLaunchKernelGGL(mk_fwd, dim3(grid), dim3(512), LDS_BYTES, stream, a); }
    else for (int p = 0; p < NPHASE; ++p) { a.ph_lo = p; a.ph_hi = p + 1; a.li = p; a.pad = 0; hipLaunchKernelGGL(mk_fwd, dim3(grid), dim3(512), LDS_BYTES, stream, a);
        if (PROBE_DBL == p || (PROBE_DBL == 33 && p == 3)) { a.pad = (PROBE_DBL == 33) ? 2 : (p == 3 ? 1 : 0); hipLaunchKernelGGL(mk_fwd, dim3(grid), dim3(512), LDS_BYTES, stream, a); } }
}
```
